# Optimizing an MI355X kernel written in HIP

```python
import jax, jax.numpy as jnp
from jax import lax
import numpy as np

D_MODEL = 1024
BATCH = 1
SEQ = 16384
DEPTH = 1
DEC_BATCH = 128
DEC_SEQ = 1
PAST_LEN = 16384
PAGE_SIZE = 128

N_HEADS = 8
N_KV_HEADS = 2
HEAD_DIM = 128
GQA_GROUP = N_HEADS // N_KV_HEADS
ATTN_WIDTH = N_HEADS * HEAD_DIM
KV_WIDTH = N_KV_HEADS * HEAD_DIM
WINDOW = 128
BLOCK = WINDOW
D_RNN = D_MODEL
RNN_BLOCKS = 8
RNN_BLOCK_W = D_RNN // RNN_BLOCKS
RG_C = 8.0
RNN_CONV_W = 4
MIX_WIDTH = ATTN_WIDTH + D_RNN
IN_COLS = ATTN_WIDTH + 2 * KV_WIDTH + 2 * D_RNN
D_FF = 2816
FFN_CONV_W = 3
RMS_EPS = 1e-6

kernel_name = "hymba_swa_sink_rglru_convffn_step"


def rms_norm(x, g):
    x32 = x.astype(jnp.float32)
    y = x32 * lax.rsqrt(jnp.mean(x32 * x32, axis=-1, keepdims=True) + RMS_EPS)
    return (y * g.astype(jnp.float32)).astype(x.dtype)


def alibi_slopes():
    h = jnp.arange(1, N_HEADS + 1, dtype=jnp.float32)
    return jnp.exp2(-8.0 * h / N_HEADS).reshape(N_KV_HEADS, GQA_GROUP)


def sink_alibi_window_attention(q, k, v, q_pos, k_pos, sinks):
    s = jnp.einsum('...qkgd,...skd->...kgqs', q, k,
                   preferred_element_type=jnp.float32) * (HEAD_DIM ** -0.5)
    dist = q_pos[..., :, None] - k_pos[..., None, :]
    valid = (dist >= 0) & (dist < WINDOW) & (k_pos[..., None, :] >= 0)
    dist_f = dist.astype(jnp.float32)[..., None, None, :, :]
    s = jnp.where(valid[..., None, None, :, :],
                  s - alibi_slopes()[:, :, None, None] * dist_f, -jnp.inf)
    sink = sinks.astype(jnp.float32).reshape(N_KV_HEADS, GQA_GROUP)[:, :, None, None]
    m = jnp.maximum(jnp.max(s, axis=-1, keepdims=True), sink)
    p = jnp.exp(s - m)
    p = p / (jnp.sum(p, axis=-1, keepdims=True) + jnp.exp(sink - m))
    return jnp.einsum('...kgqs,...skd->...qkgd', p, v.astype(jnp.float32))


def prompt_window_attention(q, k, v, sinks):
    B, T = q.shape[:2]
    nb = T // BLOCK
    qb = q.reshape(B, nb, BLOCK, N_KV_HEADS, GQA_GROUP, HEAD_DIM)

    def band(t):
        tp = jnp.pad(t, ((0, 0), (BLOCK, 0), (0, 0), (0, 0)))
        tb = tp.reshape(B, nb + 1, BLOCK, N_KV_HEADS, HEAD_DIM)
        return jnp.concatenate([tb[:, :-1], tb[:, 1:]], axis=2)

    q_pos = jnp.arange(T, dtype=jnp.int32).reshape(nb, BLOCK)
    k_pos = q_pos[:, :1] - BLOCK + jnp.arange(2 * BLOCK, dtype=jnp.int32)[None, :]
    o = sink_alibi_window_attention(qb, band(k), band(v), q_pos, k_pos, sinks)
    return o.reshape(B, T, ATTN_WIDTH)


def sample_window_attention(q, k, v, cache_k, cache_v, sinks):
    B, T = q.shape[:2]
    W = cache_k.shape[1]
    keys = jnp.concatenate([cache_k.astype(k.dtype), k], axis=1)
    vals = jnp.concatenate([cache_v.astype(v.dtype), v], axis=1)
    q_pos = PAST_LEN + jnp.arange(T, dtype=jnp.int32)
    k_pos = PAST_LEN - W + jnp.arange(W + T, dtype=jnp.int32)
    o = sink_alibi_window_attention(q.reshape(B, T, N_KV_HEADS, GQA_GROUP, HEAD_DIM),
                                    keys, vals, q_pos, k_pos, sinks)
    return o.reshape(B, T, ATTN_WIDTH), keys[:, -W:], vals[:, -W:]


def causal_depthwise_conv(x, buf, w, b):
    width = w.shape[0]
    T = x.shape[1]
    xp = jnp.concatenate([buf.astype(x.dtype), x], axis=1)
    y = xp[:, 0:T] * w[0]
    for j in range(1, width):
        y = y + xp[:, j:j + T] * w[j]
    return (y + b).astype(x.dtype), xp[:, T:]


def rg_lru(x, w_a, b_a, w_i, b_i, lam, h0):
    B, T, _ = x.shape
    xb = x.reshape(B, T, RNN_BLOCKS, RNN_BLOCK_W)
    r = jax.nn.sigmoid(jnp.einsum('btnc,ncd->btnd', xb, w_a, preferred_element_type=jnp.float32)
                       + b_a.astype(jnp.float32)).reshape(B, T, D_RNN)
    i = jax.nn.sigmoid(jnp.einsum('btnc,ncd->btnd', xb, w_i, preferred_element_type=jnp.float32)
                       + b_i.astype(jnp.float32)).reshape(B, T, D_RNN)
    log_a = -RG_C * r * jax.nn.softplus(-lam.astype(jnp.float32))
    a = jnp.exp(log_a)
    u = jnp.sqrt(-jnp.expm1(2.0 * log_a)) * (i * x.astype(jnp.float32))
    u = u.at[:, 0].add(a[:, 0] * h0.astype(jnp.float32))

    def combine(left, right):
        a_l, u_l = left
        a_r, u_r = right
        return a_l * a_r, a_r * u_l + u_r

    _, h = lax.associative_scan(combine, (a, u), axis=1)
    return h, h[:, -1]


def decoder_layer(x, c, win_k, win_v, h0, conv_buf, ffn_buf, p, is_prompt, w_keep):
    B, T = x.shape[:2]
    dt = x.dtype
    mod = jax.nn.silu(c.astype(jnp.float32)) @ p['w_ada'].astype(jnp.float32) + p['b_ada'].astype(jnp.float32)
    sh1, sc1, g1, sh2, sc2, g2 = jnp.split(mod.astype(dt)[:, None, :], 6, axis=-1)

    hmix = rms_norm(x, p['g_pre_mix']) * (1 + sc1) + sh1
    z = hmix @ p['w_in']
    c1 = ATTN_WIDTH
    c2 = c1 + KV_WIDTH
    c3 = c2 + KV_WIDTH
    c4 = c3 + D_RNN
    q, k, v, xr, yr = jnp.split(z, [c1, c2, c3, c4], axis=-1)
    k = k.reshape(B, T, N_KV_HEADS, HEAD_DIM)
    v = v.reshape(B, T, N_KV_HEADS, HEAD_DIM)
    if is_prompt:
        attn = prompt_window_attention(q, k, v, p['sinks'])
        new_k, new_v = k[:, -w_keep:], v[:, -w_keep:]
    else:
        attn, new_k, new_v = sample_window_attention(q, k, v, win_k, win_v, p['sinks'])

    xc, new_conv = causal_depthwise_conv(xr, conv_buf, p['conv_w'], p['conv_b'])
    hseq, h_last = rg_lru(xc, p['w_a'], p['b_a'], p['w_i'], p['b_i'], p['lam'], h0)
    rnn = hseq * jax.nn.gelu(yr.astype(jnp.float32))

    mix = jnp.concatenate([rms_norm(attn.astype(dt), p['g_attn_out']),
                           rms_norm(rnn.astype(dt), p['g_rnn_out'])], axis=-1)
    x = x + g1 * rms_norm(mix @ p['w_out'], p['g_post_mix'])

    hff = rms_norm(x, p['g_pre_ffn']) * (1 + sc2) + sh2
    up, new_ffn = causal_depthwise_conv(hff @ p['w_up'], ffn_buf, p['ffn_conv_w'], p['ffn_conv_b'])
    gate, val = jnp.split(up, 2, axis=-1)
    f = (jax.nn.gelu(gate) * val) @ p['w_down']
    x = x + g2 * rms_norm(f, p['g_post_ffn'])
    return x, (new_k, new_v, h_last.astype(dt), new_conv, new_ffn)


def setup_inputs(seed: int = 0) -> dict:
    key = jax.random.key(seed)
    ks = jax.random.split(key, 40)
    f32 = jnp.float32
    w_keep = min(WINDOW, PAST_LEN)
    nrm = lambda k, shape, s: jax.random.normal(k, shape, f32) * s
    gain = lambda k, shape: 1.0 + 0.05 * jax.random.normal(k, shape, f32)
    a0 = jax.random.uniform(ks[20], (DEPTH, D_RNN), f32, 0.9, 0.999)
    a_base = a0 ** (1.0 / RG_C)
    lam = jnp.log(a_base) - jnp.log1p(-a_base)
    return {
        "x_prompt": nrm(ks[0], (BATCH, SEQ, D_MODEL), 1.0),
        "x_sample": nrm(ks[1], (DEC_BATCH, DEC_SEQ, D_MODEL), 1.0),
        "cache_k": nrm(ks[2], (DEPTH, DEC_BATCH, w_keep, N_KV_HEADS, HEAD_DIM), 1.0),
        "cache_v": nrm(ks[3], (DEPTH, DEC_BATCH, w_keep, N_KV_HEADS, HEAD_DIM), 1.0),
        "state_h": nrm(ks[4], (DEPTH, DEC_BATCH, D_RNN), 0.5),
        "state_conv": nrm(ks[5], (DEPTH, DEC_BATCH, RNN_CONV_W - 1, D_RNN), 1.0),
        "state_ffn_conv": nrm(ks[6], (DEPTH, DEC_BATCH, FFN_CONV_W - 1, 2 * D_FF), 1.0),
        "c_prompt": nrm(ks[7], (BATCH, D_MODEL), 1.0),
        "c_sample": nrm(ks[8], (DEC_BATCH, D_MODEL), 1.0),
        "w_ada": nrm(ks[9], (DEPTH, D_MODEL, 6 * D_MODEL), 0.5 * D_MODEL ** -0.5),
        "b_ada": nrm(ks[10], (DEPTH, 6 * D_MODEL), 0.02),
        "g_pre_mix": gain(ks[11], (DEPTH, D_MODEL)),
        "w_in": nrm(ks[12], (DEPTH, D_MODEL, IN_COLS), D_MODEL ** -0.5),
        "conv_w": nrm(ks[13], (DEPTH, RNN_CONV_W, D_RNN), RNN_CONV_W ** -0.5),
        "conv_b": nrm(ks[14], (DEPTH, D_RNN), 0.02),
        "w_a": nrm(ks[15], (DEPTH, RNN_BLOCKS, RNN_BLOCK_W, RNN_BLOCK_W), RNN_BLOCK_W ** -0.5),
        "b_a": nrm(ks[16], (DEPTH, RNN_BLOCKS, RNN_BLOCK_W), 0.02),
        "w_i": nrm(ks[17], (DEPTH, RNN_BLOCKS, RNN_BLOCK_W, RNN_BLOCK_W), RNN_BLOCK_W ** -0.5),
        "b_i": nrm(ks[18], (DEPTH, RNN_BLOCKS, RNN_BLOCK_W), 0.02),
        "lam": lam,
        "sinks": nrm(ks[19], (DEPTH, N_HEADS), 1.0),
        "g_attn_out": gain(ks[21], (DEPTH, ATTN_WIDTH)),
        "g_rnn_out": gain(ks[22], (DEPTH, D_RNN)),
        "w_out": nrm(ks[23], (DEPTH, MIX_WIDTH, D_MODEL), MIX_WIDTH ** -0.5),
        "g_post_mix": gain(ks[24], (DEPTH, D_MODEL)),
        "g_pre_ffn": gain(ks[25], (DEPTH, D_MODEL)),
        "w_up": nrm(ks[26], (DEPTH, D_MODEL, 2 * D_FF), D_MODEL ** -0.5),
        "ffn_conv_w": nrm(ks[27], (DEPTH, FFN_CONV_W, 2 * D_FF), FFN_CONV_W ** -0.5),
        "ffn_conv_b": nrm(ks[28], (DEPTH, 2 * D_FF), 0.02),
        "w_down": nrm(ks[29], (DEPTH, D_FF, D_MODEL), D_FF ** -0.5),
        "g_post_ffn": gain(ks[30], (DEPTH, D_MODEL)),
    }


def reference(x_prompt, x_sample, cache_k, cache_v, state_h, state_conv, state_ffn_conv,
              c_prompt, c_sample, w_ada, b_ada, g_pre_mix, w_in, conv_w, conv_b, w_a, b_a,
              w_i, b_i, lam, sinks, g_attn_out, g_rnn_out, w_out, g_post_mix, g_pre_ffn,
              w_up, ffn_conv_w, ffn_conv_b, w_down, g_post_ffn):
    w_keep = cache_k.shape[2]
    yp, ys = x_prompt, x_sample
    Bp = x_prompt.shape[0]
    dt = x_prompt.dtype
    p_states, s_states = [], []
    for l in range(DEPTH):
        p = dict(w_ada=w_ada[l], b_ada=b_ada[l], g_pre_mix=g_pre_mix[l], w_in=w_in[l],
                 conv_w=conv_w[l], conv_b=conv_b[l], w_a=w_a[l], b_a=b_a[l], w_i=w_i[l],
                 b_i=b_i[l], lam=lam[l], sinks=sinks[l], g_attn_out=g_attn_out[l],
                 g_rnn_out=g_rnn_out[l], w_out=w_out[l], g_post_mix=g_post_mix[l],
                 g_pre_ffn=g_pre_ffn[l], w_up=w_up[l], ffn_conv_w=ffn_conv_w[l],
                 ffn_conv_b=ffn_conv_b[l], w_down=w_down[l], g_post_ffn=g_post_ffn[l])
        yp, sp = decoder_layer(
            yp, c_prompt, None, None,
            jnp.zeros((Bp, D_RNN), jnp.float32),
            jnp.zeros((Bp, RNN_CONV_W - 1, D_RNN), dt),
            jnp.zeros((Bp, FFN_CONV_W - 1, 2 * D_FF), dt),
            p, True, w_keep)
        ys, ss = decoder_layer(
            ys, c_sample, cache_k[l], cache_v[l], state_h[l], state_conv[l],
            state_ffn_conv[l], p, False, w_keep)
        p_states.append(sp)
        s_states.append(ss)
    kp, vp, hp, convp, ffnp = [jnp.stack(t) for t in zip(*p_states)]
    ks_, vs_, hs_, convs_, ffns_ = [jnp.stack(t) for t in zip(*s_states)]
    return (yp, ys, kp, vp, hp, convp, ffnp, ks_, vs_, hs_, convs_, ffns_)
```

```cpp
#include <hip/hip_runtime.h>
#include <hip/hip_cooperative_groups.h>
#include <cstdio>
#include <cstdint>
namespace cg = cooperative_groups;

#ifndef MK_COOP
#define MK_COOP 1
#endif
#ifndef MK_PHMASK
#define MK_PHMASK 0x7ff
#endif
#define PH_ON(x) (((MK_PHMASK) >> (x)) & 1)

#define LAS __attribute__((address_space(3)))
typedef unsigned short bf16_t;
typedef short bf16x8 __attribute__((ext_vector_type(8)));
typedef short s16x4 __attribute__((ext_vector_type(4)));
typedef float f32x4 __attribute__((ext_vector_type(4)));
typedef float f32x16 __attribute__((ext_vector_type(16)));
typedef unsigned u32x4 __attribute__((ext_vector_type(4)));
typedef unsigned u32x2 __attribute__((ext_vector_type(2)));

constexpr int T_ = 16384, SB_ = 128, MR_ = 16512, MP_ = 16640;
constexpr float EPS_ = 1e-6f;
constexpr float LOG2E_ = 1.4426950408889634f;
constexpr float QSCALE_ = 0.08838834764831845f * 1.4426950408889634f;
constexpr int LDS_BYTES = 140288;

constexpr size_t OFF_WT_ADA = 0;
constexpr size_t OFF_A_ADA = OFF_WT_ADA + (size_t)6144 * 1024 * 2;
constexpr size_t OFF_MOD = OFF_A_ADA + (size_t)256 * 1024 * 2;
constexpr size_t OFF_WT_IN = OFF_MOD + (size_t)256 * 6144 * 4;
constexpr size_t OFF_WT_OUT = OFF_WT_IN + (size_t)3584 * 1024 * 2;
constexpr size_t OFF_WT_UP = OFF_WT_OUT + (size_t)1024 * 2048 * 2;
constexpr size_t OFF_WT_DOWN = OFF_WT_UP + (size_t)5632 * 1024 * 2;
constexpr size_t OFF_WT_A = OFF_WT_DOWN + (size_t)1024 * 2816 * 2;
constexpr size_t OFF_WT_I = OFF_WT_A + (size_t)8 * 128 * 128 * 2;
constexpr size_t OFF_SP8 = OFF_WT_I + (size_t)8 * 128 * 128 * 2;
constexpr size_t OFF_SS = OFF_SP8 + 4096;
constexpr size_t OFF_SEGA = OFF_SS + (size_t)4 * MP_ * 4;
constexpr size_t OFF_SEGE = OFF_SEGA + (size_t)512 * 1024 * 4;
constexpr size_t OFF_TILEA = OFF_SEGE + (size_t)512 * 1024 * 4;
constexpr size_t OFF_TILEE = OFF_TILEA + (size_t)128 * 1024 * 4;
constexpr size_t OFF_VSB = OFF_TILEE + (size_t)128 * 1024 * 4;
constexpr size_t OFF_MIX = OFF_VSB + (size_t)256 * 256 * 2;
constexpr size_t OFF_U = OFF_MIX + (size_t)MP_ * 2048 * 2;
constexpr size_t OFF_KB = OFF_U + (size_t)MP_ * 1024 * 2;
constexpr size_t OFF_VT = OFF_KB + (size_t)MP_ * 256 * 2;
constexpr size_t OFF_XR = OFF_VT + (size_t)256 * T_ * 2;
constexpr size_t OFF_HM0 = OFF_XR + (size_t)MP_ * 1024 * 2;
constexpr size_t OFF_HM = OFF_HM0 + 4096;
constexpr size_t WS_NEED = OFF_HM + (size_t)MP_ * 1024 * 2;
static_assert(WS_NEED <= (size_t)256 * 1024 * 1024, "workspace");
static_assert(OFF_MIX + (size_t)MP_ * 2816 * 2 <= OFF_KB, "FIN alias");

constexpr size_t O_YP = 0, O_YS = O_YP + (size_t)T_ * 1024, O_KP = O_YS + 128 * 1024, O_VP = O_KP + 32768, O_HP = O_VP + 32768,
                 O_CP = O_HP + 1024, O_FP = O_CP + 3072, O_KS = O_FP + 11264, O_VS = O_KS + 4194304, O_HS = O_VS + 4194304,
                 O_CS = O_HS + 131072, O_FS = O_CS + 393216;

struct Params { const float* in[31]; float* out; char* ws; };
enum { I_XP = 0, I_XS, I_CK, I_CV, I_SH, I_SC, I_SF, I_CP, I_CS, I_WADA, I_BADA, I_GPM, I_WIN, I_CW, I_CB, I_WA, I_BA, I_WI, I_BI, I_LAM, I_SINK,
       I_GAO, I_GRO, I_WOUT, I_GPOM, I_GPF, I_WUP, I_FCW, I_FCB, I_WDOWN, I_GPOF };

__device__ __forceinline__ unsigned cvt_pk_bf16(float lo, float hi) { unsigned r; asm volatile("v_cvt_pk_bf16_f32 %0, %1, %2" : "=v"(r) : "v"(lo), "v"(hi)); return r; }
__device__ __forceinline__ float bf2f(unsigned b) { return __uint_as_float(b << 16); }
__device__ __forceinline__ float bflo(unsigned w) { return __uint_as_float(w << 16); }
__device__ __forceinline__ float bfhi(unsigned w) { return __uint_as_float(w & 0xffff0000u); }
__device__ __forceinline__ bf16_t f2bf(float f) { return (bf16_t)(cvt_pk_bf16(f, 0.f) & 0xffffu); }
__device__ __forceinline__ float gelu_t(float x) { const float u = x * (1.0f + 0.044715f * x * x); const float e = __builtin_amdgcn_exp2f(-2.302208198f * u); return x * __builtin_amdgcn_rcpf(1.0f + e); }
__device__ __forceinline__ float sigmoid_f(float x) { return __builtin_amdgcn_rcpf(1.0f + __builtin_amdgcn_exp2f(-LOG2E_ * x)); }
__device__ __forceinline__ float wave_sum(float v) { v += __shfl_xor(v, 1); v += __shfl_xor(v, 2); v += __shfl_xor(v, 4); v += __shfl_xor(v, 8); v += __shfl_xor(v, 16); v += __shfl_xor(v, 32); return v; }
__device__ __forceinline__ int modrow(int r) { return r < T_ ? 0 : r - T_ + 1; }

constexpr int BM = 256, BK = 64, HALF = 128, HTB = HALF * BK * 2, STAGE_BYTES = 8 * HTB, NXCD = 8, WGM = 8;
__device__ __forceinline__ int lds_byte(int r, int c) { const int st = (r >> 4) * 2 + (c >> 5), rr = r & 15, cc = c & 31, ob = rr * 64 + cc * 2; return st * 1024 + (ob ^ (((ob >> 9) & 1) << 5)); }
__device__ __forceinline__ void stage_rc(int b, int& R, int& C) { const int st = b / 1024, sb = b % 1024, swz = sb ^ (((sb >> 9) & 1) << 5); R = (st >> 1) * 16 + swz / 64; C = (st & 1) * 32 + (swz % 64) / 2; }
struct Unit { int pm, pn; };
struct Gemm { const bf16_t* A; const bf16_t* Bt; int K; };
struct Sched {
    int nM, nN, nwg, G, c;
    __device__ void init(int nM_, int nN_, int G_, int c_) { nM = nM_; nN = nN_; nwg = nM * nN; G = G_; c = c_; }
    __device__ bool next(int i, Unit& u) const {
        const long L = (long)i * G + c; if (L >= nwg) return false;
        int wgid = (int)L; { const int q = nwg / NXCD, r = nwg % NXCD, xcd = wgid % NXCD, off = wgid / NXCD; wgid = (xcd < r ? xcd * (q + 1) : r * (q + 1) + (xcd - r) * q) + off; }
        const int nig = WGM * nN, gid = wgid / nig, fm = gid * WGM, gsz = (nM - fm) < WGM ? (nM - fm) : WGM;
        u.pm = fm + ((wgid % nig) % gsz); u.pn = (wgid % nig) / gsz; return true;
    }
};
template <bool APERM> __device__ __forceinline__ size_t tileA_off(int pm, int K) {
    if (APERM) return (size_t)(pm < 66 ? 252 * pm : 16386) * (size_t)K * 2 - (size_t)2 * K * 2;
    return (size_t)pm * 256 * (size_t)K * 2;
}

template <class Epi, bool APERM, bool MID>
__device__ __forceinline__ void gemm_phase(LAS unsigned char* lds, const Gemm g, const Sched& S, const Epi& E) {
    int tid = threadIdx.x; asm volatile("" : "+v"(tid));
    const int wid = __builtin_amdgcn_readfirstlane(tid >> 6), lane = tid & 63, wr = wid >> 2, wc = wid & 3, fr = lane & 15, fq = lane >> 4;
    const int K = g.K, nt = K / BK;
    unsigned voffA[2], voffB[2];
#pragma unroll
    for (int i = 0; i < 2; ++i) { int R, C; stage_rc(tid * 16 + i * 8192, R, C);
        const int Ra = APERM ? (126 * (R >> 6) + 8 * (R & 15) + ((R >> 4) & 3)) : R;
        voffA[i] = (unsigned)(Ra * K + C) * 2u; voffB[i] = (unsigned)(R * K + C) * 2u; }
    const size_t kstep = (size_t)(BK * 2);
    const size_t hstepB = (size_t)HALF * K * 2;
    const size_t hstepA = APERM ? (size_t)4 * K * 2 : hstepB;
    const size_t tstepB = 2 * hstepB;
    const unsigned ldsw = (unsigned)wid * 1024u;
    const int aoff = lds_byte(wr * 64 + fr, fq * 8), boff = lds_byte(wc * 32 + fr, fq * 8);
#define PG8_SA(b, h) (((b) * 2 + (h)) * HTB)
#define PG8_SB(b, h) ((4 + (b) * 2 + (h)) * HTB)
#define PG8_STAGE(bufoff, gbase, voff) do { _Pragma("unroll") for (int _i = 0; _i < 2; ++_i) \
        __builtin_amdgcn_global_load_lds((const unsigned*)((const char*)(gbase) + (voff)[_i]), (LAS unsigned*)(lds + (bufoff) + ldsw + _i * 8192), 16, 0, 0); } while (0)
#define PG8_LDA(dst, b, h) do { _Pragma("unroll") for (int m = 0; m < 4; ++m) _Pragma("unroll") for (int k = 0; k < 2; ++k) dst[m][k] = *(const LAS bf16x8*)(lds + PG8_SA(b, h) + aoff + m * 2048 + k * 1024); } while (0)
#define PG8_LDB(dst, b, h) do { _Pragma("unroll") for (int n = 0; n < 2; ++n) _Pragma("unroll") for (int k = 0; k < 2; ++k) dst[n][k] = *(const LAS bf16x8*)(lds + PG8_SB(b, h) + boff + n * 2048 + k * 1024); } while (0)
#define PG8_MMA(ai, bj, At, Bt) do { __builtin_amdgcn_s_setprio(1); _Pragma("unroll") for (int m = 0; m < 4; ++m) _Pragma("unroll") for (int n = 0; n < 2; ++n) _Pragma("unroll") for (int k = 0; k < 2; ++k) \
        acc[ai][bj][m][n] = __builtin_amdgcn_mfma_f32_16x16x32_bf16(Bt[n][k], At[m][k], acc[ai][bj][m][n], 0, 0, 0); __builtin_amdgcn_s_setprio(0); } while (0)
#define PG8_WAIT_V(n) asm volatile("s_waitcnt vmcnt(" #n ")" ::: "memory")
#define PG8_WAIT_L(n) asm volatile("s_waitcnt lgkmcnt(" #n ")" ::: "memory")
#define PG8_BAR __builtin_amdgcn_s_barrier()
#define PG8_SCHED __builtin_amdgcn_sched_barrier(0)
    Unit cur, nxt; int ui = 0;
    if (!S.next(0, cur)) return;
    f32x4 acc[2][2][4][2];
#pragma unroll
    for (int a = 0; a < 2; ++a)
#pragma unroll
        for (int b = 0; b < 2; ++b)
#pragma unroll
            for (int m = 0; m < 4; ++m)
#pragma unroll
                for (int n = 0; n < 2; ++n) acc[a][b][m][n] = (f32x4){0.f, 0.f, 0.f, 0.f};
    bf16x8 At[4][2], B0[2][2], B1[2][2];
    const char* cA = (const char*)g.A + tileA_off<APERM>(cur.pm, K); const char* cB = (const char*)g.Bt + (size_t)cur.pn * tstepB;
    PG8_STAGE(PG8_SB(0, 0), cB, voffB); PG8_STAGE(PG8_SA(0, 0), cA, voffA); PG8_STAGE(PG8_SB(0, 1), cB + hstepB, voffB); PG8_STAGE(PG8_SA(0, 1), cA + hstepA, voffA);
    if (wr == 1) PG8_BAR;
    PG8_WAIT_V(4); PG8_BAR;
    PG8_STAGE(PG8_SB(1, 0), cB + kstep, voffB); PG8_STAGE(PG8_SA(1, 0), cA + kstep, voffA); PG8_STAGE(PG8_SB(1, 1), cB + hstepB + kstep, voffB);
    PG8_WAIT_V(6); PG8_BAR;
    for (;;) {
        const bool has_next = S.next(ui + 1, nxt);
        const char* nA = has_next ? (const char*)g.A + tileA_off<APERM>(nxt.pm, K) : cA; const char* nB = has_next ? (const char*)g.Bt + (size_t)nxt.pn * tstepB : cB;
        for (int t = 0; t < nt; t += 2) {
            const bool last = (t == nt - 2);
            const char* a1 = cA + (size_t)(t + 1) * kstep;
            const char* a2 = last ? nA : cA + (size_t)(t + 2) * kstep; const char* b2 = last ? nB : cB + (size_t)(t + 2) * kstep;
            const char* a3 = a2 + kstep; const char* b3 = b2 + kstep;
            if constexpr (MID) { if (t == (nt >> 1)) E.mid(acc, cur, wr, fr); }
            PG8_LDB(B0, 0, 0); PG8_SCHED; PG8_LDA(At, 0, 0); PG8_STAGE(PG8_SA(1, 1), a1 + hstepA, voffA);
            PG8_WAIT_L(8); PG8_BAR; PG8_WAIT_L(0); PG8_MMA(0, 0, At, B0); PG8_BAR; PG8_SCHED;
            PG8_LDB(B1, 0, 1); PG8_STAGE(PG8_SB(0, 0), b2, voffB);
            PG8_BAR; PG8_WAIT_L(0); PG8_MMA(0, 1, At, B1); PG8_BAR;
            PG8_LDA(At, 0, 1); PG8_STAGE(PG8_SA(0, 0), a2, voffA);
            PG8_BAR; PG8_WAIT_L(0); PG8_MMA(1, 0, At, B0); PG8_BAR; PG8_SCHED;
            PG8_STAGE(PG8_SB(0, 1), b2 + hstepB, voffB);
            PG8_WAIT_V(6); PG8_BAR; PG8_MMA(1, 1, At, B1); PG8_BAR;
            PG8_LDB(B0, 1, 0); PG8_SCHED; PG8_LDA(At, 1, 0); PG8_STAGE(PG8_SA(0, 1), a2 + hstepA, voffA);
            PG8_WAIT_L(8); PG8_BAR; PG8_WAIT_L(0); PG8_MMA(0, 0, At, B0); PG8_BAR; PG8_SCHED;
            PG8_LDB(B1, 1, 1); PG8_STAGE(PG8_SB(1, 0), b3, voffB);
            PG8_BAR; PG8_WAIT_L(0); PG8_MMA(0, 1, At, B1); PG8_BAR;
            PG8_LDA(At, 1, 1); PG8_STAGE(PG8_SA(1, 0), a3, voffA);
            PG8_BAR; PG8_WAIT_L(0); PG8_MMA(1, 0, At, B0); PG8_BAR; PG8_SCHED;
            PG8_STAGE(PG8_SB(1, 1), b3 + hstepB, voffB);
            PG8_WAIT_V(6); PG8_BAR; PG8_MMA(1, 1, At, B1); PG8_BAR;
        }
        E(acc, cur, wr, wc, fr, fq);
        if (!has_next) break;
#pragma unroll
        for (int a = 0; a < 2; ++a)
#pragma unroll
            for (int b = 0; b < 2; ++b)
#pragma unroll
                for (int m = 0; m < 4; ++m)
#pragma unroll
                    for (int n = 0; n < 2; ++n) acc[a][b][m][n] = (f32x4){0.f, 0.f, 0.f, 0.f};
        cur = nxt; cA = nA; cB = nB; ++ui;
    }
    PG8_WAIT_V(0);
    if (wr == 0) PG8_BAR;
    PG8_BAR;
#undef PG8_SA
#undef PG8_SB
#undef PG8_STAGE
#undef PG8_LDA
#undef PG8_LDB
#undef PG8_MMA
#undef PG8_WAIT_V
#undef PG8_WAIT_L
#undef PG8_BAR
#undef PG8_SCHED
}

typedef f32x4 AccT[2][2][4][2];

#ifndef E1MASK
#define E1MASK 31
#endif
#define E1B(x) (((E1MASK) >> (x)) & 1)
#ifndef P4MASK
#define P4MASK 7
#endif
#define P4B(x) (((P4MASK) >> (x)) & 1)
#define EPI_FENCE() asm volatile("" ::: "memory")
__device__ __forceinline__ u32x2 pk4(const f32x4 v) { u32x2 w; w.x = cvt_pk_bf16(v[0], v[1]); w.y = cvt_pk_bf16(v[2], v[3]); return w; }

struct EpiAda {
    float* C; const float* bias;
    __device__ __forceinline__ void operator()(const AccT& acc, const Unit& u, int wr, int wc, int fr, int fq) const {
        const int col0 = u.pn * BM + wc * 32 + 4 * fq;
        float* base = C + (size_t)(u.pm * BM + wr * 64 + fr) * 6144 + col0; const float* bp = bias + col0;
#pragma unroll
        for (int bj = 0; bj < 2; ++bj)
#pragma unroll
            for (int n = 0; n < 2; ++n) { const f32x4 bv = *(const f32x4*)(bp + bj * HALF + n * 16);
#pragma unroll
                for (int ai = 0; ai < 2; ++ai)
#pragma unroll
                    for (int m = 0; m < 4; ++m) *(f32x4*)(base + (size_t)(ai * HALF + m * 16) * 6144 + bj * HALF + n * 16) = acc[ai][bj][m][n] + bv;
                EPI_FENCE(); }
    }
};

struct Epi1 {
    bf16_t* MIX; bf16_t* KB; bf16_t* VT; bf16_t* VSB; bf16_t* XR;
    __device__ __forceinline__ void operator()(const AccT& acc, const Unit& u, int wr, int wc, int fr, int fq) const {
        const int rl = wr * 64 + fr, row0 = u.pm * BM + rl, cw = wc * 32 + 4 * fq; const int pn = u.pn, pm = u.pm;
        if (pn == 5 && pm < 64) {
            bf16_t* cp0 = VT + (size_t)cw * T_ + row0;
#pragma unroll
            for (int bj = 0; bj < 2; ++bj)
#pragma unroll
                for (int n = 0; n < 2; ++n) {
#pragma unroll
                    for (int e = 0; e < 4; ++e) { bf16_t* p = cp0 + (size_t)(bj * HALF + n * 16 + e) * T_;
#pragma unroll
                        for (int ai = 0; ai < 2; ++ai)
#pragma unroll
                            for (int m = 0; m < 4; ++m) p[ai * HALF + m * 16] = f2bf(acc[ai][bj][m][n][e]);
                        EPI_FENCE(); } }
            return;
        }
        bf16_t* base; int ld; float sc = 1.0f; bool gel = false;
        if (pn < 4) { base = MIX + (size_t)row0 * 2048 + pn * 256 + cw; ld = 2048; sc = QSCALE_; }
        else if (pn == 4) { base = KB + (size_t)row0 * 256 + cw; ld = 256; }
        else if (pn == 5) { base = VSB + (size_t)rl * 256 + cw; ld = 256; }
        else if (pn < 10) { base = XR + (size_t)row0 * 1024 + (pn - 6) * 256 + cw; ld = 1024; }
        else { base = MIX + (size_t)row0 * 2048 + 1024 + (pn - 10) * 256 + cw; ld = 2048; gel = true; }
        if (!gel) {
#pragma unroll
            for (int ai = 0; ai < 2; ++ai)
#pragma unroll
                for (int m = 0; m < 4; ++m) { bf16_t* rp = base + (size_t)(ai * HALF + m * 16) * ld;
#pragma unroll
                    for (int bj = 0; bj < 2; ++bj)
#pragma unroll
                        for (int n = 0; n < 2; ++n) *(u32x2*)(rp + bj * HALF + n * 16) = pk4(acc[ai][bj][m][n] * sc);
                    EPI_FENCE(); }
        } else {
#pragma unroll
            for (int ai = 0; ai < 2; ++ai)
#pragma unroll
                for (int m = 0; m < 4; ++m) { bf16_t* rp = base + (size_t)(ai * HALF + m * 16) * ld;
#pragma unroll
                    for (int bj = 0; bj < 2; ++bj)
#pragma unroll
                        for (int n = 0; n < 2; ++n) { const f32x4 v = acc[ai][bj][m][n]; u32x2 w; w.x = cvt_pk_bf16(gelu_t(v[0]), gelu_t(v[1])); w.y = cvt_pk_bf16(gelu_t(v[2]), gelu_t(v[3]));
                            *(u32x2*)(rp + bj * HALF + n * 16) = w; }
                    EPI_FENCE(); }
        }
    }
};

struct Epi2 {
    bf16_t* O; const float* SSA; const float* SSR; float* SSO;
    __device__ __forceinline__ void mid(AccT& acc, const Unit& u, int wr, int fr) const {
        const int row0 = u.pm * BM + wr * 64 + fr; const float* pa = SSA + row0; const float* pr = SSR + row0;
#pragma unroll
        for (int ai = 0; ai < 2; ++ai)
#pragma unroll
            for (int m = 0; m < 4; ++m) {
                const float ra = pa[ai * HALF + m * 16] * (1.0f / 1024.0f) + EPS_, rr = pr[ai * HALF + m * 16] * (1.0f / 1024.0f) + EPS_; const float ratio = sqrtf(rr * __builtin_amdgcn_rcpf(ra));
#pragma unroll
                for (int bj = 0; bj < 2; ++bj)
#pragma unroll
                    for (int n = 0; n < 2; ++n) acc[ai][bj][m][n] *= ratio;
                EPI_FENCE(); }
    }
    __device__ __forceinline__ void operator()(const AccT& acc, const Unit& u, int wr, int wc, int fr, int fq) const {
        const int row0 = u.pm * BM + wr * 64 + fr, col0 = u.pn * BM + wc * 32 + 4 * fq;
        bf16_t* base = O + (size_t)row0 * 1024 + col0; const float* pr = SSR + row0; float* po = SSO + row0;
#pragma unroll
        for (int ai = 0; ai < 2; ++ai)
#pragma unroll
            for (int m = 0; m < 4; ++m) { const float rs = rsqrtf(pr[ai * HALF + m * 16] * (1.0f / 1024.0f) + EPS_); float ss = 0.f; bf16_t* rp = base + (size_t)(ai * HALF + m * 16) * 1024;
#pragma unroll
                for (int bj = 0; bj < 2; ++bj)
#pragma unroll
                    for (int n = 0; n < 2; ++n) { const f32x4 v = acc[ai][bj][m][n] * rs; ss += (v[0] * v[0] + v[1] * v[1]) + (v[2] * v[2] + v[3] * v[3]);
                        *(u32x2*)(rp + bj * HALF + n * 16) = pk4(v); }
                ss += __shfl_xor(ss, 16); ss += __shfl_xor(ss, 32);
                if (fq == 0) atomicAdd(po + ai * HALF + m * 16, ss);
                EPI_FENCE(); }
    }
};

struct Epi4 {
    bf16_t* F; float* SSF;
    __device__ __forceinline__ void operator()(const AccT& acc, const Unit& u, int wr, int wc, int fr, int fq) const {
        const int row0 = u.pm * BM + wr * 64 + fr, col0 = u.pn * BM + wc * 32 + 4 * fq;
        bf16_t* base = F + (size_t)row0 * 1024 + col0; float* po = SSF + row0;
#pragma unroll
        for (int ai = 0; ai < 2; ++ai)
#pragma unroll
            for (int m = 0; m < 4; ++m) { float ss = 0.f; bf16_t* rp = base + (size_t)(ai * HALF + m * 16) * 1024;
#pragma unroll
                for (int bj = 0; bj < 2; ++bj)
#pragma unroll
                    for (int n = 0; n < 2; ++n) { const f32x4 v = acc[ai][bj][m][n]; ss += (v[0] * v[0] + v[1] * v[1]) + (v[2] * v[2] + v[3] * v[3]);
                        *(u32x2*)(rp + bj * HALF + n * 16) = pk4(v); }
                ss += __shfl_xor(ss, 16); ss += __shfl_xor(ss, 32);
                if (fq == 0) atomicAdd(po + ai * HALF + m * 16, ss);
                EPI_FENCE(); }
    }
};

struct Epi3 {
    bf16_t* FIN; const float* fcw; const float* fcb; const float* sfc; float* out;
    __device__ __forceinline__ void operator()(const AccT& acc, const Unit& u, int wr, int wc, int fr, int fq) const {
        const bool sample = (u.pm == 66);
        const int tau = sample ? 16386 : 252 * u.pm;
        const int tb = tau + 126 * wr + 8 * fr - 2;
        const int j0 = 128 * u.pn + 32 * wc + 4 * fq;
#pragma unroll
        for (int n = 0; n < 2; ++n) {
            const int j = j0 + 16 * n; const float* wp = fcw + j; const float* bp = fcb + j;
            const f32x4 gw0 = *(const f32x4*)(wp), gw1 = *(const f32x4*)(wp + 5632), gw2 = *(const f32x4*)(wp + 2 * 5632), gb = *(const f32x4*)(bp);
            const f32x4 vw0 = *(const f32x4*)(wp + 2816), vw1 = *(const f32x4*)(wp + 5632 + 2816), vw2 = *(const f32x4*)(wp + 2 * 5632 + 2816), vb = *(const f32x4*)(bp + 2816);
            EPI_FENCE();
            if (!sample) {
                f32x4 g2, g1, v2, v1;
#pragma unroll
                for (int e = 0; e < 4; ++e) { g2[e] = __shfl_up(acc[1][0][2][n][e], 1, 16); g1[e] = __shfl_up(acc[1][0][3][n][e], 1, 16);
                                              v2[e] = __shfl_up(acc[1][1][2][n][e], 1, 16); v1[e] = __shfl_up(acc[1][1][3][n][e], 1, 16); }
                bf16_t* fp = FIN + (size_t)tb * 2816 + j;
#pragma unroll
                for (int s = 0; s < 8; ++s) {
                    const f32x4 g0 = acc[s >> 2][0][s & 3][n], v0 = acc[s >> 2][1][s & 3][n];
                    const int t = tb + s;
                    const bool valid = !(fr == 0 && s < 2) && t < T_;
                    if (valid) {
                        const f32x4 yg = gw0 * g2 + gw1 * g1 + gw2 * g0 + gb, yv = vw0 * v2 + vw1 * v1 + vw2 * v0 + vb;
                        u32x2 w; w.x = cvt_pk_bf16(gelu_t(yg[0]) * yv[0], gelu_t(yg[1]) * yv[1]); w.y = cvt_pk_bf16(gelu_t(yg[2]) * yv[2], gelu_t(yg[3]) * yv[3]);
                        *(u32x2*)(fp) = w;
                    }
                    g2 = g1; g1 = g0; v2 = v1; v1 = v0; fp += 2816;
                    EPI_FENCE();
                }
                if (u.pm == 65 && wr == 0 && fr == 0) {
                    float* ob = out + O_FP + j;
                    *(f32x4*)(ob) = acc[1][0][0][n]; *(f32x4*)(ob + 2816) = acc[1][1][0][n];
                    *(f32x4*)(ob + 5632) = acc[1][0][1][n]; *(f32x4*)(ob + 5632 + 2816) = acc[1][1][1][n];
                }
            } else if (wr == 0) {
                const float* sp = sfc + (size_t)(8 * fr) * 11264 + j; bf16_t* fp = FIN + (size_t)(T_ + 8 * fr) * 2816 + j; float* ob = out + O_FS + (size_t)(8 * fr) * 11264 + 5632 + j;
#pragma unroll
                for (int s = 0; s < 8; ++s) {
                    const f32x4 g0 = acc[s >> 2][0][s & 3][n], v0 = acc[s >> 2][1][s & 3][n];
                    const f32x4 sg0 = *(const f32x4*)(sp), sg1 = *(const f32x4*)(sp + 5632), sv0 = *(const f32x4*)(sp + 2816), sv1 = *(const f32x4*)(sp + 5632 + 2816);
                    const f32x4 yg = gw0 * sg0 + gw1 * sg1 + gw2 * g0 + gb, yv = vw0 * sv0 + vw1 * sv1 + vw2 * v0 + vb;
                    u32x2 w; w.x = cvt_pk_bf16(gelu_t(yg[0]) * yv[0], gelu_t(yg[1]) * yv[1]); w.y = cvt_pk_bf16(gelu_t(yg[2]) * yv[2], gelu_t(yg[3]) * yv[3]);
                    *(u32x2*)(fp) = w;
                    *(f32x4*)(ob) = g0; *(f32x4*)(ob + 2816) = v0;
                    sp += 11264; fp += 2816; ob += 11264;
                    EPI_FENCE();
                }
            }
            EPI_FENCE();
        }
    }
};

__device__ __forceinline__ void tr_tile(float* tl, const float* W, int ldw, bf16_t* Wt, int ldt, int k0, int n0, int dn0, const float* ks0, const float* ks1) {
    int tid = threadIdx.x; asm volatile("" : "+v"(tid));
    { const int r = tid >> 4, c4 = (tid & 15) * 4;
#pragma unroll
      for (int p = 0; p < 2; ++p) { const int row = p * 32 + r; const f32x4 v = *(const f32x4*)(W + (size_t)(k0 + row) * ldw + n0 + c4);
          float sc = 1.f; if (ks0) { const int k = k0 + row; sc = k < 1024 ? ks0[k] : ks1[k - 1024]; }
          tl[row * 65 + c4 + 0] = v[0] * sc; tl[row * 65 + c4 + 1] = v[1] * sc; tl[row * 65 + c4 + 2] = v[2] * sc; tl[row * 65 + c4 + 3] = v[3] * sc; } }
    __syncthreads();
    { const int n = tid >> 3, kc = (tid & 7) * 8; float f[8];
#pragma unroll
      for (int i = 0; i < 8; ++i) f[i] = tl[(kc + i) * 65 + n];
      u32x4 w; w.x = cvt_pk_bf16(f[0], f[1]); w.y = cvt_pk_bf16(f[2], f[3]); w.z = cvt_pk_bf16(f[4], f[5]); w.w = cvt_pk_bf16(f[6], f[7]);
      *(u32x4*)(Wt + (size_t)(dn0 + n) * ldt + k0 + kc) = w; }
    __syncthreads();
}

__device__ void phase0(const Params& P, float* ldsf) {
    char* ws = P.ws; const int G = gridDim.x, bid = blockIdx.x; int tid = threadIdx.x; asm volatile("" : "+v"(tid));
    for (int idx = bid; idx < 16 * 96; idx += G) { const int ntile = idx % 96, kt = idx / 96;
        tr_tile(ldsf, P.in[I_WADA], 6144, (bf16_t*)(ws + OFF_WT_ADA), 1024, kt * 64, ntile * 64, ntile * 64, nullptr, nullptr); }
    const size_t gt = (size_t)bid * 512 + tid, gs = (size_t)G * 512;
    { bf16_t* A = (bf16_t*)(ws + OFF_A_ADA);
      for (size_t i = gt; i < (size_t)256 * 1024; i += gs) { const int r = (int)(i >> 10), c = (int)(i & 1023); float v = 0.f;
          if (r == 0) v = P.in[I_CP][c]; else if (r <= 128) v = P.in[I_CS][(size_t)(r - 1) * 1024 + c];
          A[i] = f2bf(v * sigmoid_f(v)); } }
    { float* sp = (float*)(ws + OFF_SP8); for (size_t i = gt; i < 1024; i += gs) sp[i] = 8.0f * log1pf(expf(-P.in[I_LAM][i])); }
    { float* ss = (float*)(ws + OFF_SS); for (size_t i = gt; i < (size_t)4 * MP_; i += gs) ss[i] = 0.f; }
    { float* o = P.out + O_CS; const float* s = P.in[I_SC];
      for (size_t i = gt; i < (size_t)128 * 2048; i += gs) { const size_t b = i >> 11, r = i & 2047; o[b * 3072 + r] = s[b * 3072 + 1024 + r]; } }
    { float* o = P.out + O_FS; const float* s = P.in[I_SF];
      for (size_t i = gt; i < (size_t)128 * 5632; i += gs) { const size_t b = i / 5632, r = i % 5632; o[b * 11264 + r] = s[b * 11264 + 5632 + r]; } }
    { unsigned* z = (unsigned*)(ws + OFF_HM0); for (size_t i = gt; i < 1024; i += gs) z[i] = 0u; }
}

__device__ void phase1(const Params& P, LAS unsigned char* lds, float* ldsf) {
    char* ws = P.ws; const int G = gridDim.x, bid = blockIdx.x;
    { Gemm g{(const bf16_t*)(ws + OFF_A_ADA), (const bf16_t*)(ws + OFF_WT_ADA), 1024}; Sched S; S.init(1, 24, G, bid);
      EpiAda E{(float*)(ws + OFF_MOD), P.in[I_BADA]}; gemm_phase<EpiAda, false, false>(lds, g, S, E); }
    __syncthreads();
    int wk, nw; if (G > 48) { if (bid < 24) return; wk = bid - 24; nw = G - 24; } else { wk = bid; nw = G; }
    for (int idx = wk; idx < 3584; idx += nw) {
        if (idx < 896) { const int ntile = idx % 56, kt = idx / 56; tr_tile(ldsf, P.in[I_WIN], 3584, (bf16_t*)(ws + OFF_WT_IN), 1024, kt * 64, ntile * 64, ntile * 64, nullptr, nullptr); }
        else if (idx < 1408) { const int i2 = idx - 896, ntile = i2 % 16, kt = i2 / 16; tr_tile(ldsf, P.in[I_WOUT], 1024, (bf16_t*)(ws + OFF_WT_OUT), 2048, kt * 64, ntile * 64, ntile * 64, P.in[I_GAO], P.in[I_GRO]); }
        else if (idx < 2816) { const int i2 = idx - 1408, ntile = i2 % 88, kt = i2 / 88; const int n0 = ntile * 64;
            const int dn0 = n0 < 2816 ? ((n0 >> 7) * 256 + (n0 & 127)) : ((((n0 - 2816) >> 7) * 256) + 128 + ((n0 - 2816) & 127));
            tr_tile(ldsf, P.in[I_WUP], 5632, (bf16_t*)(ws + OFF_WT_UP), 1024, kt * 64, n0, dn0, nullptr, nullptr); }
        else if (idx < 3520) { const int i2 = idx - 2816, ntile = i2 % 16, kt = i2 / 16; tr_tile(ldsf, P.in[I_WDOWN], 1024, (bf16_t*)(ws + OFF_WT_DOWN), 2816, kt * 64, ntile * 64, ntile * 64, nullptr, nullptr); }
        else { const int i2 = (idx - 3520) & 31, blk = i2 >> 2, kt = (i2 >> 1) & 1, ntile = i2 & 1; const bool isA = idx < 3552;
            tr_tile(ldsf, P.in[isA ? I_WA : I_WI] + (size_t)blk * 16384, 128, (bf16_t*)(ws + (isA ? OFF_WT_A : OFF_WT_I)) + (size_t)blk * 16384, 128, kt * 64, ntile * 64, ntile * 64, nullptr, nullptr); }
    }
}

__device__ void phase2(const Params& P) {
    int tid = threadIdx.x; asm volatile("" : "+v"(tid));
    char* ws = P.ws; const int wid = tid >> 6, lane = tid & 63; const float* MOD = (const float*)(ws + OFF_MOD); bf16_t* H = (bf16_t*)(ws + OFF_HM);
    for (int r = blockIdx.x * 8 + wid; r < MP_; r += gridDim.x * 8) {
        if (r >= MR_) { for (int i = 0; i < 4; ++i) *(u32x2*)(H + (size_t)r * 1024 + i * 256 + lane * 4) = (u32x2){0u, 0u}; continue; }
        const float* x = r < T_ ? P.in[I_XP] + (size_t)r * 1024 : P.in[I_XS] + (size_t)(r - T_) * 1024; const float* md = MOD + (size_t)modrow(r) * 6144;
        f32x4 v[4]; float ss = 0.f;
#pragma unroll
        for (int i = 0; i < 4; ++i) { v[i] = *(const f32x4*)(x + i * 256 + lane * 4); ss += (v[i][0] * v[i][0] + v[i][1] * v[i][1]) + (v[i][2] * v[i][2] + v[i][3] * v[i][3]); }
        ss = wave_sum(ss); const float rs = rsqrtf(ss * (1.0f / 1024.0f) + EPS_);
#pragma unroll
        for (int i = 0; i < 4; ++i) { const int c = i * 256 + lane * 4; const f32x4 g = *(const f32x4*)(P.in[I_GPM] + c), sh = *(const f32x4*)(md + c), sc = *(const f32x4*)(md + 1024 + c);
            const f32x4 h = (v[i] * rs * g) * (sc + 1.0f) + sh; u32x2 w; w.x = cvt_pk_bf16(h[0], h[1]); w.y = cvt_pk_bf16(h[2], h[3]); *(u32x2*)(H + (size_t)r * 1024 + c) = w; }
    }
}

__device__ __forceinline__ int crow(int r, int hi) { return (r & 3) + 8 * (r >> 2) + 4 * hi; }
__device__ void attn_prompt_item(const Params& P, char* lds, int qb, int kv) {
    char* ws = P.ws; bf16_t* MIX = (bf16_t*)(ws + OFF_MIX); const bf16_t* KB = (const bf16_t*)(ws + OFF_KB); const bf16_t* VT = (const bf16_t*)(ws + OFF_VT); float* SSA = (float*)(ws + OFF_SS);
    bf16_t* Ks = (bf16_t*)lds; bf16_t* Vs = (bf16_t*)(lds + 256 * 136 * 2);
    int tid = threadIdx.x; asm volatile("" : "+v"(tid));
    const int wid = tid >> 6, lane = tid & 63; int r32 = lane & 31, hi = lane >> 5;
    const int tbase = 128 * (qb - 1);
#pragma unroll
    for (int i = 0; i < 8; ++i) { const int id = i * 512 + tid, row = id >> 4, c = id & 15; const int t = tbase + row;
        u32x4 v = {0u, 0u, 0u, 0u}; if (t >= 0) v = *(const u32x4*)(KB + (size_t)t * 256 + kv * 128 + c * 8);
        *(u32x4*)(Ks + row * 136 + c * 8) = v; }
#pragma unroll
    for (int i = 0; i < 8; ++i) { const int id = i * 512 + tid, d = id >> 5, c = id & 31; const int t = tbase + c * 8;
        u32x4 v = {0u, 0u, 0u, 0u}; if (t >= 0) v = *(const u32x4*)(VT + (size_t)(kv * 128 + d) * T_ + t);
        u32x2* dst = (u32x2*)(Vs + d * 260 + c * 8); dst[0] = (u32x2){v.x, v.y}; dst[1] = (u32x2){v.z, v.w}; }
    __syncthreads();
#pragma unroll 1
    for (int it = 0; it < 2; ++it) {
        asm volatile("" : "+v"(r32), "+v"(hi));
        const int tile = wid + 8 * it, g = tile >> 2, w4 = tile & 3, head = kv * 4 + g;
        const int trow = 128 * qb + 32 * w4 + r32;
        bf16_t* qp = MIX + (size_t)trow * 2048 + head * 128;
        bf16x8 qr[8];
#pragma unroll
        for (int d0 = 0; d0 < 8; ++d0) qr[d0] = *(const bf16x8*)(qp + d0 * 16 + hi * 8);
        f32x16 p[5];
#pragma unroll
        for (int kt = 0; kt < 5; ++kt) {
            f32x16 a = {};
            const bf16_t* kp = Ks + (32 * (w4 + kt) + r32) * 136 + hi * 8;
#pragma unroll
            for (int d0 = 0; d0 < 8; ++d0) { const bf16x8 kf = *(const bf16x8*)(kp + d0 * 16); a = __builtin_amdgcn_mfma_f32_32x32x16_bf16(kf, qr[d0], a, 0, 0, 0); }
            p[kt] = a;
            EPI_FENCE();
        }
        const float slope2 = __builtin_amdgcn_exp2f(-(float)(head + 1)) * LOG2E_, sink2 = P.in[I_SINK][head] * LOG2E_;
        float mx = sink2;
#pragma unroll
        for (int kt = 0; kt < 5; ++kt)
#pragma unroll
            for (int r = 0; r < 16; ++r) { const int c = crow(r, hi); const int dist = 128 + r32 - 32 * kt - c; const int jb = 32 * (w4 + kt) + c;
                const bool valid = ((unsigned)dist < 128u) && (qb > 0 || jb >= 128);
                const float s = valid ? p[kt][r] - slope2 * (float)dist : -__builtin_inff(); p[kt][r] = s; mx = fmaxf(mx, s); }
        mx = fmaxf(mx, __shfl_xor(mx, 32));
        float l = 0.f;
        u32x4 pb[5][2];
#pragma unroll
        for (int kt = 0; kt < 5; ++kt) {
            float e[16];
#pragma unroll
            for (int r = 0; r < 16; ++r) { e[r] = __builtin_amdgcn_exp2f(p[kt][r] - mx); l += e[r]; }
#pragma unroll
            for (int s2 = 0; s2 < 2; ++s2) { pb[kt][s2].x = cvt_pk_bf16(e[8 * s2 + 0], e[8 * s2 + 1]); pb[kt][s2].y = cvt_pk_bf16(e[8 * s2 + 2], e[8 * s2 + 3]);
                pb[kt][s2].z = cvt_pk_bf16(e[8 * s2 + 4], e[8 * s2 + 5]); pb[kt][s2].w = cvt_pk_bf16(e[8 * s2 + 6], e[8 * s2 + 7]); }
        }
        l += __shfl_xor(l, 32); l += __builtin_amdgcn_exp2f(sink2 - mx);
        EPI_FENCE();
        f32x16 o[4] = {};
#pragma unroll
        for (int kt = 0; kt < 5; ++kt)
#pragma unroll
            for (int s2 = 0; s2 < 2; ++s2) {
                const bf16x8 pf = *reinterpret_cast<const bf16x8*>(&pb[kt][s2]);
#pragma unroll
                for (int db = 0; db < 4; ++db) { const bf16_t* vp = Vs + (32 * db + r32) * 260 + 32 * (w4 + kt) + 16 * s2 + 4 * hi;
                    const u32x2 lo = *(const u32x2*)vp, hh = *(const u32x2*)(vp + 8); u32x4 vw = {lo.x, lo.y, hh.x, hh.y};
                    o[db] = __builtin_amdgcn_mfma_f32_32x32x16_bf16(*reinterpret_cast<const bf16x8*>(&vw), pf, o[db], 0, 0, 0); }
                EPI_FENCE();
            }
        const float inv = 1.0f / l; float ss = 0.f;
#pragma unroll
        for (int db = 0; db < 4; ++db)
#pragma unroll
            for (int r4 = 0; r4 < 4; ++r4) { const float a = o[db][4 * r4] * inv, b = o[db][4 * r4 + 1] * inv, c = o[db][4 * r4 + 2] * inv, d = o[db][4 * r4 + 3] * inv;
                ss += (a * a + b * b) + (c * c + d * d); u32x2 w; w.x = cvt_pk_bf16(a, b); w.y = cvt_pk_bf16(c, d);
                *(u32x2*)(qp + 32 * db + 8 * r4 + 4 * hi) = w; }
        ss += __shfl_xor(ss, 32);
        if (hi == 0) atomicAdd(SSA + trow, ss);
    }
    __syncthreads();
}

__device__ void attn_sample_item(const Params& P, char* lds, int b, int kv) {
    char* ws = P.ws; bf16_t* MIX = (bf16_t*)(ws + OFF_MIX); const bf16_t* KB = (const bf16_t*)(ws + OFF_KB); const bf16_t* VSB = (const bf16_t*)(ws + OFF_VSB); float* SSA = (float*)(ws + OFF_SS);
    float* Kf = (float*)lds; float* Vf = Kf + 128 * 129; float* qs = Vf + 128 * 129; float* ps = qs + 512; float* red = ps + 512;
    int tid = threadIdx.x; asm volatile("" : "+v"(tid));
    const int g = tid >> 7, jd = tid & 127, head = kv * 4 + g;
    bf16_t* qp = MIX + (size_t)(T_ + b) * 2048 + head * 128;
    qs[tid] = bf2f(qp[jd]);
    for (int id = tid; id < 128 * 32; id += 512) { const int j = id >> 5, c4 = (id & 31) * 4; f32x4 kk, vv;
        if (j < 127) { const size_t src = ((size_t)(b * 128 + j + 1) * 2 + kv) * 128 + c4, dst = ((size_t)(b * 128 + j) * 2 + kv) * 128 + c4;
            kk = *(const f32x4*)(P.in[I_CK] + src); vv = *(const f32x4*)(P.in[I_CV] + src);
            *(f32x4*)(P.out + O_KS + dst) = kk; *(f32x4*)(P.out + O_VS + dst) = vv; }
        else { const u32x2 kw = *(const u32x2*)(KB + (size_t)(T_ + b) * 256 + kv * 128 + c4), vw = *(const u32x2*)(VSB + (size_t)b * 256 + kv * 128 + c4);
            kk = (f32x4){bflo(kw.x), bfhi(kw.x), bflo(kw.y), bfhi(kw.y)}; vv = (f32x4){bflo(vw.x), bfhi(vw.x), bflo(vw.y), bfhi(vw.y)};
            const size_t dst = ((size_t)(b * 128 + 127) * 2 + kv) * 128 + c4; *(f32x4*)(P.out + O_KS + dst) = kk; *(f32x4*)(P.out + O_VS + dst) = vv; }
#pragma unroll
        for (int e = 0; e < 4; ++e) { Kf[j * 129 + c4 + e] = kk[e]; Vf[j * 129 + c4 + e] = vv[e]; } }
    __syncthreads();
    const float slope2 = __builtin_amdgcn_exp2f(-(float)(head + 1)) * LOG2E_, sink2 = P.in[I_SINK][head] * LOG2E_;
    float s = 0.f;
    for (int d = 0; d < 128; ++d) s += qs[g * 128 + d] * Kf[jd * 129 + d];
    s -= slope2 * (float)(127 - jd);
    ps[tid] = s;
    __syncthreads();
    float mx = sink2; for (int j = 0; j < 128; ++j) mx = fmaxf(mx, ps[g * 128 + j]);
    const float e = __builtin_amdgcn_exp2f(s - mx);
    __syncthreads();
    ps[tid] = e;
    __syncthreads();
    float l = __builtin_amdgcn_exp2f(sink2 - mx); for (int j = 0; j < 128; ++j) l += ps[g * 128 + j];
    float o = 0.f;
    for (int j = 0; j < 128; ++j) o += ps[g * 128 + j] * Vf[j * 129 + jd];
    o /= l;
    qp[jd] = f2bf(o);
    const float ss = wave_sum(o * o);
    if ((tid & 63) == 0) atomicAdd(SSA + T_ + b, ss);
    (void)red;
    __syncthreads();
}

__device__ void rnn1_item(const Params& P, char* lds, int tile, int nb) {
    char* ws = P.ws; const bool sample = (tile == 128);
    const bf16_t* XR = (const bf16_t*)(ws + OFF_XR); bf16_t* MIX = (bf16_t*)(ws + OFF_MIX); bf16_t* LA = (bf16_t*)(ws + OFF_HM); bf16_t* Ub = (bf16_t*)(ws + OFF_U);
    const float* SP8 = (const float*)(ws + OFF_SP8); float* SSR = (float*)(ws + OFF_SS) + MP_;
    bf16_t* XC = (bf16_t*)lds; bf16_t* WA = XC + 128 * 136; bf16_t* WI = WA + 128 * 136;
    float* As = (float*)lds; float* Us = As + 128 * 129; float* sgA = Us + 128 * 129; float* sgE = sgA + 512;
    int tid = threadIdx.x; asm volatile("" : "+v"(tid));
    const int wid = tid >> 6, lane = tid & 63, fr = lane & 15, fq = lane >> 4;
    const int t0 = tile * 128, ch0 = nb * 128;
#pragma unroll
    for (int i = 0; i < 4; ++i) { const int id = i * 512 + tid, row = id >> 4, c8 = (id & 15) * 8; const int ch = ch0 + c8;
        float xin[4][8];
        if (!sample) {
#pragma unroll
            for (int k = 0; k < 4; ++k) { const int tt = t0 + row - 3 + k; u32x4 v = {0u, 0u, 0u, 0u}; if (tt >= 0) v = *(const u32x4*)(XR + (size_t)tt * 1024 + ch);
                xin[k][0] = bflo(v.x); xin[k][1] = bfhi(v.x); xin[k][2] = bflo(v.y); xin[k][3] = bfhi(v.y); xin[k][4] = bflo(v.z); xin[k][5] = bfhi(v.z); xin[k][6] = bflo(v.w); xin[k][7] = bfhi(v.w); }
        } else {
#pragma unroll
            for (int k = 0; k < 3; ++k) { const float* sp = P.in[I_SC] + (size_t)row * 3072 + k * 1024 + ch; const f32x4 a = *(const f32x4*)sp, b2 = *(const f32x4*)(sp + 4);
                xin[k][0] = a[0]; xin[k][1] = a[1]; xin[k][2] = a[2]; xin[k][3] = a[3]; xin[k][4] = b2[0]; xin[k][5] = b2[1]; xin[k][6] = b2[2]; xin[k][7] = b2[3]; }
            const u32x4 v = *(const u32x4*)(XR + (size_t)(T_ + row) * 1024 + ch);
            { float* oc = P.out + O_CS + (size_t)row * 3072 + 2048 + ch; *(f32x4*)oc = (f32x4){bflo(v.x), bfhi(v.x), bflo(v.y), bfhi(v.y)}; *(f32x4*)(oc + 4) = (f32x4){bflo(v.z), bfhi(v.z), bflo(v.w), bfhi(v.w)}; }
            xin[3][0] = bflo(v.x); xin[3][1] = bfhi(v.x); xin[3][2] = bflo(v.y); xin[3][3] = bfhi(v.y); xin[3][4] = bflo(v.z); xin[3][5] = bfhi(v.z); xin[3][6] = bflo(v.w); xin[3][7] = bfhi(v.w);
        }
        float xc[8];
#pragma unroll
        for (int e = 0; e < 8; ++e) xc[e] = P.in[I_CB][ch + e];
#pragma unroll
        for (int k = 0; k < 4; ++k) { const f32x4 w0 = *(const f32x4*)(P.in[I_CW] + k * 1024 + ch), w1 = *(const f32x4*)(P.in[I_CW] + k * 1024 + ch + 4);
#pragma unroll
            for (int e = 0; e < 4; ++e) { xc[e] += w0[e] * xin[k][e]; xc[4 + e] += w1[e] * xin[k][4 + e]; } }
        u32x4 w; w.x = cvt_pk_bf16(xc[0], xc[1]); w.y = cvt_pk_bf16(xc[2], xc[3]); w.z = cvt_pk_bf16(xc[4], xc[5]); w.w = cvt_pk_bf16(xc[6], xc[7]);
        *(u32x4*)(XC + row * 136 + c8) = w; }
#pragma unroll
    for (int i = 0; i < 4; ++i) { const int id = i * 512 + tid, d = id >> 4, c8 = (id & 15) * 8;
        *(u32x4*)(WA + d * 136 + c8) = *(const u32x4*)((const bf16_t*)(ws + OFF_WT_A) + (size_t)nb * 16384 + d * 128 + c8);
        *(u32x4*)(WI + d * 136 + c8) = *(const u32x4*)((const bf16_t*)(ws + OFF_WT_I) + (size_t)nb * 16384 + d * 128 + c8); }
    __syncthreads();
    const int row = 16 * wid + fr;
    bf16x8 xf[4];
#pragma unroll
    for (int ks = 0; ks < 4; ++ks) xf[ks] = *(const bf16x8*)(XC + row * 136 + 32 * ks + 8 * fq);
    f32x4 aa[8], ai[8]; u32x2 xcw[8];
#pragma unroll
    for (int nt = 0; nt < 8; ++nt) { f32x4 a = {0.f, 0.f, 0.f, 0.f}, b = {0.f, 0.f, 0.f, 0.f};
#pragma unroll
        for (int ks = 0; ks < 4; ++ks) { const bf16x8 wa = *(const bf16x8*)(WA + (16 * nt + fr) * 136 + 32 * ks + 8 * fq), wi = *(const bf16x8*)(WI + (16 * nt + fr) * 136 + 32 * ks + 8 * fq);
            a = __builtin_amdgcn_mfma_f32_16x16x32_bf16(wa, xf[ks], a, 0, 0, 0); b = __builtin_amdgcn_mfma_f32_16x16x32_bf16(wi, xf[ks], b, 0, 0, 0); }
        aa[nt] = a; ai[nt] = b; xcw[nt] = *(const u32x2*)(XC + row * 136 + 16 * nt + 4 * fq); }
    __syncthreads();
    float ssr = 0.f;
#pragma unroll
    for (int nt = 0; nt < 8; ++nt) { const int d = 16 * nt + 4 * fq, ch = ch0 + d;
        const f32x4 ba = *(const f32x4*)(P.in[I_BA] + ch), bi = *(const f32x4*)(P.in[I_BI] + ch), sp = *(const f32x4*)(SP8 + ch);
        const float xv[4] = {bflo(xcw[nt].x), bfhi(xcw[nt].x), bflo(xcw[nt].y), bfhi(xcw[nt].y)};
        float la[4], uu[4], av[4];
#pragma unroll
        for (int e = 0; e < 4; ++e) { const float r = sigmoid_f(aa[nt][e] + ba[e]), ig = sigmoid_f(ai[nt][e] + bi[e]);
            la[e] = -r * sp[e]; av[e] = __expf(la[e]); uu[e] = sqrtf(fmaxf(-expm1f(2.0f * la[e]), 0.f)) * (ig * xv[e]); }
        if (!sample) {
#pragma unroll
            for (int e = 0; e < 4; ++e) { As[row * 129 + d + e] = av[e]; Us[row * 129 + d + e] = uu[e]; }
            u32x2 w; w.x = cvt_pk_bf16(la[0], la[1]); w.y = cvt_pk_bf16(la[2], la[3]); *(u32x2*)(LA + (size_t)(t0 + row) * 1024 + ch) = w;
            w.x = cvt_pk_bf16(uu[0], uu[1]); w.y = cvt_pk_bf16(uu[2], uu[3]); *(u32x2*)(Ub + (size_t)(t0 + row) * 1024 + ch) = w;
        } else {
            const f32x4 h0 = *(const f32x4*)(P.in[I_SH] + (size_t)row * 1024 + ch);
            bf16_t* gp = MIX + (size_t)(T_ + row) * 2048 + 1024 + ch; const u32x2 gw = *(const u32x2*)gp; const float gy[4] = {bflo(gw.x), bfhi(gw.x), bflo(gw.y), bfhi(gw.y)};
            f32x4 h; float rn[4];
#pragma unroll
            for (int e = 0; e < 4; ++e) { h[e] = av[e] * h0[e] + uu[e]; rn[e] = h[e] * gy[e]; ssr += rn[e] * rn[e]; }
            *(f32x4*)(P.out + O_HS + (size_t)row * 1024 + ch) = h;
            u32x2 w; w.x = cvt_pk_bf16(rn[0], rn[1]); w.y = cvt_pk_bf16(rn[2], rn[3]); *(u32x2*)gp = w;
        } }
    if (sample) { ssr += __shfl_xor(ssr, 16); ssr += __shfl_xor(ssr, 32); if (fq == 0) atomicAdd(SSR + T_ + row, ssr); __syncthreads(); return; }
    __syncthreads();
    { const int s = tid >> 7, c = tid & 127; float A = 1.f, E = 0.f;
#pragma unroll 8
      for (int j = 0; j < 32; ++j) { const float a = As[(32 * s + j) * 129 + c], u = Us[(32 * s + j) * 129 + c]; E = a * E + u; A *= a; }
      ((float*)(ws + OFF_SEGA))[(size_t)(tile * 4 + s) * 1024 + ch0 + c] = A; ((float*)(ws + OFF_SEGE))[(size_t)(tile * 4 + s) * 1024 + ch0 + c] = E;
      sgA[tid] = A; sgE[tid] = E; }
    __syncthreads();
    if (tid < 128) { float A = 1.f, E = 0.f;
#pragma unroll
        for (int s = 0; s < 4; ++s) { const float a = sgA[s * 128 + tid], e = sgE[s * 128 + tid]; E = a * E + e; A *= a; }
        ((float*)(ws + OFF_TILEA))[(size_t)tile * 1024 + ch0 + tid] = A; ((float*)(ws + OFF_TILEE))[(size_t)tile * 1024 + ch0 + tid] = E; }
    __syncthreads();
}

__device__ void rnn2_item(const Params& P, char* lds, int tile, int nb) {
    char* ws = P.ws; bf16_t* MIX = (bf16_t*)(ws + OFF_MIX); const bf16_t* LA = (const bf16_t*)(ws + OFF_HM); const bf16_t* Ub = (const bf16_t*)(ws + OFF_U);
    const float* SEGA = (const float*)(ws + OFF_SEGA); const float* SEGE = (const float*)(ws + OFF_SEGE); const float* TA = (const float*)(ws + OFF_TILEA); const float* TE = (const float*)(ws + OFF_TILEE);
    float* SSR = (float*)(ws + OFF_SS) + MP_;
    float* pa = (float*)lds; float* pe = pa + 512;
    int tid = threadIdx.x; asm volatile("" : "+v"(tid));
    const int s = tid >> 7, c = tid & 127, ch = nb * 128 + c, lane = tid & 63;
    { float A = 1.f, E = 0.f; const int lo = s * 32, hi = min(lo + 32, tile);
      for (int k = lo; k < hi; ++k) { const float a = TA[(size_t)k * 1024 + ch], e = TE[(size_t)k * 1024 + ch]; E = a * E + e; A *= a; }
      pa[tid] = A; pe[tid] = E; }
    __syncthreads();
    float h = 0.f;
#pragma unroll
    for (int q = 0; q < 4; ++q) h = pa[q * 128 + c] * h + pe[q * 128 + c];
    for (int s2 = 0; s2 < s; ++s2) h = SEGA[(size_t)(tile * 4 + s2) * 1024 + ch] * h + SEGE[(size_t)(tile * 4 + s2) * 1024 + ch];
    const int tb = tile * 128 + 32 * s;
#pragma unroll 4
    for (int j = 0; j < 32; ++j) { const int t = tb + j;
        const float la = bf2f(LA[(size_t)t * 1024 + ch]), u = bf2f(Ub[(size_t)t * 1024 + ch]); bf16_t* gp = MIX + (size_t)t * 2048 + 1024 + ch; const float gy = bf2f(*gp);
        h = __expf(la) * h + u; const float rn = h * gy; *gp = f2bf(rn);
        const float sq = wave_sum(rn * rn); if (lane == 0) atomicAdd(SSR + t, sq); }
    if (tile == 127 && s == 3) P.out[O_HP + ch] = h;
    __syncthreads();
}

__device__ void state_out_prompt(const Params& P) {
    char* ws = P.ws; const bf16_t* KB = (const bf16_t*)(ws + OFF_KB); const bf16_t* VT = (const bf16_t*)(ws + OFF_VT); const bf16_t* XR = (const bf16_t*)(ws + OFF_XR);
    int tid = threadIdx.x; asm volatile("" : "+v"(tid));
    const size_t gt = (size_t)blockIdx.x * 512 + tid, gs = (size_t)gridDim.x * 512;
    for (size_t i = gt; i < 32768; i += gs) { const int j = (int)(i >> 8), c = (int)(i & 255);
        P.out[O_KP + i] = bf2f(KB[(size_t)(T_ - 128 + j) * 256 + c]); P.out[O_VP + i] = bf2f(VT[(size_t)c * T_ + (T_ - 128 + j)]); }
    for (size_t i = gt; i < 3072; i += gs) P.out[O_CP + i] = bf2f(XR[(size_t)(T_ - 3) * 1024 + i]);
}

__device__ void phase7(const Params& P) {
    int tid = threadIdx.x; asm volatile("" : "+v"(tid));
    char* ws = P.ws; const int wid = tid >> 6, lane = tid & 63; const float* MOD = (const float*)(ws + OFF_MOD);
    const bf16_t* O = (const bf16_t*)(ws + OFF_XR); bf16_t* H = (bf16_t*)(ws + OFF_HM); const float* SSO = (const float*)(ws + OFF_SS) + 2 * MP_;
    for (int r = blockIdx.x * 8 + wid; r < MP_; r += gridDim.x * 8) {
        if (r >= MR_) { for (int i = 0; i < 4; ++i) *(u32x2*)(H + (size_t)r * 1024 + i * 256 + lane * 4) = (u32x2){0u, 0u}; continue; }
        const float* x = r < T_ ? P.in[I_XP] + (size_t)r * 1024 : P.in[I_XS] + (size_t)(r - T_) * 1024; const float* md = MOD + (size_t)modrow(r) * 6144;
        const float rso = rsqrtf(SSO[r] * (1.0f / 1024.0f) + EPS_);
        f32x4 v[4]; float ss = 0.f;
#pragma unroll
        for (int i = 0; i < 4; ++i) { const int c = i * 256 + lane * 4; const f32x4 xv = *(const f32x4*)(x + c); const u32x2 ow = *(const u32x2*)(O + (size_t)r * 1024 + c);
            const f32x4 ov = {bflo(ow.x), bfhi(ow.x), bflo(ow.y), bfhi(ow.y)}; const f32x4 g1 = *(const f32x4*)(md + 2048 + c), gp = *(const f32x4*)(P.in[I_GPOM] + c);
            v[i] = xv + g1 * ((ov * rso) * gp); ss += (v[i][0] * v[i][0] + v[i][1] * v[i][1]) + (v[i][2] * v[i][2] + v[i][3] * v[i][3]); }
        ss = wave_sum(ss); const float rs = rsqrtf(ss * (1.0f / 1024.0f) + EPS_);
#pragma unroll
        for (int i = 0; i < 4; ++i) { const int c = i * 256 + lane * 4; const f32x4 g = *(const f32x4*)(P.in[I_GPF] + c), sh = *(const f32x4*)(md + 3072 + c), sc = *(const f32x4*)(md + 4096 + c);
            const f32x4 h = (v[i] * rs * g) * (sc + 1.0f) + sh; u32x2 w; w.x = cvt_pk_bf16(h[0], h[1]); w.y = cvt_pk_bf16(h[2], h[3]); *(u32x2*)(H + (size_t)r * 1024 + c) = w; }
    }
}

__device__ void phase10(const Params& P) {
    int tid = threadIdx.x; asm volatile("" : "+v"(tid));
    char* ws = P.ws; const int wid = tid >> 6, lane = tid & 63; const float* MOD = (const float*)(ws + OFF_MOD);
    const bf16_t* O = (const bf16_t*)(ws + OFF_XR); const bf16_t* F = (const bf16_t*)(ws + OFF_HM); const float* SSO = (const float*)(ws + OFF_SS) + 2 * MP_; const float* SSF = (const float*)(ws + OFF_SS) + 3 * MP_;
    for (int r = blockIdx.x * 8 + wid; r < MR_; r += gridDim.x * 8) {
        const float* x = r < T_ ? P.in[I_XP] + (size_t)r * 1024 : P.in[I_XS] + (size_t)(r - T_) * 1024; const float* md = MOD + (size_t)modrow(r) * 6144;
        float* y = r < T_ ? P.out + O_YP + (size_t)r * 1024 : P.out + O_YS + (size_t)(r - T_) * 1024;
        const float rso = rsqrtf(SSO[r] * (1.0f / 1024.0f) + EPS_), rsf = rsqrtf(SSF[r] * (1.0f / 1024.0f) + EPS_);
#pragma unroll
        for (int i = 0; i < 4; ++i) { const int c = i * 256 + lane * 4; const f32x4 xv = *(const f32x4*)(x + c); const u32x2 ow = *(const u32x2*)(O + (size_t)r * 1024 + c), fw = *(const u32x2*)(F + (size_t)r * 1024 + c);
            const f32x4 ov = {bflo(ow.x), bfhi(ow.x), bflo(ow.y), bfhi(ow.y)}, fv = {bflo(fw.x), bfhi(fw.x), bflo(fw.y), bfhi(fw.y)};
            const f32x4 g1 = *(const f32x4*)(md + 2048 + c), gp = *(const f32x4*)(P.in[I_GPOM] + c), g2 = *(const f32x4*)(md + 5120 + c), gf = *(const f32x4*)(P.in[I_GPOF] + c);
            const f32x4 x1 = xv + g1 * ((ov * rso) * gp);
            *(f32x4*)(y + c) = x1 + g2 * ((fv * rsf) * gf); }
    }
}

template <bool COOP>
__global__ void __launch_bounds__(512) hymba_mega(Params P, int ph_lo, int ph_hi) {
    extern __shared__ __attribute__((aligned(16))) char lds_raw[];
    LAS unsigned char* lds = (LAS unsigned char*)lds_raw;
    char* ws = P.ws; const int G = gridDim.x, bid = blockIdx.x;
    for (int ph = ph_lo; ph < ph_hi; ++ph) {
        switch (ph) {
        case 0: if constexpr (PH_ON(0)) phase0(P, (float*)lds_raw); break;
        case 1: if constexpr (PH_ON(1)) phase1(P, lds, (float*)lds_raw); break;
        case 2: if constexpr (PH_ON(2)) phase2(P); break;
        case 3: if constexpr (PH_ON(3)) { Gemm g{(const bf16_t*)(ws + OFF_HM), (const bf16_t*)(ws + OFF_WT_IN), 1024}; Sched S; S.init(65, 14, G, bid);
                  Epi1 E{(bf16_t*)(ws + OFF_MIX), (bf16_t*)(ws + OFF_KB), (bf16_t*)(ws + OFF_VT), (bf16_t*)(ws + OFF_VSB), (bf16_t*)(ws + OFF_XR)};
                  gemm_phase<Epi1, false, false>(lds, g, S, E); } break;
        case 4: if constexpr (PH_ON(4)) { if (P4B(0)) for (int it = bid; it < 256; it += G) attn_prompt_item(P, lds_raw, it >> 1, it & 1);
                  if (P4B(1)) for (int it = bid; it < 256; it += G) attn_sample_item(P, lds_raw, it >> 1, it & 1);
                  if (P4B(2)) for (int it = bid; it < 129 * 8; it += G) rnn1_item(P, lds_raw, it >> 3, it & 7);
                  state_out_prompt(P); } break;
        case 5: if constexpr (PH_ON(5)) { for (int it = bid; it < 128 * 8; it += G) rnn2_item(P, lds_raw, it >> 3, it & 7); } break;
        case 6: if constexpr (PH_ON(6)) { Gemm g{(const bf16_t*)(ws + OFF_MIX), (const bf16_t*)(ws + OFF_WT_OUT), 2048}; Sched S; S.init(65, 4, G, bid);
                  Epi2 E{(bf16_t*)(ws + OFF_XR), (const float*)(ws + OFF_SS), (const float*)(ws + OFF_SS) + MP_, (float*)(ws + OFF_SS) + 2 * MP_};
                  gemm_phase<Epi2, false, true>(lds, g, S, E); } break;
        case 7: if constexpr (PH_ON(7)) phase7(P); break;
        case 8: if constexpr (PH_ON(8)) { Gemm g{(const bf16_t*)(ws + OFF_HM), (const bf16_t*)(ws + OFF_WT_UP), 1024}; Sched S; S.init(67, 22, G, bid);
                  Epi3 E{(bf16_t*)(ws + OFF_MIX), P.in[I_FCW], P.in[I_FCB], P.in[I_SF], P.out};
                  gemm_phase<Epi3, true, false>(lds, g, S, E); } break;
        case 9: if constexpr (PH_ON(9)) { Gemm g{(const bf16_t*)(ws + OFF_MIX), (const bf16_t*)(ws + OFF_WT_DOWN), 2816}; Sched S; S.init(65, 4, G, bid);
                  Epi4 E{(bf16_t*)(ws + OFF_HM), (float*)(ws + OFF_SS) + 3 * MP_};
                  gemm_phase<Epi4, false, false>(lds, g, S, E); } break;
        case 10: if constexpr (PH_ON(10)) phase10(P); break;
        }
        if (COOP) { if (ph + 1 < ph_hi) { __threadfence(); cg::this_grid().sync(); } }
    }
}

extern "C" void kernel_launch(void* const* d_in, const int* in_sizes, int n_in, void* d_out, int out_size, void* d_ws, size_t ws_size, hipStream_t stream) {
    (void)in_sizes; (void)out_size;
    if (n_in != 31 || ws_size < WS_NEED) { fprintf(stderr, "hymba_mega: bad arguments (n_in %d, ws %zu < %zu)\n", n_in, ws_size, (size_t)WS_NEED); return; }
    Params P{};
    for (int i = 0; i < 31; ++i) P.in[i] = (const float*)d_in[i];
    P.out = (float*)d_out; P.ws = (char*)d_ws;
#if MK_COOP
    static int grid_blocks = 0;
    if (!grid_blocks) {
        hipFuncSetAttribute((const void*)hymba_mega<true>, hipFuncAttributeMaxDynamicSharedMemorySize, LDS_BYTES);
        int dev = 0, cus = 0, per_cu = 0; hipGetDevice(&dev); hipDeviceGetAttribute(&cus, hipDeviceAttributeMultiprocessorCount, dev);
        hipOccupancyMaxActiveBlocksPerMultiprocessor(&per_cu, (const void*)hymba_mega<true>, 512, LDS_BYTES);
        if (per_cu < 1) per_cu = 1; if (per_cu > 1) per_cu = 1;
        grid_blocks = cus * per_cu;
    }
    int lo = 0, hi = 11; void* args[] = {&P, &lo, &hi};
    hipError_t e = hipLaunchCooperativeKernel((const void*)hymba_mega<true>, dim3(grid_blocks), dim3(512), args, LDS_BYTES, stream);
    if (e != hipSuccess) fprintf(stderr, "cooperative launch failed: %s (grid %d)\n", hipGetErrorString(e), grid_blocks);
#else
    static bool attr = false;
    if (!attr) { attr = true; hipFuncSetAttribute((const void*)hymba_mega<false>, hipFuncAttributeMaxDynamicSharedMemorySize, LDS_BYTES); }
    for (int ph = 0; ph < 11; ++ph) hymba_mega<false><<<dim3(256), dim3(512), LDS_BYTES, stream>>>(P, ph, ph + 1);
#endif
}
```

```cpp
#include <hip/hip_runtime.h>
#include <hip/hip_cooperative_groups.h>
#include <cstdio>
#include <cstdint>
namespace cg = cooperative_groups;

#ifndef MK_COOP
#define MK_COOP 1
#endif
#ifndef MK_PROBE
#define MK_PROBE 0
#endif
#ifndef MK_PROBE_ID
#define MK_PROBE_ID 0
#endif
#if MK_PROBE_ID
#define PB_BEGIN(id) unsigned long long _pb##id = 0; if (((MK_PROBE_ID) >> (id)) & 1) _pb##id = __builtin_amdgcn_s_memrealtime()
#define PB_END(id) if (((MK_PROBE_ID) >> (id)) & 1) tacc2 += __builtin_amdgcn_s_memrealtime() - _pb##id
#else
#define PB_BEGIN(id)
#define PB_END(id)
#endif
#ifndef MK_PHMASK
#define MK_PHMASK 0x7ff
#endif
#define PH_ON(x) (((MK_PHMASK) >> (x)) & 1)

#define LAS __attribute__((address_space(3)))
typedef unsigned short bf16_t;
typedef short bf16x8 __attribute__((ext_vector_type(8)));
typedef short s16x4 __attribute__((ext_vector_type(4)));
typedef float f32x4 __attribute__((ext_vector_type(4)));
typedef float f32x16 __attribute__((ext_vector_type(16)));
typedef unsigned u32x4 __attribute__((ext_vector_type(4)));
typedef unsigned u32x2 __attribute__((ext_vector_type(2)));

constexpr int T_ = 16384, SB_ = 128, MR_ = 16512, MP_ = 16640;
constexpr float EPS_ = 1e-6f;
constexpr float LOG2E_ = 1.4426950408889634f;
constexpr float QSCALE_ = 0.08838834764831845f * 1.4426950408889634f;
constexpr int LDS_BYTES = 140288;

constexpr size_t OFF_WT_ADA = 0;
constexpr size_t OFF_A_ADA = OFF_WT_ADA + (size_t)6144 * 1024 * 2;
constexpr size_t OFF_MOD = OFF_A_ADA + (size_t)256 * 1024 * 2;
constexpr size_t OFF_WT_IN = OFF_MOD + (size_t)256 * 6144 * 4;
constexpr size_t OFF_WT_OUT = OFF_WT_IN + (size_t)3584 * 1024 * 2;
constexpr size_t OFF_WT_UP = OFF_WT_OUT + (size_t)1024 * 2048 * 2;
constexpr size_t OFF_WT_DOWN = OFF_WT_UP + (size_t)5632 * 1024 * 2;
constexpr size_t OFF_WT_A = OFF_WT_DOWN + (size_t)1024 * 2816 * 2;
constexpr size_t OFF_WT_I = OFF_WT_A + (size_t)8 * 128 * 128 * 2;
constexpr size_t OFF_SP8 = OFF_WT_I + (size_t)8 * 128 * 128 * 2;
constexpr size_t OFF_SS = OFF_SP8 + 4096;
constexpr size_t OFF_SEGA = OFF_SS + (size_t)4 * MP_ * 4;
constexpr size_t OFF_SEGE = OFF_SEGA + (size_t)512 * 1024 * 4;
constexpr size_t OFF_TILEA = OFF_SEGE + (size_t)512 * 1024 * 4;
constexpr size_t OFF_TILEE = OFF_TILEA + (size_t)128 * 1024 * 4;
constexpr size_t OFF_VSB = OFF_TILEE + (size_t)128 * 1024 * 4;
constexpr size_t OFF_OS2 = OFF_VSB + (size_t)256 * 256 * 2;
constexpr size_t OFF_OS4 = OFF_OS2 + (size_t)8 * 128 * 1024 * 4;
constexpr size_t OFF_BAR = OFF_OS4 + (size_t)8 * 128 * 1024 * 4;
constexpr size_t OFF_MIX = OFF_BAR + 16384;
constexpr size_t OFF_U = OFF_MIX + (size_t)MP_ * 2048 * 2;
constexpr size_t OFF_KB = OFF_U + (size_t)MP_ * 1024 * 2;
constexpr size_t OFF_VT = OFF_KB + (size_t)MP_ * 256 * 2;
constexpr size_t OFF_XR = OFF_VT + (size_t)256 * T_ * 2;
constexpr size_t OFF_HM0 = OFF_XR + (size_t)MP_ * 1024 * 2;
constexpr size_t OFF_HM = OFF_HM0 + 4096;
constexpr size_t WS_NEED = OFF_HM + (size_t)MP_ * 1024 * 2;
static_assert(WS_NEED <= (size_t)256 * 1024 * 1024, "workspace");
static_assert(OFF_MIX + (size_t)MP_ * 2816 * 2 <= OFF_KB, "FIN alias");

constexpr size_t O_YP = 0, O_YS = O_YP + (size_t)T_ * 1024, O_KP = O_YS + 128 * 1024, O_VP = O_KP + 32768, O_HP = O_VP + 32768,
                 O_CP = O_HP + 1024, O_FP = O_CP + 3072, O_KS = O_FP + 11264, O_VS = O_KS + 4194304, O_HS = O_VS + 4194304,
                 O_CS = O_HS + 131072, O_FS = O_CS + 393216;

struct Params { const float* in[31]; float* out; char* ws; };
enum { I_XP = 0, I_XS, I_CK, I_CV, I_SH, I_SC, I_SF, I_CP, I_CS, I_WADA, I_BADA, I_GPM, I_WIN, I_CW, I_CB, I_WA, I_BA, I_WI, I_BI, I_LAM, I_SINK,
       I_GAO, I_GRO, I_WOUT, I_GPOM, I_GPF, I_WUP, I_FCW, I_FCB, I_WDOWN, I_GPOF };

__device__ __forceinline__ unsigned cvt_pk_bf16(float lo, float hi) { unsigned r; asm volatile("v_cvt_pk_bf16_f32 %0, %1, %2" : "=v"(r) : "v"(lo), "v"(hi)); return r; }
__device__ __forceinline__ float bf2f(unsigned b) { return __uint_as_float(b << 16); }
__device__ __forceinline__ float bflo(unsigned w) { return __uint_as_float(w << 16); }
__device__ __forceinline__ float bfhi(unsigned w) { return __uint_as_float(w & 0xffff0000u); }
__device__ __forceinline__ bf16_t f2bf(float f) { return (bf16_t)(cvt_pk_bf16(f, 0.f) & 0xffffu); }
__device__ __forceinline__ float gelu_t(float x) { const float u = x * (1.0f + 0.044715f * x * x); const float e = __builtin_amdgcn_exp2f(-2.302208198f * u); return x * __builtin_amdgcn_rcpf(1.0f + e); }
__device__ __forceinline__ float sigmoid_f(float x) { return __builtin_amdgcn_rcpf(1.0f + __builtin_amdgcn_exp2f(-LOG2E_ * x)); }
__device__ __forceinline__ float wave_sum(float v) { v += __shfl_xor(v, 1); v += __shfl_xor(v, 2); v += __shfl_xor(v, 4); v += __shfl_xor(v, 8); v += __shfl_xor(v, 16); v += __shfl_xor(v, 32); return v; }
__device__ __forceinline__ int modrow(int r) { return r < T_ ? 0 : r - T_ + 1; }

constexpr int BM = 256, BK = 64, HALF = 128, HTB = HALF * BK * 2, STAGE_BYTES = 8 * HTB, NXCD = 8, WGM = 8;
__device__ __forceinline__ int lds_byte(int r, int c) { const int st = (r >> 4) * 2 + (c >> 5), rr = r & 15, cc = c & 31, ob = rr * 64 + cc * 2; return st * 1024 + (ob ^ (((ob >> 9) & 1) << 5)); }
__device__ __forceinline__ void stage_rc(int b, int& R, int& C) { const int st = b / 1024, sb = b % 1024, swz = sb ^ (((sb >> 9) & 1) << 5); R = (st >> 1) * 16 + swz / 64; C = (st & 1) * 32 + (swz % 64) / 2; }
struct Unit { int pm, pn; };
struct Gemm { const bf16_t* A; const bf16_t* Bt; int K; };
struct Sched {
    int nM, nN, nwg, G, c;
    __device__ void init(int nM_, int nN_, int G_, int c_) { nM = nM_; nN = nN_; nwg = nM * nN; G = G_; c = c_; }
    __device__ bool next(int i, Unit& u) const {
        const long L = (long)i * G + c; if (L >= nwg) return false;
        int wgid = (int)L; { const int q = nwg / NXCD, r = nwg % NXCD, xcd = wgid % NXCD, off = wgid / NXCD; wgid = (xcd < r ? xcd * (q + 1) : r * (q + 1) + (xcd - r) * q) + off; }
        const int nig = WGM * nN, gid = wgid / nig, fm = gid * WGM, gsz = (nM - fm) < WGM ? (nM - fm) : WGM;
        u.pm = fm + ((wgid % nig) % gsz); u.pn = (wgid % nig) / gsz; return true;
    }
};
template <bool APERM> __device__ __forceinline__ size_t tileA_off(int pm, int K) {
    if (APERM) return (size_t)(pm < 66 ? 252 * pm : 16386) * (size_t)K * 2 - (size_t)2 * K * 2;
    return (size_t)pm * 256 * (size_t)K * 2;
}

template <class Epi, bool APERM, bool MID>
__device__ __forceinline__ void gemm_phase(LAS unsigned char* lds, const Gemm g, const Sched& S, const Epi& E) {
    int tid = threadIdx.x; asm volatile("" : "+v"(tid));
    const int wid = __builtin_amdgcn_readfirstlane(tid >> 6), lane = tid & 63, wr = wid >> 2, wc = wid & 3, fr = lane & 15, fq = lane >> 4;
    const int K = g.K, nt = K / BK;
    unsigned voffA[2], voffB[2];
#pragma unroll
    for (int i = 0; i < 2; ++i) { int R, C; stage_rc(tid * 16 + i * 8192, R, C);
        const int Ra = APERM ? (126 * (R >> 6) + 8 * (R & 15) + ((R >> 4) & 3)) : R;
        voffA[i] = (unsigned)(Ra * K + C) * 2u; voffB[i] = (unsigned)(R * K + C) * 2u; }
    const size_t kstep = (size_t)(BK * 2);
    const size_t hstepB = (size_t)HALF * K * 2;
    const size_t hstepA = APERM ? (size_t)4 * K * 2 : hstepB;
    const size_t tstepB = 2 * hstepB;
    const unsigned ldsw = (unsigned)wid * 1024u;
    const int aoff = lds_byte(wr * 64 + fr, fq * 8), boff = lds_byte(wc * 32 + fr, fq * 8);
#define PG8_SA(b, h) (((b) * 2 + (h)) * HTB)
#define PG8_SB(b, h) ((4 + (b) * 2 + (h)) * HTB)
#define PG8_STAGE(bufoff, gbase, voff) do { _Pragma("unroll") for (int _i = 0; _i < 2; ++_i) \
        __builtin_amdgcn_global_load_lds((const unsigned*)((const char*)(gbase) + (voff)[_i]), (LAS unsigned*)(lds + (bufoff) + ldsw + _i * 8192), 16, 0, 0); } while (0)
#define PG8_LDA(dst, b, h) do { _Pragma("unroll") for (int m = 0; m < 4; ++m) _Pragma("unroll") for (int k = 0; k < 2; ++k) dst[m][k] = *(const LAS bf16x8*)(lds + PG8_SA(b, h) + aoff + m * 2048 + k * 1024); } while (0)
#define PG8_LDB(dst, b, h) do { _Pragma("unroll") for (int n = 0; n < 2; ++n) _Pragma("unroll") for (int k = 0; k < 2; ++k) dst[n][k] = *(const LAS bf16x8*)(lds + PG8_SB(b, h) + boff + n * 2048 + k * 1024); } while (0)
#define PG8_MMA(ai, bj, At, Bt) do { __builtin_amdgcn_s_setprio(1); _Pragma("unroll") for (int m = 0; m < 4; ++m) _Pragma("unroll") for (int n = 0; n < 2; ++n) _Pragma("unroll") for (int k = 0; k < 2; ++k) \
        acc[ai][bj][m][n] = __builtin_amdgcn_mfma_f32_16x16x32_bf16(Bt[n][k], At[m][k], acc[ai][bj][m][n], 0, 0, 0); __builtin_amdgcn_s_setprio(0); } while (0)
#define PG8_WAIT_V(n) asm volatile("s_waitcnt vmcnt(" #n ")" ::: "memory")
#define PG8_WAIT_L(n) asm volatile("s_waitcnt lgkmcnt(" #n ")" ::: "memory")
#define PG8_BAR __builtin_amdgcn_s_barrier()
#define PG8_SCHED __builtin_amdgcn_sched_barrier(0)
    Unit cur, nxt; int ui = 0;
    if (!S.next(0, cur)) return;
    f32x4 acc[2][2][4][2];
#pragma unroll
    for (int a = 0; a < 2; ++a)
#pragma unroll
        for (int b = 0; b < 2; ++b)
#pragma unroll
            for (int m = 0; m < 4; ++m)
#pragma unroll
                for (int n = 0; n < 2; ++n) acc[a][b][m][n] = (f32x4){0.f, 0.f, 0.f, 0.f};
    bf16x8 At[4][2], B0[2][2], B1[2][2];
    const char* cA = (const char*)g.A + tileA_off<APERM>(cur.pm, K); const char* cB = (const char*)g.Bt + (size_t)cur.pn * tstepB;
    PG8_STAGE(PG8_SB(0, 0), cB, voffB); PG8_STAGE(PG8_SA(0, 0), cA, voffA); PG8_STAGE(PG8_SB(0, 1), cB + hstepB, voffB); PG8_STAGE(PG8_SA(0, 1), cA + hstepA, voffA);
    if (wr == 1) PG8_BAR;
    PG8_WAIT_V(4); PG8_BAR;
    PG8_STAGE(PG8_SB(1, 0), cB + kstep, voffB); PG8_STAGE(PG8_SA(1, 0), cA + kstep, voffA); PG8_STAGE(PG8_SB(1, 1), cB + hstepB + kstep, voffB);
    PG8_WAIT_V(6); PG8_BAR;
    for (;;) {
        const bool has_next = S.next(ui + 1, nxt);
        const char* nA = has_next ? (const char*)g.A + tileA_off<APERM>(nxt.pm, K) : cA; const char* nB = has_next ? (const char*)g.Bt + (size_t)nxt.pn * tstepB : cB;
        for (int t = 0; t < nt; t += 2) {
            const bool last = (t == nt - 2);
            const char* a1 = cA + (size_t)(t + 1) * kstep;
            const char* a2 = last ? nA : cA + (size_t)(t + 2) * kstep; const char* b2 = last ? nB : cB + (size_t)(t + 2) * kstep;
            const char* a3 = a2 + kstep; const char* b3 = b2 + kstep;
            if constexpr (MID) { if (t == (nt >> 1)) E.mid(acc, cur, wr, fr); }
            PG8_LDB(B0, 0, 0); PG8_SCHED; PG8_LDA(At, 0, 0); PG8_STAGE(PG8_SA(1, 1), a1 + hstepA, voffA);
            PG8_WAIT_L(8); PG8_BAR; PG8_WAIT_L(0); PG8_MMA(0, 0, At, B0); PG8_BAR; PG8_SCHED;
            PG8_LDB(B1, 0, 1); PG8_STAGE(PG8_SB(0, 0), b2, voffB);
            PG8_BAR; PG8_WAIT_L(0); PG8_MMA(0, 1, At, B1); PG8_BAR;
            PG8_LDA(At, 0, 1); PG8_STAGE(PG8_SA(0, 0), a2, voffA);
            PG8_BAR; PG8_WAIT_L(0); PG8_MMA(1, 0, At, B0); PG8_BAR; PG8_SCHED;
            PG8_STAGE(PG8_SB(0, 1), b2 + hstepB, voffB);
            PG8_WAIT_V(6); PG8_BAR; PG8_MMA(1, 1, At, B1); PG8_BAR;
            PG8_LDB(B0, 1, 0); PG8_SCHED; PG8_LDA(At, 1, 0); PG8_STAGE(PG8_SA(0, 1), a2 + hstepA, voffA);
            PG8_WAIT_L(8); PG8_BAR; PG8_WAIT_L(0); PG8_MMA(0, 0, At, B0); PG8_BAR; PG8_SCHED;
            PG8_LDB(B1, 1, 1); PG8_STAGE(PG8_SB(1, 0), b3, voffB);
            PG8_BAR; PG8_WAIT_L(0); PG8_MMA(0, 1, At, B1); PG8_BAR;
            PG8_LDA(At, 1, 1); PG8_STAGE(PG8_SA(1, 0), a3, voffA);
            PG8_BAR; PG8_WAIT_L(0); PG8_MMA(1, 0, At, B0); PG8_BAR; PG8_SCHED;
            PG8_STAGE(PG8_SB(1, 1), b3 + hstepB, voffB);
            PG8_WAIT_V(6); PG8_BAR; PG8_MMA(1, 1, At, B1); PG8_BAR;
        }
        E(acc, cur, wr, wc, fr, fq);
        if (!has_next) break;
#pragma unroll
        for (int a = 0; a < 2; ++a)
#pragma unroll
            for (int b = 0; b < 2; ++b)
#pragma unroll
                for (int m = 0; m < 4; ++m)
#pragma unroll
                    for (int n = 0; n < 2; ++n) acc[a][b][m][n] = (f32x4){0.f, 0.f, 0.f, 0.f};
        cur = nxt; cA = nA; cB = nB; ++ui;
    }
    PG8_WAIT_V(0);
    if (wr == 0) PG8_BAR;
    PG8_BAR;
#undef PG8_SA
#undef PG8_SB
#undef PG8_STAGE
#undef PG8_LDA
#undef PG8_LDB
#undef PG8_MMA
#undef PG8_WAIT_V
#undef PG8_WAIT_L
#undef PG8_BAR
#undef PG8_SCHED
}

typedef f32x4 AccT[2][2][4][2];

#ifndef E1MASK
#define E1MASK 31
#endif
#define E1B(x) (((E1MASK) >> (x)) & 1)
#ifndef P4MASK
#define P4MASK 7
#endif
#define P4B(x) (((P4MASK) >> (x)) & 1)
#define EPI_FENCE() asm volatile("" ::: "memory")
__device__ __forceinline__ u32x2 pk4(const f32x4 v) { u32x2 w; w.x = cvt_pk_bf16(v[0], v[1]); w.y = cvt_pk_bf16(v[2], v[3]); return w; }

struct EpiAda {
    float* C; const float* bias;
    __device__ __forceinline__ void operator()(const AccT& acc, const Unit& u, int wr, int wc, int fr, int fq) const {
        const int col0 = u.pn * BM + wc * 32 + 4 * fq;
        float* base = C + (size_t)(u.pm * BM + wr * 64 + fr) * 6144 + col0; const float* bp = bias + col0;
#pragma unroll
        for (int bj = 0; bj < 2; ++bj)
#pragma unroll
            for (int n = 0; n < 2; ++n) { const f32x4 bv = *(const f32x4*)(bp + bj * HALF + n * 16);
#pragma unroll
                for (int ai = 0; ai < 2; ++ai)
#pragma unroll
                    for (int m = 0; m < 4; ++m) *(f32x4*)(base + (size_t)(ai * HALF + m * 16) * 6144 + bj * HALF + n * 16) = acc[ai][bj][m][n] + bv;
                EPI_FENCE(); }
    }
};

struct Epi1 {
    bf16_t* MIX; bf16_t* KB; bf16_t* VT; bf16_t* VSB; bf16_t* XR;
    __device__ __forceinline__ void operator()(const AccT& acc, const Unit& u, int wr, int wc, int fr, int fq) const {
        const int rl = wr * 64 + fr, row0 = u.pm * BM + rl, cw = wc * 32 + 4 * fq; const int pn = u.pn, pm = u.pm;
        if (pn == 5 && pm < 64) {
            bf16_t* cp0 = VT + (size_t)cw * T_ + row0;
#pragma unroll
            for (int bj = 0; bj < 2; ++bj)
#pragma unroll
                for (int n = 0; n < 2; ++n) {
#pragma unroll
                    for (int e = 0; e < 4; ++e) { bf16_t* p = cp0 + (size_t)(bj * HALF + n * 16 + e) * T_;
#pragma unroll
                        for (int ai = 0; ai < 2; ++ai)
#pragma unroll
                            for (int m = 0; m < 4; ++m) p[ai * HALF + m * 16] = f2bf(acc[ai][bj][m][n][e]);
                        EPI_FENCE(); } }
            return;
        }
        bf16_t* base; int ld; float sc = 1.0f; bool gel = false;
        if (pn < 4) { base = MIX + (size_t)row0 * 2048 + pn * 256 + cw; ld = 2048; sc = QSCALE_; }
        else if (pn == 4) { base = KB + (size_t)row0 * 256 + cw; ld = 256; }
        else if (pn == 5) { base = VSB + (size_t)rl * 256 + cw; ld = 256; }
        else if (pn < 10) { base = XR + (size_t)row0 * 1024 + (pn - 6) * 256 + cw; ld = 1024; }
        else { base = MIX + (size_t)row0 * 2048 + 1024 + (pn - 10) * 256 + cw; ld = 2048; gel = true; }
        if (!gel) {
#pragma unroll
            for (int ai = 0; ai < 2; ++ai)
#pragma unroll
                for (int m = 0; m < 4; ++m) { bf16_t* rp = base + (size_t)(ai * HALF + m * 16) * ld;
#pragma unroll
                    for (int bj = 0; bj < 2; ++bj)
#pragma unroll
                        for (int n = 0; n < 2; ++n) *(u32x2*)(rp + bj * HALF + n * 16) = pk4(acc[ai][bj][m][n] * sc);
                    EPI_FENCE(); }
        } else {
#pragma unroll
            for (int ai = 0; ai < 2; ++ai)
#pragma unroll
                for (int m = 0; m < 4; ++m) { bf16_t* rp = base + (size_t)(ai * HALF + m * 16) * ld;
#pragma unroll
                    for (int bj = 0; bj < 2; ++bj)
#pragma unroll
                        for (int n = 0; n < 2; ++n) { const f32x4 v = acc[ai][bj][m][n]; u32x2 w; w.x = cvt_pk_bf16(gelu_t(v[0]), gelu_t(v[1])); w.y = cvt_pk_bf16(gelu_t(v[2]), gelu_t(v[3]));
                            *(u32x2*)(rp + bj * HALF + n * 16) = w; }
                    EPI_FENCE(); }
        }
    }
};

struct Epi2 {
    bf16_t* O; const float* SSA; const float* SSR;
    __device__ __forceinline__ void mid(AccT& acc, const Unit& u, int wr, int fr) const {
        const int row0 = u.pm * BM + wr * 64 + fr; const float* pa = SSA + row0; const float* pr = SSR + row0;
        float va[8], vr[8];
#pragma unroll
        for (int q = 0; q < 8; ++q) { va[q] = pa[(q >> 2) * HALF + (q & 3) * 16]; vr[q] = pr[(q >> 2) * HALF + (q & 3) * 16]; }
        EPI_FENCE();
#pragma unroll
        for (int ai = 0; ai < 2; ++ai)
#pragma unroll
            for (int m = 0; m < 4; ++m) {
                const float ra = va[ai * 4 + m] * (1.0f / 1024.0f) + EPS_, rr = vr[ai * 4 + m] * (1.0f / 1024.0f) + EPS_; const float ratio = sqrtf(rr * __builtin_amdgcn_rcpf(ra));
#pragma unroll
                for (int bj = 0; bj < 2; ++bj)
#pragma unroll
                    for (int n = 0; n < 2; ++n) acc[ai][bj][m][n] *= ratio; }
    }
    __device__ __forceinline__ void operator()(const AccT& acc, const Unit& u, int wr, int wc, int fr, int fq) const {
        const int row0 = u.pm * BM + wr * 64 + fr, col0 = u.pn * BM + wc * 32 + 4 * fq;
        bf16_t* base = O + (size_t)row0 * 1024 + col0; const float* pr = SSR + row0;
        float vr[8];
#pragma unroll
        for (int q = 0; q < 8; ++q) vr[q] = pr[(q >> 2) * HALF + (q & 3) * 16];
        EPI_FENCE();
#pragma unroll
        for (int ai = 0; ai < 2; ++ai)
#pragma unroll
            for (int m = 0; m < 4; ++m) { const float rs = rsqrtf(vr[ai * 4 + m] * (1.0f / 1024.0f) + EPS_); bf16_t* rp = base + (size_t)(ai * HALF + m * 16) * 1024;
#pragma unroll
                for (int bj = 0; bj < 2; ++bj)
#pragma unroll
                    for (int n = 0; n < 2; ++n) *(u32x2*)(rp + bj * HALF + n * 16) = pk4(acc[ai][bj][m][n] * rs);
                EPI_FENCE(); }
    }
};

struct Epi4 {
    bf16_t* F;
    __device__ __forceinline__ void operator()(const AccT& acc, const Unit& u, int wr, int wc, int fr, int fq) const {
        const int row0 = u.pm * BM + wr * 64 + fr, col0 = u.pn * BM + wc * 32 + 4 * fq;
        bf16_t* base = F + (size_t)row0 * 1024 + col0;
#pragma unroll
        for (int ai = 0; ai < 2; ++ai)
#pragma unroll
            for (int m = 0; m < 4; ++m) { bf16_t* rp = base + (size_t)(ai * HALF + m * 16) * 1024;
#pragma unroll
                for (int bj = 0; bj < 2; ++bj)
#pragma unroll
                    for (int n = 0; n < 2; ++n) *(u32x2*)(rp + bj * HALF + n * 16) = pk4(acc[ai][bj][m][n]);
                EPI_FENCE(); }
    }
};

template <int KS>
__device__ __forceinline__ void small_gemm_item(const bf16_t* A, int lda, const bf16_t* Bt, int ldb, float* OS, int nc, int ksp, const float* ss) {
    int tid = threadIdx.x; asm volatile("" : "+v"(tid));
    const int wid = tid >> 6, lane = tid & 63, fr = lane & 15, fq = lane >> 4;
    const int k0 = ksp * KS * 32, n0 = nc * 32, row = 16 * wid + fr;
    const bf16_t* ap = A + (size_t)row * lda + k0 + 8 * fq; const bf16_t* bp = Bt + (size_t)(n0 + fr) * ldb + k0 + 8 * fq;
    bf16x8 af[KS], b0[KS], b1[KS];
#pragma unroll
    for (int ks = 0; ks < KS; ++ks) { af[ks] = *(const bf16x8*)(ap + 32 * ks); b0[ks] = *(const bf16x8*)(bp + 32 * ks); b1[ks] = *(const bf16x8*)(bp + (size_t)16 * ldb + 32 * ks); }
    __builtin_amdgcn_sched_barrier(0);
    f32x4 c0 = {0.f, 0.f, 0.f, 0.f}, c1 = {0.f, 0.f, 0.f, 0.f};
#pragma unroll
    for (int ks = 0; ks < KS; ++ks) { c0 = __builtin_amdgcn_mfma_f32_16x16x32_bf16(b0[ks], af[ks], c0, 0, 0, 0); c1 = __builtin_amdgcn_mfma_f32_16x16x32_bf16(b1[ks], af[ks], c1, 0, 0, 0); }
    float sc = 1.0f; if (ss) sc = rsqrtf(ss[row] * (1.0f / 1024.0f) + EPS_);
    float* op = OS + (size_t)ksp * 131072 + (size_t)row * 1024 + n0 + 4 * fq;
    *(f32x4*)op = c0 * sc; *(f32x4*)(op + 16) = c1 * sc;
}

struct Epi3 {
    bf16_t* FIN; const float* fcw; const float* fcb; const float* sfc; float* out;
    __device__ __forceinline__ void operator()(const AccT& acc, const Unit& u, int wr, int wc, int fr, int fq) const {
        const bool sample = (u.pm == 66);
        const int tau = sample ? 16386 : 252 * u.pm;
        const int tb = tau + 126 * wr + 8 * fr - 2;
        const int j0 = 128 * u.pn + 32 * wc + 4 * fq;
#pragma unroll
        for (int n = 0; n < 2; ++n) {
            const int j = j0 + 16 * n; const float* wp = fcw + j; const float* bp = fcb + j;
            const f32x4 gw0 = *(const f32x4*)(wp), gw1 = *(const f32x4*)(wp + 5632), gw2 = *(const f32x4*)(wp + 2 * 5632), gb = *(const f32x4*)(bp);
            const f32x4 vw0 = *(const f32x4*)(wp + 2816), vw1 = *(const f32x4*)(wp + 5632 + 2816), vw2 = *(const f32x4*)(wp + 2 * 5632 + 2816), vb = *(const f32x4*)(bp + 2816);
            EPI_FENCE();
            if (!sample) {
                f32x4 g2, g1, v2, v1;
#pragma unroll
                for (int e = 0; e < 4; ++e) { g2[e] = __shfl_up(acc[1][0][2][n][e], 1, 16); g1[e] = __shfl_up(acc[1][0][3][n][e], 1, 16);
                                              v2[e] = __shfl_up(acc[1][1][2][n][e], 1, 16); v1[e] = __shfl_up(acc[1][1][3][n][e], 1, 16); }
                bf16_t* fp = FIN + (size_t)tb * 2816 + j;
#pragma unroll
                for (int s = 0; s < 8; ++s) {
                    const f32x4 g0 = acc[s >> 2][0][s & 3][n], v0 = acc[s >> 2][1][s & 3][n];
                    const int t = tb + s;
                    const bool valid = !(fr == 0 && s < 2) && t < T_;
                    if (valid) {
                        const f32x4 yg = gw0 * g2 + gw1 * g1 + gw2 * g0 + gb, yv = vw0 * v2 + vw1 * v1 + vw2 * v0 + vb;
                        u32x2 w; w.x = cvt_pk_bf16(gelu_t(yg[0]) * yv[0], gelu_t(yg[1]) * yv[1]); w.y = cvt_pk_bf16(gelu_t(yg[2]) * yv[2], gelu_t(yg[3]) * yv[3]);
                        *(u32x2*)(fp) = w;
                    }
                    g2 = g1; g1 = g0; v2 = v1; v1 = v0; fp += 2816;
                    EPI_FENCE();
                }
                if (u.pm == 65 && wr == 0 && fr == 0) {
                    float* ob = out + O_FP + j;
                    *(f32x4*)(ob) = acc[1][0][0][n]; *(f32x4*)(ob + 2816) = acc[1][1][0][n];
                    *(f32x4*)(ob + 5632) = acc[1][0][1][n]; *(f32x4*)(ob + 5632 + 2816) = acc[1][1][1][n];
                }
            } else if (wr == 0) {
                const float* sp = sfc + (size_t)(8 * fr) * 11264 + j; bf16_t* fp = FIN + (size_t)(T_ + 8 * fr) * 2816 + j; float* ob = out + O_FS + (size_t)(8 * fr) * 11264 + 5632 + j;
#pragma unroll
                for (int s = 0; s < 8; ++s) {
                    const f32x4 g0 = acc[s >> 2][0][s & 3][n], v0 = acc[s >> 2][1][s & 3][n];
                    const f32x4 sg0 = *(const f32x4*)(sp), sg1 = *(const f32x4*)(sp + 5632), sv0 = *(const f32x4*)(sp + 2816), sv1 = *(const f32x4*)(sp + 5632 + 2816);
                    const f32x4 yg = gw0 * sg0 + gw1 * sg1 + gw2 * g0 + gb, yv = vw0 * sv0 + vw1 * sv1 + vw2 * v0 + vb;
                    u32x2 w; w.x = cvt_pk_bf16(gelu_t(yg[0]) * yv[0], gelu_t(yg[1]) * yv[1]); w.y = cvt_pk_bf16(gelu_t(yg[2]) * yv[2], gelu_t(yg[3]) * yv[3]);
                    *(u32x2*)(fp) = w;
                    *(f32x4*)(ob) = g0; *(f32x4*)(ob + 2816) = v0;
                    sp += 11264; fp += 2816; ob += 11264;
                    EPI_FENCE();
                }
            }
            EPI_FENCE();
        }
    }
};

__device__ __forceinline__ void tr_tile(float* tl, const float* W, int ldw, bf16_t* Wt, int ldt, int k0, int n0, int dn0, const float* ks0, const float* ks1) {
    int tid = threadIdx.x; asm volatile("" : "+v"(tid));
    { const int r = tid >> 4, c4 = (tid & 15) * 4;
#pragma unroll
      for (int p = 0; p < 2; ++p) { const int row = p * 32 + r; const f32x4 v = *(const f32x4*)(W + (size_t)(k0 + row) * ldw + n0 + c4);
          float sc = 1.f; if (ks0) { const int k = k0 + row; sc = k < 1024 ? ks0[k] : ks1[k - 1024]; }
          tl[row * 65 + c4 + 0] = v[0] * sc; tl[row * 65 + c4 + 1] = v[1] * sc; tl[row * 65 + c4 + 2] = v[2] * sc; tl[row * 65 + c4 + 3] = v[3] * sc; } }
    __syncthreads();
    { const int n = tid >> 3, kc = (tid & 7) * 8; float f[8];
#pragma unroll
      for (int i = 0; i < 8; ++i) f[i] = tl[(kc + i) * 65 + n];
      u32x4 w; w.x = cvt_pk_bf16(f[0], f[1]); w.y = cvt_pk_bf16(f[2], f[3]); w.z = cvt_pk_bf16(f[4], f[5]); w.w = cvt_pk_bf16(f[6], f[7]);
      *(u32x4*)(Wt + (size_t)(dn0 + n) * ldt + k0 + kc) = w; }
    __syncthreads();
}

__device__ __forceinline__ void tr_group(float* tl, const float* W, int ldw, bf16_t* Wt, int ldt, int k0, int nbase, int mode, const float* ks0, const float* ks1) {
    int tid = threadIdx.x; asm volatile("" : "+v"(tid));
    { const int r = tid >> 4, c4 = (tid & 15) * 4; f32x4 v[4][2];
#pragma unroll
      for (int j = 0; j < 4; ++j)
#pragma unroll
          for (int p = 0; p < 2; ++p) v[j][p] = __builtin_nontemporal_load((const f32x4*)(W + (size_t)(k0 + p * 32 + r) * ldw + nbase + 64 * j + c4));
#pragma unroll
      for (int p = 0; p < 2; ++p) { const int row = p * 32 + r; float sc = 1.f; if (ks0) { const int k = k0 + row; sc = k < 1024 ? ks0[k] : ks1[k - 1024]; }
#pragma unroll
          for (int j = 0; j < 4; ++j) { float* t = tl + j * 4160 + row * 65 + c4; t[0] = v[j][p][0] * sc; t[1] = v[j][p][1] * sc; t[2] = v[j][p][2] * sc; t[3] = v[j][p][3] * sc; } } }
    __syncthreads();
    { const int n = tid >> 3, kc = (tid & 7) * 8;
#pragma unroll
      for (int j = 0; j < 4; ++j) { float f[8];
#pragma unroll
          for (int i = 0; i < 8; ++i) f[i] = tl[j * 4160 + (kc + i) * 65 + n];
          const int n0 = nbase + 64 * j; int dn0 = n0;
          if (mode == 1) dn0 = n0 < 2816 ? ((n0 >> 7) * 256 + (n0 & 127)) : ((((n0 - 2816) >> 7) * 256) + 128 + ((n0 - 2816) & 127));
          u32x4 w; w.x = cvt_pk_bf16(f[0], f[1]); w.y = cvt_pk_bf16(f[2], f[3]); w.z = cvt_pk_bf16(f[4], f[5]); w.w = cvt_pk_bf16(f[6], f[7]);
          *(u32x4*)(Wt + (size_t)(dn0 + n) * ldt + k0 + kc) = w; } }
    __syncthreads();
}

__device__ void phase0(const Params& P, float* ldsf) {
    char* ws = P.ws; const int G = gridDim.x, bid = blockIdx.x; int tid = threadIdx.x; asm volatile("" : "+v"(tid));
    for (int idx = bid; idx < 16 * 24; idx += G) { const int ng = idx % 24, kt = idx / 24;
        tr_group(ldsf, P.in[I_WADA], 6144, (bf16_t*)(ws + OFF_WT_ADA), 1024, kt * 64, ng * 256, 0, nullptr, nullptr); }
    const size_t gt = (size_t)bid * 512 + tid, gs = (size_t)G * 512;
    { bf16_t* A = (bf16_t*)(ws + OFF_A_ADA);
      for (size_t i = gt; i < (size_t)256 * 1024; i += gs) { const int r = (int)(i >> 10), c = (int)(i & 1023); float v = 0.f;
          if (r == 0) v = P.in[I_CP][c]; else if (r <= 128) v = P.in[I_CS][(size_t)(r - 1) * 1024 + c];
          A[i] = f2bf(v * sigmoid_f(v)); } }
    { float* sp = (float*)(ws + OFF_SP8); for (size_t i = gt; i < 1024; i += gs) sp[i] = 8.0f * log1pf(expf(-P.in[I_LAM][i])); }
    { float* ss = (float*)(ws + OFF_SS); for (size_t i = gt; i < (size_t)4 * MP_; i += gs) ss[i] = 0.f; }
    { float* __restrict__ o = P.out + O_CS; const float* __restrict__ s = P.in[I_SC];
#pragma unroll 4
      for (size_t i = gt; i < (size_t)128 * 2048; i += gs) { const size_t b = i >> 11, r = i & 2047; o[b * 3072 + r] = s[b * 3072 + 1024 + r]; } }
    { float* __restrict__ o = P.out + O_FS; const float* __restrict__ s = P.in[I_SF];
#pragma unroll 8
      for (size_t i = gt; i < (size_t)128 * 5632; i += gs) { const size_t b = i / 5632, r = i % 5632; o[b * 11264 + r] = s[b * 11264 + 5632 + r]; } }
    { unsigned* z = (unsigned*)(ws + OFF_HM0); for (size_t i = gt; i < 1024; i += gs) z[i] = 0u; }
}

__device__ void phase1(const Params& P, LAS unsigned char* lds, float* ldsf) {
    char* ws = P.ws; const int G = gridDim.x, bid = blockIdx.x;
    { Gemm g{(const bf16_t*)(ws + OFF_A_ADA), (const bf16_t*)(ws + OFF_WT_ADA), 1024}; Sched S; S.init(1, 24, G, bid);
      EpiAda E{(float*)(ws + OFF_MOD), P.in[I_BADA]}; gemm_phase<EpiAda, false, false>(lds, g, S, E); }
    __syncthreads();
    int wk, nw; if (G > 48) { if (bid < 24) return; wk = bid - 24; nw = G - 24; } else { wk = bid; nw = G; }
    for (int idx = wk; idx < 944; idx += nw) {
        if (idx < 224) { const int ng = idx % 14, kt = idx / 14; tr_group(ldsf, P.in[I_WIN], 3584, (bf16_t*)(ws + OFF_WT_IN), 1024, kt * 64, ng * 256, 0, nullptr, nullptr); }
        else if (idx < 352) { const int i2 = idx - 224, ng = i2 & 3, kt = i2 >> 2; tr_group(ldsf, P.in[I_WOUT], 1024, (bf16_t*)(ws + OFF_WT_OUT), 2048, kt * 64, ng * 256, 0, P.in[I_GAO], P.in[I_GRO]); }
        else if (idx < 704) { const int i2 = idx - 352, ng = i2 % 22, kt = i2 / 22; tr_group(ldsf, P.in[I_WUP], 5632, (bf16_t*)(ws + OFF_WT_UP), 1024, kt * 64, ng * 256, 1, nullptr, nullptr); }
        else if (idx < 880) { const int i2 = idx - 704, ng = i2 & 3, kt = i2 >> 2; tr_group(ldsf, P.in[I_WDOWN], 1024, (bf16_t*)(ws + OFF_WT_DOWN), 2816, kt * 64, ng * 256, 0, nullptr, nullptr); }
        else { const int i2 = (idx - 880) & 31, blk = i2 >> 2, kt = (i2 >> 1) & 1, ntile = i2 & 1; const bool isA = idx < 912;
            tr_tile(ldsf, P.in[isA ? I_WA : I_WI] + (size_t)blk * 16384, 128, (bf16_t*)(ws + (isA ? OFF_WT_A : OFF_WT_I)) + (size_t)blk * 16384, 128, kt * 64, ntile * 64, ntile * 64, nullptr, nullptr); }
    }
}

constexpr int NBR = 4;
__device__ __forceinline__ const float* xrow(const Params& P, int r) { return r < T_ ? P.in[I_XP] + (size_t)r * 1024 : P.in[I_XS] + (size_t)(r - T_) * 1024; }
constexpr int NB2 = 8;
template <bool PO>
__device__ __forceinline__ void phase2_batch(const Params& P, int r0, int nw, int lane) {
    char* ws = P.ws; const float* MOD = (const float*)(ws + OFF_MOD); bf16_t* H = (bf16_t*)(ws + OFF_HM);
    f32x4 v[NB2][4]; float ss[NB2];
#pragma unroll
    for (int b = 0; b < NB2; ++b) { const int r = r0 + b * nw; ss[b] = 0.f;
        if (PO || r < MR_) { const float* x = xrow(P, r);
#pragma unroll
            for (int i = 0; i < 4; ++i) v[b][i] = __builtin_nontemporal_load((const f32x4*)(x + i * 256 + lane * 4)); }
        else {
#pragma unroll
            for (int i = 0; i < 4; ++i) v[b][i] = (f32x4){0.f, 0.f, 0.f, 0.f}; } }
#pragma unroll
    for (int b = 0; b < NB2; ++b) {
#pragma unroll
        for (int i = 0; i < 4; ++i) ss[b] += (v[b][i][0] * v[b][i][0] + v[b][i][1] * v[b][i][1]) + (v[b][i][2] * v[b][i][2] + v[b][i][3] * v[b][i][3]);
        ss[b] = wave_sum(ss[b]); }
#pragma unroll
    for (int b = 0; b < NB2; ++b) { const int r = r0 + b * nw; if (!PO && r >= MP_) continue;
        if (!PO && r >= MR_) { for (int i = 0; i < 4; ++i) *(u32x2*)(H + (size_t)r * 1024 + i * 256 + lane * 4) = (u32x2){0u, 0u}; continue; }
        const float* md = MOD + (size_t)modrow(r) * 6144; const float rs = rsqrtf(ss[b] * (1.0f / 1024.0f) + EPS_);
#pragma unroll
        for (int i = 0; i < 4; ++i) { const int c = i * 256 + lane * 4; const f32x4 g = *(const f32x4*)(P.in[I_GPM] + c), sh = *(const f32x4*)(md + c), sc = *(const f32x4*)(md + 1024 + c);
            __builtin_nontemporal_store(pk4((v[b][i] * rs * g) * (sc + 1.0f) + sh), (u32x2*)(H + (size_t)r * 1024 + c)); } }
}
__device__ void phase2(const Params& P) {
    int tid = threadIdx.x; asm volatile("" : "+v"(tid));
    const int wid = __builtin_amdgcn_readfirstlane(tid >> 6), lane = tid & 63;
    const int nw = gridDim.x * 8;
    for (int r0 = blockIdx.x * 8 + wid; r0 < MP_; r0 += nw * NB2) {
        if (r0 + (NB2 - 1) * nw < T_) phase2_batch<true>(P, r0, nw, lane); else phase2_batch<false>(P, r0, nw, lane);
    }
}

__device__ __forceinline__ int crow(int r, int hi) { return (r & 3) + 8 * (r >> 2) + 4 * hi; }
__device__ void attn_prompt_item(const Params& P, char* lds, int qb, int kv) {
    char* ws = P.ws; bf16_t* MIX = (bf16_t*)(ws + OFF_MIX); const bf16_t* KB = (const bf16_t*)(ws + OFF_KB); const bf16_t* VT = (const bf16_t*)(ws + OFF_VT); float* SSA = (float*)(ws + OFF_SS);
    bf16_t* Ks = (bf16_t*)lds; bf16_t* Vs = (bf16_t*)(lds + 256 * 136 * 2);
    int tid = threadIdx.x; asm volatile("" : "+v"(tid));
    const int wid = tid >> 6, lane = tid & 63; int r32 = lane & 31, hi = lane >> 5;
    const int tbase = 128 * (qb - 1);
    if (qb > 0) {
        u32x4 kv_[8], vv_[8];
#pragma unroll
        for (int i = 0; i < 8; ++i) { const int id = i * 512 + tid; kv_[i] = *(const u32x4*)(KB + (size_t)(tbase + (id >> 4)) * 256 + kv * 128 + (id & 15) * 8);
            vv_[i] = *(const u32x4*)(VT + (size_t)(kv * 128 + (id >> 5)) * T_ + tbase + (id & 31) * 8); }
#pragma unroll
        for (int i = 0; i < 8; ++i) { const int id = i * 512 + tid; *(u32x4*)(Ks + (id >> 4) * 136 + (id & 15) * 8) = kv_[i];
            u32x2* dst = (u32x2*)(Vs + (id >> 5) * 260 + (id & 31) * 8); dst[0] = (u32x2){vv_[i].x, vv_[i].y}; dst[1] = (u32x2){vv_[i].z, vv_[i].w}; }
    } else {
#pragma unroll
        for (int i = 0; i < 8; ++i) { const int id = i * 512 + tid, row = id >> 4, c = id & 15; const int t = tbase + row;
            u32x4 v = {0u, 0u, 0u, 0u}; if (t >= 0) v = *(const u32x4*)(KB + (size_t)t * 256 + kv * 128 + c * 8);
            *(u32x4*)(Ks + row * 136 + c * 8) = v; }
#pragma unroll
        for (int i = 0; i < 8; ++i) { const int id = i * 512 + tid, d = id >> 5, c = id & 31; const int t = tbase + c * 8;
            u32x4 v = {0u, 0u, 0u, 0u}; if (t >= 0) v = *(const u32x4*)(VT + (size_t)(kv * 128 + d) * T_ + t);
            u32x2* dst = (u32x2*)(Vs + d * 260 + c * 8); dst[0] = (u32x2){v.x, v.y}; dst[1] = (u32x2){v.z, v.w}; }
    }
    __syncthreads();
#pragma unroll 1
    for (int it = 0; it < 2; ++it) {
        asm volatile("" : "+v"(r32), "+v"(hi));
        const int tile = wid + 8 * it, g = tile >> 2, w4 = tile & 3, head = kv * 4 + g;
        const int trow = 128 * qb + 32 * w4 + r32;
        bf16_t* qp = MIX + (size_t)trow * 2048 + head * 128;
        bf16x8 qr[8];
#pragma unroll
        for (int d0 = 0; d0 < 8; ++d0) qr[d0] = *(const bf16x8*)(qp + d0 * 16 + hi * 8);
        f32x16 p[5];
#pragma unroll
        for (int kt = 0; kt < 5; ++kt) {
            f32x16 a = {};
            const bf16_t* kp = Ks + (32 * (w4 + kt) + r32) * 136 + hi * 8;
#pragma unroll
            for (int d0 = 0; d0 < 8; ++d0) { const bf16x8 kf = *(const bf16x8*)(kp + d0 * 16); a = __builtin_amdgcn_mfma_f32_32x32x16_bf16(kf, qr[d0], a, 0, 0, 0); }
            p[kt] = a;
            EPI_FENCE();
        }
        const float slope2 = __builtin_amdgcn_exp2f(-(float)(head + 1)) * LOG2E_, sink2 = P.in[I_SINK][head] * LOG2E_;
        float mx = sink2;
#pragma unroll
        for (int kt = 0; kt < 5; ++kt)
#pragma unroll
            for (int r = 0; r < 16; ++r) { const int c = crow(r, hi); const int dist = 128 + r32 - 32 * kt - c; const int jb = 32 * (w4 + kt) + c;
                const bool valid = ((unsigned)dist < 128u) && (qb > 0 || jb >= 128);
                const float s = valid ? p[kt][r] - slope2 * (float)dist : -__builtin_inff(); p[kt][r] = s; mx = fmaxf(mx, s); }
        mx = fmaxf(mx, __shfl_xor(mx, 32));
        float l = 0.f;
        u32x4 pb[5][2];
#pragma unroll
        for (int kt = 0; kt < 5; ++kt) {
            float e[16];
#pragma unroll
            for (int r = 0; r < 16; ++r) { e[r] = __builtin_amdgcn_exp2f(p[kt][r] - mx); l += e[r]; }
#pragma unroll
            for (int s2 = 0; s2 < 2; ++s2) { pb[kt][s2].x = cvt_pk_bf16(e[8 * s2 + 0], e[8 * s2 + 1]); pb[kt][s2].y = cvt_pk_bf16(e[8 * s2 + 2], e[8 * s2 + 3]);
                pb[kt][s2].z = cvt_pk_bf16(e[8 * s2 + 4], e[8 * s2 + 5]); pb[kt][s2].w = cvt_pk_bf16(e[8 * s2 + 6], e[8 * s2 + 7]); }
        }
        l += __shfl_xor(l, 32); l += __builtin_amdgcn_exp2f(sink2 - mx);
        EPI_FENCE();
        f32x16 o[4] = {};
#pragma unroll
        for (int kt = 0; kt < 5; ++kt)
#pragma unroll
            for (int s2 = 0; s2 < 2; ++s2) {
                const bf16x8 pf = *reinterpret_cast<const bf16x8*>(&pb[kt][s2]);
#pragma unroll
                for (int db = 0; db < 4; ++db) { const bf16_t* vp = Vs + (32 * db + r32) * 260 + 32 * (w4 + kt) + 16 * s2 + 4 * hi;
                    const u32x2 lo = *(const u32x2*)vp, hh = *(const u32x2*)(vp + 8); u32x4 vw = {lo.x, lo.y, hh.x, hh.y};
                    o[db] = __builtin_amdgcn_mfma_f32_32x32x16_bf16(*reinterpret_cast<const bf16x8*>(&vw), pf, o[db], 0, 0, 0); }
                EPI_FENCE();
            }
        const float inv = 1.0f / l; float ss = 0.f;
#pragma unroll
        for (int db = 0; db < 4; ++db)
#pragma unroll
            for (int r4 = 0; r4 < 4; ++r4) { const float a = o[db][4 * r4] * inv, b = o[db][4 * r4 + 1] * inv, c = o[db][4 * r4 + 2] * inv, d = o[db][4 * r4 + 3] * inv;
                ss += (a * a + b * b) + (c * c + d * d); u32x2 w; w.x = cvt_pk_bf16(a, b); w.y = cvt_pk_bf16(c, d);
                *(u32x2*)(qp + 32 * db + 8 * r4 + 4 * hi) = w; }
        ss += __shfl_xor(ss, 32);
        if (hi == 0) atomicAdd(SSA + trow, ss);
    }
    __syncthreads();
}

__device__ void attn_sample_item(const Params& P, char* lds, int b, int kv) {
    char* ws = P.ws; bf16_t* MIX = (bf16_t*)(ws + OFF_MIX); const bf16_t* KB = (const bf16_t*)(ws + OFF_KB); const bf16_t* VSB = (const bf16_t*)(ws + OFF_VSB); float* SSA = (float*)(ws + OFF_SS);
    float* Kf = (float*)lds; float* Vf = Kf + 128 * 129; float* qs = Vf + 128 * 129; float* ps = qs + 512; float* red = ps + 512;
    int tid = threadIdx.x; asm volatile("" : "+v"(tid));
    const int g = tid >> 7, jd = tid & 127, head = kv * 4 + g;
    bf16_t* qp = MIX + (size_t)(T_ + b) * 2048 + head * 128;
    qs[tid] = bf2f(qp[jd]);
    { f32x4 kk[8], vv[8];
#pragma unroll
      for (int i = 0; i < 8; ++i) { const int id = i * 512 + tid, j = id >> 5, c4 = (id & 31) * 4;
          if (j < 127) { const size_t src = ((size_t)(b * 128 + j + 1) * 2 + kv) * 128 + c4; kk[i] = __builtin_nontemporal_load((const f32x4*)(P.in[I_CK] + src)); vv[i] = __builtin_nontemporal_load((const f32x4*)(P.in[I_CV] + src)); }
          else { const u32x2 kw = *(const u32x2*)(KB + (size_t)(T_ + b) * 256 + kv * 128 + c4), vw = *(const u32x2*)(VSB + (size_t)b * 256 + kv * 128 + c4);
              kk[i] = (f32x4){bflo(kw.x), bfhi(kw.x), bflo(kw.y), bfhi(kw.y)}; vv[i] = (f32x4){bflo(vw.x), bfhi(vw.x), bflo(vw.y), bfhi(vw.y)}; } }
#pragma unroll
      for (int i = 0; i < 8; ++i) { const int id = i * 512 + tid, j = id >> 5, c4 = (id & 31) * 4;
          const size_t dst = ((size_t)(b * 128 + j) * 2 + kv) * 128 + c4; __builtin_nontemporal_store(kk[i], (f32x4*)(P.out + O_KS + dst)); __builtin_nontemporal_store(vv[i], (f32x4*)(P.out + O_VS + dst));
#pragma unroll
          for (int e = 0; e < 4; ++e) { Kf[j * 129 + c4 + e] = kk[i][e]; Vf[j * 129 + c4 + e] = vv[i][e]; } } }
    __syncthreads();
    const float slope2 = __builtin_amdgcn_exp2f(-(float)(head + 1)) * LOG2E_, sink2 = P.in[I_SINK][head] * LOG2E_;
    float s = 0.f;
    for (int d = 0; d < 128; ++d) s += qs[g * 128 + d] * Kf[jd * 129 + d];
    s -= slope2 * (float)(127 - jd);
    ps[tid] = s;
    __syncthreads();
    float mx = sink2; for (int j = 0; j < 128; ++j) mx = fmaxf(mx, ps[g * 128 + j]);
    const float e = __builtin_amdgcn_exp2f(s - mx);
    __syncthreads();
    ps[tid] = e;
    __syncthreads();
    float l = __builtin_amdgcn_exp2f(sink2 - mx); for (int j = 0; j < 128; ++j) l += ps[g * 128 + j];
    float o = 0.f;
    for (int j = 0; j < 128; ++j) o += ps[g * 128 + j] * Vf[j * 129 + jd];
    o /= l;
    qp[jd] = f2bf(o);
    const float ss = wave_sum(o * o);
    if ((tid & 63) == 0) atomicAdd(SSA + T_ + b, ss);
    (void)red;
    __syncthreads();
}

template <bool SAMPLE>
__device__ void rnn1_item(const Params& P, char* lds, int tile, int nb, int rg) {
    char* ws = P.ws; constexpr bool sample = SAMPLE;
    const bf16_t* XR = (const bf16_t*)(ws + OFF_XR); bf16_t* MIX = (bf16_t*)(ws + OFF_MIX); bf16_t* LAT = (bf16_t*)(ws + OFF_HM); bf16_t* UT = (bf16_t*)(ws + OFF_U);
    const float* SP8 = (const float*)(ws + OFF_SP8); float* SSR = (float*)(ws + OFF_SS) + MP_;
    bf16_t* XC = (bf16_t*)lds; bf16_t* WA = XC + 128 * 136; bf16_t* WI = WA + 128 * 136;
    float* As = (float*)lds; float* Us = As + 128 * 129; float* sgA = Us + 128 * 129; float* sgE = sgA + 512; float* bl = sgE + 512;
    int tid = threadIdx.x; asm volatile("" : "+v"(tid));
    const int wid = tid >> 6, lane = tid & 63, fr = lane & 15, fq = lane >> 4;
    const int t0 = tile * 128, ch0 = nb * 128;
    float blv = 0.f; if (tid < 384) blv = tid < 128 ? P.in[I_BA][ch0 + tid] : (tid < 256 ? P.in[I_BI][ch0 + tid - 128] : SP8[ch0 + tid - 256]);
    if (!sample) {
        const int c8 = (tid & 15) * 8, ch = ch0 + c8;
        u32x4 xv[4][4];
        if (tile > 0) {
#pragma unroll
            for (int i = 0; i < 4; ++i)
#pragma unroll
                for (int k = 0; k < 4; ++k) xv[i][k] = *(const u32x4*)(XR + (size_t)(t0 + i * 32 + (tid >> 4) - 3 + k) * 1024 + ch);
        } else {
#pragma unroll
            for (int i = 0; i < 4; ++i)
#pragma unroll
                for (int k = 0; k < 4; ++k) { const int tt = i * 32 + (tid >> 4) - 3 + k; xv[i][k] = (u32x4){0u, 0u, 0u, 0u}; if (tt >= 0) xv[i][k] = *(const u32x4*)(XR + (size_t)tt * 1024 + ch); }
        }
        f32x4 cw[4][2], cb[2];
#pragma unroll
        for (int k = 0; k < 4; ++k) { cw[k][0] = *(const f32x4*)(P.in[I_CW] + k * 1024 + ch); cw[k][1] = *(const f32x4*)(P.in[I_CW] + k * 1024 + ch + 4); }
        cb[0] = *(const f32x4*)(P.in[I_CB] + ch); cb[1] = *(const f32x4*)(P.in[I_CB] + ch + 4);
#pragma unroll
        for (int i = 0; i < 4; ++i) { const int row = i * 32 + (tid >> 4);
            f32x4 x0 = cb[0], x1 = cb[1];
#pragma unroll
            for (int k = 0; k < 4; ++k) { const u32x4 v = xv[i][k];
                x0 += cw[k][0] * (f32x4){bflo(v.x), bfhi(v.x), bflo(v.y), bfhi(v.y)}; x1 += cw[k][1] * (f32x4){bflo(v.z), bfhi(v.z), bflo(v.w), bfhi(v.w)}; }
            u32x4 w; w.x = cvt_pk_bf16(x0[0], x0[1]); w.y = cvt_pk_bf16(x0[2], x0[3]); w.z = cvt_pk_bf16(x1[0], x1[1]); w.w = cvt_pk_bf16(x1[2], x1[3]);
            *(u32x4*)(XC + row * 136 + c8) = w; }
    } else if (tid < 256) {
        const int row = tid >> 4, c8 = (tid & 15) * 8, ch = ch0 + c8, b = 16 * rg + row;
        float xc[8];
        { const f32x4 b0 = *(const f32x4*)(P.in[I_CB] + ch), b1 = *(const f32x4*)(P.in[I_CB] + ch + 4);
          xc[0] = b0[0]; xc[1] = b0[1]; xc[2] = b0[2]; xc[3] = b0[3]; xc[4] = b1[0]; xc[5] = b1[1]; xc[6] = b1[2]; xc[7] = b1[3]; }
#pragma unroll
        for (int k = 0; k < 3; ++k) { const float* sp = P.in[I_SC] + (size_t)b * 3072 + k * 1024 + ch; const f32x4 x0 = *(const f32x4*)sp, x1 = *(const f32x4*)(sp + 4);
            const f32x4 w0 = *(const f32x4*)(P.in[I_CW] + k * 1024 + ch), w1 = *(const f32x4*)(P.in[I_CW] + k * 1024 + ch + 4);
#pragma unroll
            for (int e = 0; e < 4; ++e) { xc[e] += w0[e] * x0[e]; xc[4 + e] += w1[e] * x1[e]; } }
        { const u32x4 v = *(const u32x4*)(XR + (size_t)(T_ + b) * 1024 + ch);
          const f32x4 x0 = {bflo(v.x), bfhi(v.x), bflo(v.y), bfhi(v.y)}, x1 = {bflo(v.z), bfhi(v.z), bflo(v.w), bfhi(v.w)};
          float* oc = P.out + O_CS + (size_t)b * 3072 + 2048 + ch; *(f32x4*)oc = x0; *(f32x4*)(oc + 4) = x1;
          const f32x4 w0 = *(const f32x4*)(P.in[I_CW] + 3 * 1024 + ch), w1 = *(const f32x4*)(P.in[I_CW] + 3 * 1024 + ch + 4);
#pragma unroll
          for (int e = 0; e < 4; ++e) { xc[e] += w0[e] * x0[e]; xc[4 + e] += w1[e] * x1[e]; } }
        u32x4 w; w.x = cvt_pk_bf16(xc[0], xc[1]); w.y = cvt_pk_bf16(xc[2], xc[3]); w.z = cvt_pk_bf16(xc[4], xc[5]); w.w = cvt_pk_bf16(xc[6], xc[7]);
        *(u32x4*)(XC + row * 136 + c8) = w;
    }
    if (tid < 384) bl[tid] = blv;
    { u32x4 wa_[4], wi_[4];
#pragma unroll
      for (int i = 0; i < 4; ++i) { const int id = i * 512 + tid; wa_[i] = *(const u32x4*)((const bf16_t*)(ws + OFF_WT_A) + (size_t)nb * 16384 + id * 8); wi_[i] = *(const u32x4*)((const bf16_t*)(ws + OFF_WT_I) + (size_t)nb * 16384 + id * 8); }
#pragma unroll
      for (int i = 0; i < 4; ++i) { const int id = i * 512 + tid, d = id >> 4, c8 = (id & 15) * 8; *(u32x4*)(WA + d * 136 + c8) = wa_[i]; *(u32x4*)(WI + d * 136 + c8) = wi_[i]; } }
    __syncthreads();
    constexpr bool active = true;
    constexpr int NT = SAMPLE ? 1 : 8;
    const int dofs = SAMPLE ? 16 * wid : 0;
    const int row = SAMPLE ? fr : 16 * wid + fr;
    f32x4 aa[NT], ai[NT]; u32x2 xcw[NT];
    if (active) {
        bf16x8 xf[4];
#pragma unroll
        for (int ks = 0; ks < 4; ++ks) xf[ks] = *(const bf16x8*)(XC + row * 136 + 32 * ks + 8 * fq);
#pragma unroll
        for (int nt = 0; nt < NT; ++nt) { f32x4 a = {0.f, 0.f, 0.f, 0.f}, b = {0.f, 0.f, 0.f, 0.f};
#pragma unroll
            for (int ks = 0; ks < 4; ++ks) { const bf16x8 wa = *(const bf16x8*)(WA + (dofs + 16 * nt + fr) * 136 + 32 * ks + 8 * fq), wi = *(const bf16x8*)(WI + (dofs + 16 * nt + fr) * 136 + 32 * ks + 8 * fq);
                a = __builtin_amdgcn_mfma_f32_16x16x32_bf16(wa, xf[ks], a, 0, 0, 0); b = __builtin_amdgcn_mfma_f32_16x16x32_bf16(wi, xf[ks], b, 0, 0, 0); }
            aa[nt] = a; ai[nt] = b; xcw[nt] = *(const u32x2*)(XC + row * 136 + dofs + 16 * nt + 4 * fq); }
    }
    __syncthreads();
    if (active) {
        float ssr = 0.f; const int brow = 16 * rg + fr;
#pragma unroll
        for (int nt = 0; nt < NT; ++nt) { const int d = dofs + 16 * nt + 4 * fq, ch = ch0 + d;
            const f32x4 ba = *(const f32x4*)(bl + d), bi = *(const f32x4*)(bl + 128 + d), sp = *(const f32x4*)(bl + 256 + d);
            const float xv[4] = {bflo(xcw[nt].x), bfhi(xcw[nt].x), bflo(xcw[nt].y), bfhi(xcw[nt].y)};
            float la[4], uu[4], av[4];
#pragma unroll
            for (int e = 0; e < 4; ++e) { const float r = sigmoid_f(aa[nt][e] + ba[e]), ig = sigmoid_f(ai[nt][e] + bi[e]);
                la[e] = -r * sp[e]; av[e] = __builtin_amdgcn_exp2f(LOG2E_ * la[e]);
                const float x2 = 2.0f * la[e];
                const float pol = -x2 * (1.0f + x2 * 0.5f * (1.0f + x2 * (1.0f / 3.0f) * (1.0f + x2 * 0.25f * (1.0f + x2 * 0.2f))));
                const float em = x2 > -0.25f ? pol : 1.0f - av[e] * av[e];
                uu[e] = __builtin_amdgcn_sqrtf(fmaxf(em, 0.f)) * (ig * xv[e]); }
            if (!sample) {
#pragma unroll
                for (int e = 0; e < 4; ++e) { As[row * 129 + d + e] = la[e]; Us[row * 129 + d + e] = uu[e]; }
            } else {
                const f32x4 h0 = *(const f32x4*)(P.in[I_SH] + (size_t)brow * 1024 + ch);
                bf16_t* gp = MIX + (size_t)(T_ + brow) * 2048 + 1024 + ch; const u32x2 gw = *(const u32x2*)gp; const float gy[4] = {bflo(gw.x), bfhi(gw.x), bflo(gw.y), bfhi(gw.y)};
                f32x4 h; float rn[4];
#pragma unroll
                for (int e = 0; e < 4; ++e) { h[e] = av[e] * h0[e] + uu[e]; rn[e] = h[e] * gy[e]; ssr += rn[e] * rn[e]; }
                *(f32x4*)(P.out + O_HS + (size_t)brow * 1024 + ch) = h;
                u32x2 w; w.x = cvt_pk_bf16(rn[0], rn[1]); w.y = cvt_pk_bf16(rn[2], rn[3]); *(u32x2*)gp = w;
            } }
        if (sample) { ssr += __shfl_xor(ssr, 16); ssr += __shfl_xor(ssr, 32); if (fq == 0) atomicAdd(SSR + T_ + brow, ssr); }
    }
    __syncthreads();
    if (sample) return;
    { const int s = tid >> 7, c = tid & 127; float A = 1.f, E = 0.f; unsigned lw[16], uw[16];
#pragma unroll
      for (int j = 0; j < 32; j += 2) { const float l0 = As[(32 * s + j) * 129 + c], u0 = Us[(32 * s + j) * 129 + c], l1 = As[(32 * s + j + 1) * 129 + c], u1 = Us[(32 * s + j + 1) * 129 + c];
          const float a0 = __builtin_amdgcn_exp2f(LOG2E_ * l0), a1 = __builtin_amdgcn_exp2f(LOG2E_ * l1);
          E = a0 * E + u0; A *= a0; E = a1 * E + u1; A *= a1; lw[j >> 1] = cvt_pk_bf16(l0, l1); uw[j >> 1] = cvt_pk_bf16(u0, u1); }
      ((float*)(ws + OFF_SEGA))[(size_t)(tile * 4 + s) * 1024 + ch0 + c] = A; ((float*)(ws + OFF_SEGE))[(size_t)(tile * 4 + s) * 1024 + ch0 + c] = E;
      sgA[tid] = A; sgE[tid] = E;
      u32x4* lp = (u32x4*)(LAT + (size_t)(ch0 + c) * T_ + t0 + 32 * s); u32x4* up = (u32x4*)(UT + (size_t)(ch0 + c) * T_ + t0 + 32 * s);
#pragma unroll
      for (int q = 0; q < 4; ++q) { lp[q] = (u32x4){lw[4 * q], lw[4 * q + 1], lw[4 * q + 2], lw[4 * q + 3]}; up[q] = (u32x4){uw[4 * q], uw[4 * q + 1], uw[4 * q + 2], uw[4 * q + 3]}; } }
    __syncthreads();
    if (tid < 128) { float A = 1.f, E = 0.f;
#pragma unroll
        for (int s = 0; s < 4; ++s) { const float a = sgA[s * 128 + tid], e = sgE[s * 128 + tid]; E = a * E + e; A *= a; }
        ((float*)(ws + OFF_TILEA))[(size_t)tile * 1024 + ch0 + tid] = A; ((float*)(ws + OFF_TILEE))[(size_t)tile * 1024 + ch0 + tid] = E; }
    __syncthreads();
}

__device__ void rnn2_item(const Params& P, char* lds, int tile, int nb) {
    char* ws = P.ws; bf16_t* MIX = (bf16_t*)(ws + OFF_MIX); const bf16_t* LAT = (const bf16_t*)(ws + OFF_HM); const bf16_t* UT = (const bf16_t*)(ws + OFF_U);
    const float* SEGA = (const float*)(ws + OFF_SEGA); const float* SEGE = (const float*)(ws + OFF_SEGE); const float* TA = (const float*)(ws + OFF_TILEA); const float* TE = (const float*)(ws + OFF_TILEE);
    float* SSR = (float*)(ws + OFF_SS) + MP_;
    float* pa = (float*)lds; float* pe = pa + 512; float* sq = pe + 512; bf16_t* GY = (bf16_t*)(sq + 128 * 129);
    int tid = threadIdx.x; asm volatile("" : "+v"(tid));
    const int s = tid >> 7, c = tid & 127, ch = nb * 128 + c;
    const int t0 = tile * 128, tb = t0 + 32 * s;
    u32x4 gyv[4];
#pragma unroll
    for (int i = 0; i < 4; ++i) { const int id = i * 512 + tid, row = id >> 4, c8 = (id & 15) * 8; gyv[i] = *(const u32x4*)(MIX + (size_t)(t0 + row) * 2048 + 1024 + nb * 128 + c8); }
    u32x4 lav[4], uv[4];
    { const u32x4* lp = (const u32x4*)(LAT + (size_t)ch * T_ + tb); const u32x4* up = (const u32x4*)(UT + (size_t)ch * T_ + tb);
#pragma unroll
      for (int q = 0; q < 4; ++q) { lav[q] = lp[q]; uv[q] = up[q]; } }
    { float A = 1.f, E = 0.f; const int lo = s * 32, hi = min(lo + 32, tile);
      if (lo < hi) { float av[32], ev[32];
#pragma unroll
          for (int i = 0; i < 32; ++i) { const int k = min(lo + i, hi - 1); av[i] = TA[(size_t)k * 1024 + ch]; ev[i] = TE[(size_t)k * 1024 + ch]; }
#pragma unroll
          for (int i = 0; i < 32; ++i) { const bool on = lo + i < hi; const float a = on ? av[i] : 1.f, e = on ? ev[i] : 0.f; E = a * E + e; A *= a; } }
      pa[tid] = A; pe[tid] = E; }
#pragma unroll
    for (int i = 0; i < 4; ++i) { const int id = i * 512 + tid, row = id >> 4, c8 = (id & 15) * 8; *(u32x4*)(GY + row * 136 + c8) = gyv[i]; }
    float sa[3], se[3];
#pragma unroll
    for (int s2 = 0; s2 < 3; ++s2) { const int sx = min(s2, max(s - 1, 0)); sa[s2] = SEGA[(size_t)(tile * 4 + sx) * 1024 + ch]; se[s2] = SEGE[(size_t)(tile * 4 + sx) * 1024 + ch]; }
    __syncthreads();
    float h = 0.f;
#pragma unroll
    for (int q = 0; q < 4; ++q) h = pa[q * 128 + c] * h + pe[q * 128 + c];
#pragma unroll
    for (int s2 = 0; s2 < 3; ++s2) if (s2 < s) h = sa[s2] * h + se[s2];
#pragma unroll
    for (int q = 0; q < 4; ++q) {
        const unsigned lw[4] = {lav[q].x, lav[q].y, lav[q].z, lav[q].w}, uw[4] = {uv[q].x, uv[q].y, uv[q].z, uv[q].w};
#pragma unroll
        for (int p = 0; p < 4; ++p)
#pragma unroll
            for (int hh = 0; hh < 2; ++hh) { const int j = 8 * q + 2 * p + hh; const float la = hh ? bfhi(lw[p]) : bflo(lw[p]), u = hh ? bfhi(uw[p]) : bflo(uw[p]);
                bf16_t* g = GY + (32 * s + j) * 136 + c;
                h = __builtin_amdgcn_exp2f(LOG2E_ * la) * h + u; const float rn = h * bf2f(*g); *g = f2bf(rn); sq[(32 * s + j) * 129 + c] = rn * rn; }
    }
    if (tile == 127 && s == 3) P.out[O_HP + ch] = h;
    __syncthreads();
#pragma unroll
    for (int i = 0; i < 4; ++i) { const int id = i * 512 + tid, row = id >> 4, c8 = (id & 15) * 8; *(u32x4*)(MIX + (size_t)(t0 + row) * 2048 + 1024 + nb * 128 + c8) = *(const u32x4*)(GY + row * 136 + c8); }
    { const int row = tid >> 2, q = tid & 3; float a = 0.f;
#pragma unroll 8
      for (int j = 0; j < 32; ++j) a += sq[row * 129 + q * 32 + ((j + 8 * q) & 31)];
      a += __shfl_xor(a, 1); a += __shfl_xor(a, 2);
      if (q == 0) atomicAdd(SSR + tile * 128 + row, a); }
    __syncthreads();
}

__device__ void state_out_prompt(const Params& P) {
    char* ws = P.ws; const bf16_t* KB = (const bf16_t*)(ws + OFF_KB); const bf16_t* VT = (const bf16_t*)(ws + OFF_VT); const bf16_t* XR = (const bf16_t*)(ws + OFF_XR);
    int tid = threadIdx.x; asm volatile("" : "+v"(tid));
    const size_t gt = (size_t)blockIdx.x * 512 + tid, gs = (size_t)gridDim.x * 512;
    for (size_t i = gt; i < 32768; i += gs) { const int j = (int)(i >> 8), c = (int)(i & 255);
        P.out[O_KP + i] = bf2f(KB[(size_t)(T_ - 128 + j) * 256 + c]); P.out[O_VP + i] = bf2f(VT[(size_t)c * T_ + (T_ - 128 + j)]); }
    for (size_t i = gt; i < 3072; i += gs) P.out[O_CP + i] = bf2f(XR[(size_t)(T_ - 3) * 1024 + i]);
}

template <bool PO>
__device__ __forceinline__ void ld_row16(const bf16_t* B, const float* S, int r, int lane, f32x4 (&o)[4]) {
    if (PO || r < T_) {
        u32x2 w[4];
#pragma unroll
        for (int i = 0; i < 4; ++i) w[i] = *(const u32x2*)(B + (size_t)r * 1024 + i * 256 + lane * 4);
#pragma unroll
        for (int i = 0; i < 4; ++i) o[i] = (f32x4){bflo(w[i].x), bfhi(w[i].x), bflo(w[i].y), bfhi(w[i].y)};
    } else {
        const float* p = S + (size_t)(r - T_) * 1024 + lane * 4;
#pragma unroll
        for (int i = 0; i < 4; ++i) o[i] = (f32x4){0.f, 0.f, 0.f, 0.f};
#pragma unroll
        for (int k0 = 0; k0 < 8; k0 += 2) { f32x4 t[2][4];
#pragma unroll
            for (int k = 0; k < 2; ++k)
#pragma unroll
                for (int i = 0; i < 4; ++i) t[k][i] = *(const f32x4*)(p + (size_t)(k0 + k) * 131072 + i * 256);
#pragma unroll
            for (int i = 0; i < 4; ++i) o[i] += t[0][i] + t[1][i]; }
    }
}
template <bool PO>
__device__ __forceinline__ void phase7_batch(const Params& P, int r0, int nw, int lane) {
    char* ws = P.ws; const float* MOD = (const float*)(ws + OFF_MOD);
    const bf16_t* O = (const bf16_t*)(ws + OFF_XR); bf16_t* H = (bf16_t*)(ws + OFF_HM); const float* OS2 = (const float*)(ws + OFF_OS2);
    f32x4 v[NBR][4], ov[NBR][4]; float sso[NBR], ss[NBR];
#pragma unroll
    for (int b = 0; b < NBR; ++b) { const int r = r0 + b * nw;
        if (PO || r < MR_) { const float* x = xrow(P, r);
#pragma unroll
            for (int i = 0; i < 4; ++i) v[b][i] = __builtin_nontemporal_load((const f32x4*)(x + i * 256 + lane * 4));
            ld_row16<PO>(O, OS2, r, lane, ov[b]); }
        else {
#pragma unroll
            for (int i = 0; i < 4; ++i) { v[b][i] = (f32x4){0.f, 0.f, 0.f, 0.f}; ov[b][i] = (f32x4){0.f, 0.f, 0.f, 0.f}; } } }
#pragma unroll
    for (int b = 0; b < NBR; ++b) { sso[b] = 0.f;
#pragma unroll
        for (int i = 0; i < 4; ++i) sso[b] += (ov[b][i][0] * ov[b][i][0] + ov[b][i][1] * ov[b][i][1]) + (ov[b][i][2] * ov[b][i][2] + ov[b][i][3] * ov[b][i][3]);
        sso[b] = wave_sum(sso[b]); }
#pragma unroll
    for (int b = 0; b < NBR; ++b) { const int r = r0 + b * nw; ss[b] = 0.f; if (!PO && r >= MR_) continue;
        const float* md = MOD + (size_t)modrow(r) * 6144; const float rso = rsqrtf(sso[b] * (1.0f / 1024.0f) + EPS_);
#pragma unroll
        for (int i = 0; i < 4; ++i) { const int c = i * 256 + lane * 4; const f32x4 g1 = *(const f32x4*)(md + 2048 + c), gp = *(const f32x4*)(P.in[I_GPOM] + c);
            v[b][i] = v[b][i] + g1 * ((ov[b][i] * rso) * gp); ss[b] += (v[b][i][0] * v[b][i][0] + v[b][i][1] * v[b][i][1]) + (v[b][i][2] * v[b][i][2] + v[b][i][3] * v[b][i][3]); }
        ss[b] = wave_sum(ss[b]); }
#pragma unroll
    for (int b = 0; b < NBR; ++b) { const int r = r0 + b * nw; if (!PO && r >= MP_) continue;
        if (!PO && r >= MR_) { for (int i = 0; i < 4; ++i) *(u32x2*)(H + (size_t)r * 1024 + i * 256 + lane * 4) = (u32x2){0u, 0u}; continue; }
        const float* md = MOD + (size_t)modrow(r) * 6144; const float rs = rsqrtf(ss[b] * (1.0f / 1024.0f) + EPS_);
#pragma unroll
        for (int i = 0; i < 4; ++i) { const int c = i * 256 + lane * 4; const f32x4 g = *(const f32x4*)(P.in[I_GPF] + c), sh = *(const f32x4*)(md + 3072 + c), sc = *(const f32x4*)(md + 4096 + c);
            __builtin_nontemporal_store(pk4((v[b][i] * rs * g) * (sc + 1.0f) + sh), (u32x2*)(H + (size_t)r * 1024 + c)); } }
}
__device__ void phase7(const Params& P) {
    int tid = threadIdx.x; asm volatile("" : "+v"(tid));
    const int wid = __builtin_amdgcn_readfirstlane(tid >> 6), lane = tid & 63;
    const int nw = gridDim.x * 8;
    for (int r0 = blockIdx.x * 8 + wid; r0 < MP_; r0 += nw * NBR) {
        if (r0 + (NBR - 1) * nw < T_) phase7_batch<true>(P, r0, nw, lane); else phase7_batch<false>(P, r0, nw, lane);
    }
}

constexpr int NB10 = 2;
template <bool PO>
__device__ __forceinline__ void phase10_batch(const Params& P, int r0, int nw, int lane) {
    char* ws = P.ws; const float* MOD = (const float*)(ws + OFF_MOD);
    const bf16_t* O = (const bf16_t*)(ws + OFF_XR); const bf16_t* F = (const bf16_t*)(ws + OFF_HM); const float* OS2 = (const float*)(ws + OFF_OS2); const float* OS4 = (const float*)(ws + OFF_OS4);
    f32x4 xv[NB10][4], ov[NB10][4], fv[NB10][4]; float sso[NB10], ssf[NB10];
#pragma unroll
    for (int b = 0; b < NB10; ++b) { const int r = r0 + b * nw;
        if (PO || r < MR_) { const float* x = xrow(P, r);
#pragma unroll
            for (int i = 0; i < 4; ++i) xv[b][i] = __builtin_nontemporal_load((const f32x4*)(x + i * 256 + lane * 4));
            ld_row16<PO>(O, OS2, r, lane, ov[b]); ld_row16<PO>(F, OS4, r, lane, fv[b]); }
        else {
#pragma unroll
            for (int i = 0; i < 4; ++i) { xv[b][i] = (f32x4){0.f, 0.f, 0.f, 0.f}; ov[b][i] = (f32x4){0.f, 0.f, 0.f, 0.f}; fv[b][i] = (f32x4){0.f, 0.f, 0.f, 0.f}; } } }
#pragma unroll
    for (int b = 0; b < NB10; ++b) { sso[b] = 0.f; ssf[b] = 0.f;
#pragma unroll
        for (int i = 0; i < 4; ++i) { sso[b] += (ov[b][i][0] * ov[b][i][0] + ov[b][i][1] * ov[b][i][1]) + (ov[b][i][2] * ov[b][i][2] + ov[b][i][3] * ov[b][i][3]);
            ssf[b] += (fv[b][i][0] * fv[b][i][0] + fv[b][i][1] * fv[b][i][1]) + (fv[b][i][2] * fv[b][i][2] + fv[b][i][3] * fv[b][i][3]); }
        sso[b] = wave_sum(sso[b]); ssf[b] = wave_sum(ssf[b]); }
#pragma unroll
    for (int b = 0; b < NB10; ++b) { const int r = r0 + b * nw; if (!PO && r >= MR_) continue;
        const float* md = MOD + (size_t)modrow(r) * 6144; float* y = r < T_ ? P.out + O_YP + (size_t)r * 1024 : P.out + O_YS + (size_t)(r - T_) * 1024;
        const float rso = rsqrtf(sso[b] * (1.0f / 1024.0f) + EPS_), rsf = rsqrtf(ssf[b] * (1.0f / 1024.0f) + EPS_);
#pragma unroll
        for (int i = 0; i < 4; ++i) { const int c = i * 256 + lane * 4;
            const f32x4 g1 = *(const f32x4*)(md + 2048 + c), gp = *(const f32x4*)(P.in[I_GPOM] + c), g2 = *(const f32x4*)(md + 5120 + c), gf = *(const f32x4*)(P.in[I_GPOF] + c);
            const f32x4 x1 = xv[b][i] + g1 * ((ov[b][i] * rso) * gp);
            __builtin_nontemporal_store(x1 + g2 * ((fv[b][i] * rsf) * gf), (f32x4*)(y + c)); } }
}
constexpr int NBF = 3;
__device__ __forceinline__ f32x4 up4(const u32x2 w) { return (f32x4){bflo(w.x), bfhi(w.x), bflo(w.y), bfhi(w.y)}; }
__device__ __forceinline__ void phase10_fast(const Params& P, int r0, int nw, int lane) {
    char* ws = P.ws; const float* md = (const float*)(ws + OFF_MOD);
    const bf16_t* O = (const bf16_t*)(ws + OFF_XR); const bf16_t* F = (const bf16_t*)(ws + OFF_HM);
    f32x4 xv[NBF][4]; u32x2 ow[NBF][4], fw[NBF][4]; float sso[NBF], ssf[NBF];
#pragma unroll
    for (int b = 0; b < NBF; ++b) { const int r = r0 + b * nw; const float* x = P.in[I_XP] + (size_t)r * 1024;
#pragma unroll
        for (int i = 0; i < 4; ++i) { const int c = i * 256 + lane * 4; xv[b][i] = __builtin_nontemporal_load((const f32x4*)(x + c));
            ow[b][i] = *(const u32x2*)(O + (size_t)r * 1024 + c); fw[b][i] = *(const u32x2*)(F + (size_t)r * 1024 + c); } }
#pragma unroll
    for (int b = 0; b < NBF; ++b) { sso[b] = 0.f; ssf[b] = 0.f;
#pragma unroll
        for (int i = 0; i < 4; ++i) { const f32x4 o = up4(ow[b][i]), f = up4(fw[b][i]);
            sso[b] += (o[0] * o[0] + o[1] * o[1]) + (o[2] * o[2] + o[3] * o[3]); ssf[b] += (f[0] * f[0] + f[1] * f[1]) + (f[2] * f[2] + f[3] * f[3]); }
        sso[b] = wave_sum(sso[b]); ssf[b] = wave_sum(ssf[b]); }
#pragma unroll
    for (int i = 0; i < 4; ++i) { const int c = i * 256 + lane * 4;
        const f32x4 g1 = *(const f32x4*)(md + 2048 + c), gp = *(const f32x4*)(P.in[I_GPOM] + c), g2 = *(const f32x4*)(md + 5120 + c), gf = *(const f32x4*)(P.in[I_GPOF] + c);
        const f32x4 a1 = g1 * gp, a2 = g2 * gf;
#pragma unroll
        for (int b = 0; b < NBF; ++b) { const int r = r0 + b * nw;
            const float rso = rsqrtf(sso[b] * (1.0f / 1024.0f) + EPS_), rsf = rsqrtf(ssf[b] * (1.0f / 1024.0f) + EPS_);
            const f32x4 x1 = xv[b][i] + a1 * (up4(ow[b][i]) * rso);
            __builtin_nontemporal_store(x1 + a2 * (up4(fw[b][i]) * rsf), (f32x4*)(P.out + O_YP + (size_t)r * 1024 + c)); } }
}
__device__ void phase10(const Params& P) {
    int tid = threadIdx.x; asm volatile("" : "+v"(tid));
    const int wid = __builtin_amdgcn_readfirstlane(tid >> 6), lane = tid & 63;
    const int nw = gridDim.x * 8;
    int r0 = blockIdx.x * 8 + wid;
    for (; r0 + (NBF - 1) * nw < T_; r0 += nw * NBF) phase10_fast(P, r0, nw, lane);
    for (; r0 < MR_; r0 += nw * NB10) {
        if (r0 + (NB10 - 1) * nw < T_) phase10_batch<true>(P, r0, nw, lane); else phase10_batch<false>(P, r0, nw, lane);
    }
}

#define XB_TMO      128
#define XB_XCNT(j)  (256  + 64 * (j))
#define XB_XSUB(j)  (1280 + 64 * (j))
#define XB_XGEN(j)  (2304 + 64 * (j))
#define XB_TOP      3328
#define XB_TOPGEN   3392
#define XCD_BAR_WORDS 3456
#define XB_SPIN_CAP (1u << 22)
__device__ __forceinline__ unsigned xb_ld(unsigned* p)              { return __hip_atomic_load(p, __ATOMIC_RELAXED, __HIP_MEMORY_SCOPE_AGENT); }
__device__ __forceinline__ unsigned xb_add(unsigned* p, unsigned v) { return __hip_atomic_fetch_add(p, v, __ATOMIC_RELAXED, __HIP_MEMORY_SCOPE_AGENT); }
__device__ __forceinline__ unsigned xb_xcc_id() { return (unsigned)__builtin_amdgcn_s_getreg((3 << 11) | 20) & 0xFu; }
#define XB_SPIN(cond, bar) do { unsigned _sp = 0; while (cond) { __builtin_amdgcn_s_sleep(1); \
    if ((++_sp & 255u) == 0u) { if (xb_ld(&(bar)[XB_TMO])) break; if (_sp > XB_SPIN_CAP) { atomicAdd(&(bar)[XB_TMO], 1u); break; } } } } while (0)
struct XcdBarrier { unsigned* bar; unsigned x; volatile LAS unsigned* st; };
__device__ __forceinline__ XcdBarrier xcd_barrier_post(unsigned* bar, volatile LAS unsigned* st) {
    XcdBarrier b; b.bar = bar; b.x = xb_xcc_id(); b.st = st;
    if (threadIdx.x == 0) (void)xb_add(&bar[XB_XCNT(b.x)], 1u);
    return b;
}
__device__ __forceinline__ void xcd_barrier_complete(unsigned* bar, unsigned x, unsigned& nloc, unsigned& nx) {
    const unsigned G = gridDim.x * gridDim.y * gridDim.z;
    unsigned sum, cnt, mine, sp = 0u;
    for (;;) {
        sum = 0u; cnt = 0u; mine = 0u;
#pragma unroll
        for (unsigned j = 0; j < 16; ++j) { const unsigned c = xb_ld(&bar[XB_XCNT(j)]); sum += c; cnt += (c > 0u) ? 1u : 0u; mine = (j == x) ? c : mine; }
        if (sum == G) break;
        __builtin_amdgcn_s_sleep(1);
        if ((++sp & 255u) == 0u) { if (xb_ld(&bar[XB_TMO])) break; if (sp > XB_SPIN_CAP) { atomicAdd(&bar[XB_TMO], 1u); break; } }
    }
    nloc = mine > 0u ? mine : 1u; nx = cnt > 0u ? cnt : 1u;
}
__device__ __forceinline__ void xcd_barrier(const XcdBarrier& b) {
    asm volatile("s_waitcnt vmcnt(0)" ::: "memory");
    __syncthreads();
    if (threadIdx.x == 0) {
        unsigned* bar = b.bar;
        __builtin_amdgcn_s_waitcnt(0);
        unsigned nloc = b.st[0], nx = b.st[1];
        if (nloc == 0u) { xcd_barrier_complete(bar, b.x, nloc, nx); b.st[0] = nloc; b.st[1] = nx; }
        const unsigned old = xb_add(&bar[XB_XSUB(b.x)], 1u);
        const unsigned gen = old / nloc;
        if (old + 1u == (gen + 1u) * nloc) {
            __builtin_amdgcn_fence(__ATOMIC_RELEASE, "agent");
            asm volatile("s_waitcnt vmcnt(0)" ::: "memory");
            const unsigned og = xb_add(&bar[XB_TOP], 1u);
            const unsigned tg = og / nx;
            if (og + 1u == (tg + 1u) * nx) xb_add(&bar[XB_TOPGEN], 1u);
            else XB_SPIN(xb_ld(&bar[XB_TOPGEN]) == tg, bar);
            __builtin_amdgcn_fence(__ATOMIC_ACQUIRE, "agent");
            xb_add(&bar[XB_XGEN(b.x)], 1u);
            asm volatile("s_waitcnt vmcnt(0)" ::: "memory");
        } else {
            XB_SPIN(xb_ld(&bar[XB_XGEN(b.x)]) == gen, bar);
            __builtin_amdgcn_fence(__ATOMIC_ACQUIRE, "agent");
            asm volatile("s_waitcnt vmcnt(0)" ::: "memory");
        }
    }
    __syncthreads();
}

template <bool COOP>
__global__ void __launch_bounds__(512) hymba_mega(Params P, int ph_lo, int ph_hi) {
    extern __shared__ __attribute__((aligned(16))) char lds_raw[];
    LAS unsigned char* lds = (LAS unsigned char*)lds_raw;
    char* ws = P.ws; const int G = gridDim.x, bid = blockIdx.x;
    XcdBarrier xb; xb.bar = (unsigned*)(ws + OFF_BAR); xb.x = 0; xb.st = (volatile LAS unsigned*)(lds + LDS_BYTES - 16);
    if (COOP) { if (threadIdx.x == 0) { xb.st[0] = 0u; xb.st[1] = 0u; } __syncthreads(); xb = xcd_barrier_post((unsigned*)(ws + OFF_BAR), (volatile LAS unsigned*)(lds + LDS_BYTES - 16)); }
#if MK_PROBE
    unsigned long long tprev = __builtin_amdgcn_s_memrealtime(), tacc = 0ull;
#endif
#if MK_PROBE_ID
    unsigned long long tacc2 = 0ull;
#endif
    for (int ph = ph_lo; ph < ph_hi; ++ph) {
        switch (ph) {
        case 0: if constexpr (PH_ON(0)) phase0(P, (float*)lds_raw); break;
        case 1: if constexpr (PH_ON(1)) phase1(P, lds, (float*)lds_raw); break;
        case 2: if constexpr (PH_ON(2)) phase2(P); break;
        case 3: if constexpr (PH_ON(3)) { Gemm g{(const bf16_t*)(ws + OFF_HM), (const bf16_t*)(ws + OFF_WT_IN), 1024}; Sched S; S.init(65, 14, G, bid);
                  Epi1 E{(bf16_t*)(ws + OFF_MIX), (bf16_t*)(ws + OFF_KB), (bf16_t*)(ws + OFF_VT), (bf16_t*)(ws + OFF_VSB), (bf16_t*)(ws + OFF_XR)};
                  PB_BEGIN(5); gemm_phase<Epi1, false, false>(lds, g, S, E); PB_END(5); } break;
        case 4: if constexpr (PH_ON(4)) { PB_BEGIN(7); if (P4B(0)) for (int it = bid; it < 256; it += G) attn_prompt_item(P, lds_raw, it >> 1, it & 1); PB_END(7);
                  PB_BEGIN(8); if (P4B(1)) for (int it = bid; it < 256; it += G) attn_sample_item(P, lds_raw, it >> 1, it & 1); PB_END(8);
                  PB_BEGIN(9); if (P4B(2)) for (int it = bid; it < 1024 + 64; it += G) { if (it < 1024) rnn1_item<false>(P, lds_raw, it >> 3, it & 7, 0); else rnn1_item<true>(P, lds_raw, 128, (it - 1024) & 7, (it - 1024) >> 3); } PB_END(9);
                  state_out_prompt(P); } break;
        case 5: if constexpr (PH_ON(5)) { for (int it = bid; it < 128 * 8; it += G) rnn2_item(P, lds_raw, it >> 3, it & 7); } break;
        case 6: if constexpr (PH_ON(6)) { Gemm g{(const bf16_t*)(ws + OFF_MIX), (const bf16_t*)(ws + OFF_WT_OUT), 2048}; Sched S; S.init(64, 4, G, bid);
                  Epi2 E{(bf16_t*)(ws + OFF_XR), (const float*)(ws + OFF_SS), (const float*)(ws + OFF_SS) + MP_};
                  PB_BEGIN(1); gemm_phase<Epi2, false, true>(lds, g, S, E); PB_END(1);
                  PB_BEGIN(2); for (int it = bid; it < 256; it += G) small_gemm_item<8>((const bf16_t*)(ws + OFF_MIX) + (size_t)T_ * 2048, 2048, (const bf16_t*)(ws + OFF_WT_OUT), 2048, (float*)(ws + OFF_OS2), it >> 3, it & 7,
                                                                          (const float*)(ws + OFF_SS) + ((it & 7) < 4 ? 0 : MP_) + T_); PB_END(2); } break;
        case 7: if constexpr (PH_ON(7)) phase7(P); break;
        case 8: if constexpr (PH_ON(8)) { Gemm g{(const bf16_t*)(ws + OFF_HM), (const bf16_t*)(ws + OFF_WT_UP), 1024}; Sched S; S.init(67, 22, G, bid);
                  Epi3 E{(bf16_t*)(ws + OFF_MIX), P.in[I_FCW], P.in[I_FCB], P.in[I_SF], P.out};
                  PB_BEGIN(6); gemm_phase<Epi3, true, false>(lds, g, S, E); PB_END(6); } break;
        case 9: if constexpr (PH_ON(9)) { Gemm g{(const bf16_t*)(ws + OFF_MIX), (const bf16_t*)(ws + OFF_WT_DOWN), 2816}; Sched S; S.init(64, 4, G, bid);
                  Epi4 E{(bf16_t*)(ws + OFF_HM)};
                  PB_BEGIN(3); gemm_phase<Epi4, false, false>(lds, g, S, E); PB_END(3);
                  PB_BEGIN(4); for (int it = bid; it < 256; it += G) small_gemm_item<11>((const bf16_t*)(ws + OFF_MIX) + (size_t)T_ * 2816, 2816, (const bf16_t*)(ws + OFF_WT_DOWN), 2816, (float*)(ws + OFF_OS4), it >> 3, it & 7, nullptr); PB_END(4); } break;
        case 10: if constexpr (PH_ON(10)) phase10(P); break;
        }
        if (COOP) { if (ph + 1 < ph_hi) xcd_barrier(xb); }
#if MK_PROBE
        { const unsigned long long tn = __builtin_amdgcn_s_memrealtime(); if ((MK_PROBE >> ph) & 1) tacc += tn - tprev; tprev = tn; }
#endif
    }
#if MK_PROBE_ID
    if (bid == 0 && threadIdx.x == 0) { const unsigned long long t0 = __builtin_amdgcn_s_memrealtime(); while (__builtin_amdgcn_s_memrealtime() - t0 < 4ull * tacc2) __builtin_amdgcn_s_sleep(8); }
#endif
#if MK_PROBE
    if (bid == 0 && threadIdx.x == 0) { const unsigned long long t0 = __builtin_amdgcn_s_memrealtime(); while (__builtin_amdgcn_s_memrealtime() - t0 < 4ull * tacc) __builtin_amdgcn_s_sleep(8); }
#endif
}

extern "C" void kernel_launch(void* const* d_in, const int* in_sizes, int n_in, void* d_out, int out_size, void* d_ws, size_t ws_size, hipStream_t stream) {
    (void)in_sizes; (void)out_size;
    if (n_in != 31 || ws_size < WS_NEED) { fprintf(stderr, "hymba_mega: bad arguments (n_in %d, ws %zu < %zu)\n", n_in, ws_size, (size_t)WS_NEED); return; }
    Params P{};
    for (int i = 0; i < 31; ++i) P.in[i] = (const float*)d_in[i];
    P.out = (float*)d_out; P.ws = (char*)d_ws;
#if MK_COOP
    static int grid_blocks = 0;
    if (!grid_blocks) {
        (void)hipFuncSetAttribute((const void*)hymba_mega<true>, hipFuncAttributeMaxDynamicSharedMemorySize, LDS_BYTES);
        int dev = 0, cus = 0, per_cu = 0; (void)hipGetDevice(&dev); (void)hipDeviceGetAttribute(&cus, hipDeviceAttributeMultiprocessorCount, dev);
        (void)hipOccupancyMaxActiveBlocksPerMultiprocessor(&per_cu, (const void*)hymba_mega<true>, 512, LDS_BYTES);
        if (per_cu < 1) per_cu = 1; if (per_cu > 1) per_cu = 1;
        grid_blocks = cus * per_cu;
    }
    (void)hipMemsetAsync((char*)d_ws + OFF_BAR, 0, 16384, stream);
    int lo = 0, hi = 11; void* args[] = {&P, &lo, &hi};
    hipError_t e = hipLaunchCooperativeKernel((const void*)hymba_mega<true>, dim3(grid_blocks), dim3(512), args, LDS_BYTES, stream);
    if (e != hipSuccess) fprintf(stderr, "cooperative launch failed: %s (grid %d)\n", hipGetErrorString(e), grid_blocks);
#else
    static bool attr = false;
    if (!attr) { attr = true; (void)hipFuncSetAttribute((const void*)hymba_mega<false>, hipFuncAttributeMaxDynamicSharedMemorySize, LDS_BYTES); }
    for (int ph = 0; ph < 11; ++ph) hymba_mega<false><<<dim3(256), dim3(512), LDS_BYTES, stream>>>(P, ph, ph + 1);
#endif
}
```

```cpp
#include <hip/hip_runtime.h>
#include <hip/hip_cooperative_groups.h>
#include <cstdio>
#include <cstdint>
namespace cg = cooperative_groups;

#ifndef MK_COOP
#define MK_COOP 1
#endif
#ifndef MK_PROBE
#define MK_PROBE 0
#endif
#ifndef MK_PROBE_ID
#define MK_PROBE_ID 0
#endif
#if MK_PROBE_ID
#define PB_BEGIN(id) unsigned long long _pb##id = 0; if (((MK_PROBE_ID) >> (id)) & 1) _pb##id = __builtin_amdgcn_s_memrealtime()
#define PB_END(id) if (((MK_PROBE_ID) >> (id)) & 1) tacc2 += __builtin_amdgcn_s_memrealtime() - _pb##id
#else
#define PB_BEGIN(id)
#define PB_END(id)
#endif
#ifndef MK_PHMASK
#define MK_PHMASK 0x7ff
#endif
#define PH_ON(x) (((MK_PHMASK) >> (x)) & 1)

#define LAS __attribute__((address_space(3)))
typedef unsigned short bf16_t;
typedef short bf16x8 __attribute__((ext_vector_type(8)));
typedef short s16x4 __attribute__((ext_vector_type(4)));
typedef float f32x4 __attribute__((ext_vector_type(4)));
typedef float f32x16 __attribute__((ext_vector_type(16)));
typedef unsigned u32x4 __attribute__((ext_vector_type(4)));
typedef unsigned u32x2 __attribute__((ext_vector_type(2)));

constexpr int T_ = 16384, SB_ = 128, MR_ = 16512, MP_ = 16640;
constexpr float EPS_ = 1e-6f;
constexpr float LOG2E_ = 1.4426950408889634f;
constexpr float QSCALE_ = 0.08838834764831845f * 1.4426950408889634f;
constexpr int LDS_BYTES = 140288;

constexpr size_t OFF_WT_ADA = 0;
constexpr size_t OFF_A_ADA = OFF_WT_ADA + (size_t)6144 * 1024 * 2;
constexpr size_t OFF_MOD = OFF_A_ADA + (size_t)256 * 1024 * 2;
constexpr size_t OFF_WT_IN = OFF_MOD + (size_t)256 * 6144 * 4;
constexpr size_t OFF_WT_OUT = OFF_WT_IN + (size_t)3584 * 1024 * 2;
constexpr size_t OFF_WT_UP = OFF_WT_OUT + (size_t)1024 * 2048 * 2;
constexpr size_t OFF_WT_DOWN = OFF_WT_UP + (size_t)5632 * 1024 * 2;
constexpr size_t OFF_WT_A = OFF_WT_DOWN + (size_t)1024 * 2816 * 2;
constexpr size_t OFF_WT_I = OFF_WT_A + (size_t)8 * 128 * 128 * 2;
constexpr size_t OFF_SP8 = OFF_WT_I + (size_t)8 * 128 * 128 * 2;
constexpr size_t OFF_SS = OFF_SP8 + 4096;
constexpr size_t OFF_SEGA = OFF_SS + (size_t)4 * MP_ * 4;
constexpr size_t OFF_SEGE = OFF_SEGA + (size_t)512 * 1024 * 4;
constexpr size_t OFF_TILEA = OFF_SEGE + (size_t)512 * 1024 * 4;
constexpr size_t OFF_TILEE = OFF_TILEA + (size_t)128 * 1024 * 4;
constexpr size_t OFF_VSB = OFF_TILEE + (size_t)128 * 1024 * 4;
constexpr size_t OFF_OS2 = OFF_VSB + (size_t)256 * 256 * 2;
constexpr size_t OFF_OS4 = OFF_OS2 + (size_t)8 * 128 * 1024 * 4;
constexpr size_t OFF_BAR = OFF_OS4 + (size_t)8 * 128 * 1024 * 4;
constexpr size_t OFF_MIX = OFF_BAR + 16384;
constexpr size_t OFF_U = OFF_MIX + (size_t)MP_ * 2048 * 2;
constexpr size_t OFF_KB = OFF_U + (size_t)MP_ * 1024 * 2;
constexpr size_t OFF_VT = OFF_KB + (size_t)MP_ * 256 * 2;
constexpr size_t OFF_XR = OFF_VT + (size_t)256 * T_ * 2;
constexpr size_t OFF_HM0 = OFF_XR + (size_t)MP_ * 1024 * 2;
constexpr size_t OFF_HM = OFF_HM0 + 4096;
constexpr size_t WS_NEED = OFF_HM + (size_t)MP_ * 1024 * 2;
static_assert(WS_NEED <= (size_t)256 * 1024 * 1024, "workspace");
static_assert(OFF_MIX + (size_t)MP_ * 2816 * 2 <= OFF_KB, "FIN alias");

constexpr size_t O_YP = 0, O_YS = O_YP + (size_t)T_ * 1024, O_KP = O_YS + 128 * 1024, O_VP = O_KP + 32768, O_HP = O_VP + 32768,
                 O_CP = O_HP + 1024, O_FP = O_CP + 3072, O_KS = O_FP + 11264, O_VS = O_KS + 4194304, O_HS = O_VS + 4194304,
                 O_CS = O_HS + 131072, O_FS = O_CS + 393216;

struct Params { const float* in[31]; float* out; char* ws; };
enum { I_XP = 0, I_XS, I_CK, I_CV, I_SH, I_SC, I_SF, I_CP, I_CS, I_WADA, I_BADA, I_GPM, I_WIN, I_CW, I_CB, I_WA, I_BA, I_WI, I_BI, I_LAM, I_SINK,
       I_GAO, I_GRO, I_WOUT, I_GPOM, I_GPF, I_WUP, I_FCW, I_FCB, I_WDOWN, I_GPOF };

__device__ __forceinline__ unsigned cvt_pk_bf16(float lo, float hi) { unsigned r; asm volatile("v_cvt_pk_bf16_f32 %0, %1, %2" : "=v"(r) : "v"(lo), "v"(hi)); return r; }
__device__ __forceinline__ float bf2f(unsigned b) { return __uint_as_float(b << 16); }
__device__ __forceinline__ float bflo(unsigned w) { return __uint_as_float(w << 16); }
__device__ __forceinline__ float bfhi(unsigned w) { return __uint_as_float(w & 0xffff0000u); }
__device__ __forceinline__ bf16_t f2bf(float f) { return (bf16_t)(cvt_pk_bf16(f, 0.f) & 0xffffu); }
__device__ __forceinline__ float gelu_t(float x) { const float u = x * (1.0f + 0.044715f * x * x); const float e = __builtin_amdgcn_exp2f(-2.302208198f * u); return x * __builtin_amdgcn_rcpf(1.0f + e); }
__device__ __forceinline__ float sigmoid_f(float x) { return __builtin_amdgcn_rcpf(1.0f + __builtin_amdgcn_exp2f(-LOG2E_ * x)); }
__device__ __forceinline__ float wave_sum(float v) { v += __shfl_xor(v, 1); v += __shfl_xor(v, 2); v += __shfl_xor(v, 4); v += __shfl_xor(v, 8); v += __shfl_xor(v, 16); v += __shfl_xor(v, 32); return v; }
__device__ __forceinline__ int modrow(int r) { return r < T_ ? 0 : r - T_ + 1; }

constexpr int BM = 256, BK = 64, HALF = 128, HTB = HALF * BK * 2, STAGE_BYTES = 8 * HTB, NXCD = 8, WGM = 8;
__device__ __forceinline__ int lds_byte(int r, int c) { const int st = (r >> 4) * 2 + (c >> 5), rr = r & 15, cc = c & 31, ob = rr * 64 + cc * 2; return st * 1024 + (ob ^ (((ob >> 9) & 1) << 5)); }
__device__ __forceinline__ void stage_rc(int b, int& R, int& C) { const int st = b / 1024, sb = b % 1024, swz = sb ^ (((sb >> 9) & 1) << 5); R = (st >> 1) * 16 + swz / 64; C = (st & 1) * 32 + (swz % 64) / 2; }
struct Unit { int pm, pn; };
struct Gemm { const bf16_t* A; const bf16_t* Bt; int K; };
struct Sched {
    int nM, nN, nwg, G, c;
    __device__ void init(int nM_, int nN_, int G_, int c_) { nM = nM_; nN = nN_; nwg = nM * nN; G = G_; c = c_; }
    __device__ bool next(int i, Unit& u) const {
        const long L = (long)i * G + c; if (L >= nwg) return false;
        int wgid = (int)L; { const int q = nwg / NXCD, r = nwg % NXCD, xcd = wgid % NXCD, off = wgid / NXCD; wgid = (xcd < r ? xcd * (q + 1) : r * (q + 1) + (xcd - r) * q) + off; }
        const int nig = WGM * nN, gid = wgid / nig, fm = gid * WGM, gsz = (nM - fm) < WGM ? (nM - fm) : WGM;
        u.pm = fm + ((wgid % nig) % gsz); u.pn = (wgid % nig) / gsz; return true;
    }
};
template <bool APERM> __device__ __forceinline__ size_t tileA_off(int pm, int K) {
    if (APERM) return (size_t)(pm < 66 ? 252 * pm : 16386) * (size_t)K * 2 - (size_t)2 * K * 2;
    return (size_t)pm * 256 * (size_t)K * 2;
}

template <class Epi, bool APERM, bool MID>
__device__ __forceinline__ void gemm_phase(LAS unsigned char* lds, const Gemm g, const Sched& S, const Epi& E) {
    int tid = threadIdx.x; asm volatile("" : "+v"(tid));
    const int wid = __builtin_amdgcn_readfirstlane(tid >> 6), lane = tid & 63, wr = wid >> 2, wc = wid & 3, fr = lane & 15, fq = lane >> 4;
    const int K = g.K, nt = K / BK;
    unsigned voffA[2], voffB[2];
#pragma unroll
    for (int i = 0; i < 2; ++i) { int R, C; stage_rc(tid * 16 + i * 8192, R, C);
        const int Ra = APERM ? (126 * (R >> 6) + 8 * (R & 15) + ((R >> 4) & 3)) : R;
        voffA[i] = (unsigned)(Ra * K + C) * 2u; voffB[i] = (unsigned)(R * K + C) * 2u; }
    const size_t kstep = (size_t)(BK * 2);
    const size_t hstepB = (size_t)HALF * K * 2;
    const size_t hstepA = APERM ? (size_t)4 * K * 2 : hstepB;
    const size_t tstepB = 2 * hstepB;
    const unsigned ldsw = (unsigned)wid * 1024u;
    const int aoff = lds_byte(wr * 64 + fr, fq * 8), boff = lds_byte(wc * 32 + fr, fq * 8);
#define PG8_SA(b, h) (((b) * 2 + (h)) * HTB)
#define PG8_SB(b, h) ((4 + (b) * 2 + (h)) * HTB)
#define PG8_STAGE(bufoff, gbase, voff) do { _Pragma("unroll") for (int _i = 0; _i < 2; ++_i) \
        __builtin_amdgcn_global_load_lds((const unsigned*)((const char*)(gbase) + (voff)[_i]), (LAS unsigned*)(lds + (bufoff) + ldsw + _i * 8192), 16, 0, 0); } while (0)
#define PG8_LDA(dst, b, h) do { _Pragma("unroll") for (int m = 0; m < 4; ++m) _Pragma("unroll") for (int k = 0; k < 2; ++k) dst[m][k] = *(const LAS bf16x8*)(lds + PG8_SA(b, h) + aoff + m * 2048 + k * 1024); } while (0)
#define PG8_LDB(dst, b, h) do { _Pragma("unroll") for (int n = 0; n < 2; ++n) _Pragma("unroll") for (int k = 0; k < 2; ++k) dst[n][k] = *(const LAS bf16x8*)(lds + PG8_SB(b, h) + boff + n * 2048 + k * 1024); } while (0)
#define PG8_MMA(ai, bj, At, Bt) do { __builtin_amdgcn_s_setprio(1); _Pragma("unroll") for (int m = 0; m < 4; ++m) _Pragma("unroll") for (int n = 0; n < 2; ++n) _Pragma("unroll") for (int k = 0; k < 2; ++k) \
        acc[ai][bj][m][n] = __builtin_amdgcn_mfma_f32_16x16x32_bf16(Bt[n][k], At[m][k], acc[ai][bj][m][n], 0, 0, 0); __builtin_amdgcn_s_setprio(0); } while (0)
#define PG8_WAIT_V(n) asm volatile("s_waitcnt vmcnt(" #n ")" ::: "memory")
#define PG8_WAIT_L(n) asm volatile("s_waitcnt lgkmcnt(" #n ")" ::: "memory")
#define PG8_BAR __builtin_amdgcn_s_barrier()
#define PG8_SCHED __builtin_amdgcn_sched_barrier(0)
    Unit cur, nxt; int ui = 0;
    if (!S.next(0, cur)) return;
    f32x4 acc[2][2][4][2];
#pragma unroll
    for (int a = 0; a < 2; ++a)
#pragma unroll
        for (int b = 0; b < 2; ++b)
#pragma unroll
            for (int m = 0; m < 4; ++m)
#pragma unroll
                for (int n = 0; n < 2; ++n) acc[a][b][m][n] = (f32x4){0.f, 0.f, 0.f, 0.f};
    bf16x8 At[4][2], B0[2][2], B1[2][2];
    const char* cA = (const char*)g.A + tileA_off<APERM>(cur.pm, K); const char* cB = (const char*)g.Bt + (size_t)cur.pn * tstepB;
    PG8_STAGE(PG8_SB(0, 0), cB, voffB); PG8_STAGE(PG8_SA(0, 0), cA, voffA); PG8_STAGE(PG8_SB(0, 1), cB + hstepB, voffB); PG8_STAGE(PG8_SA(0, 1), cA + hstepA, voffA);
    if (wr == 1) PG8_BAR;
    PG8_WAIT_V(4); PG8_BAR;
    PG8_STAGE(PG8_SB(1, 0), cB + kstep, voffB); PG8_STAGE(PG8_SA(1, 0), cA + kstep, voffA); PG8_STAGE(PG8_SB(1, 1), cB + hstepB + kstep, voffB);
    PG8_WAIT_V(6); PG8_BAR;
    for (;;) {
        const bool has_next = S.next(ui + 1, nxt);
        const char* nA = has_next ? (const char*)g.A + tileA_off<APERM>(nxt.pm, K) : cA; const char* nB = has_next ? (const char*)g.Bt + (size_t)nxt.pn * tstepB : cB;
        for (int t = 0; t < nt; t += 2) {
            const bool last = (t == nt - 2);
            const char* a1 = cA + (size_t)(t + 1) * kstep;
            const char* a2 = last ? nA : cA + (size_t)(t + 2) * kstep; const char* b2 = last ? nB : cB + (size_t)(t + 2) * kstep;
            const char* a3 = a2 + kstep; const char* b3 = b2 + kstep;
            if constexpr (MID) { if (t == (nt >> 1)) E.mid(acc, cur, wr, fr); }
            PG8_LDB(B0, 0, 0); PG8_SCHED; PG8_LDA(At, 0, 0); PG8_STAGE(PG8_SA(1, 1), a1 + hstepA, voffA);
            PG8_WAIT_L(8); PG8_BAR; PG8_WAIT_L(0); PG8_MMA(0, 0, At, B0); PG8_BAR; PG8_SCHED;
            PG8_LDB(B1, 0, 1); PG8_STAGE(PG8_SB(0, 0), b2, voffB);
            PG8_BAR; PG8_WAIT_L(0); PG8_MMA(0, 1, At, B1); PG8_BAR;
            PG8_LDA(At, 0, 1); PG8_STAGE(PG8_SA(0, 0), a2, voffA);
            PG8_BAR; PG8_WAIT_L(0); PG8_MMA(1, 0, At, B0); PG8_BAR; PG8_SCHED;
            PG8_STAGE(PG8_SB(0, 1), b2 + hstepB, voffB);
            PG8_WAIT_V(6); PG8_BAR; PG8_MMA(1, 1, At, B1); PG8_BAR;
            PG8_LDB(B0, 1, 0); PG8_SCHED; PG8_LDA(At, 1, 0); PG8_STAGE(PG8_SA(0, 1), a2 + hstepA, voffA);
            PG8_WAIT_L(8); PG8_BAR; PG8_WAIT_L(0); PG8_MMA(0, 0, At, B0); PG8_BAR; PG8_SCHED;
            PG8_LDB(B1, 1, 1); PG8_STAGE(PG8_SB(1, 0), b3, voffB);
            PG8_BAR; PG8_WAIT_L(0); PG8_MMA(0, 1, At, B1); PG8_BAR;
            PG8_LDA(At, 1, 1); PG8_STAGE(PG8_SA(1, 0), a3, voffA);
            PG8_BAR; PG8_WAIT_L(0); PG8_MMA(1, 0, At, B0); PG8_BAR; PG8_SCHED;
            PG8_STAGE(PG8_SB(1, 1), b3 + hstepB, voffB);
            PG8_WAIT_V(6); PG8_BAR; PG8_MMA(1, 1, At, B1); PG8_BAR;
        }
        E(acc, cur, wr, wc, fr, fq);
        if (!has_next) break;
#pragma unroll
        for (int a = 0; a < 2; ++a)
#pragma unroll
            for (int b = 0; b < 2; ++b)
#pragma unroll
                for (int m = 0; m < 4; ++m)
#pragma unroll
                    for (int n = 0; n < 2; ++n) acc[a][b][m][n] = (f32x4){0.f, 0.f, 0.f, 0.f};
        cur = nxt; cA = nA; cB = nB; ++ui;
    }
    PG8_WAIT_V(0);
    if (wr == 0) PG8_BAR;
    PG8_BAR;
#undef PG8_SA
#undef PG8_SB
#undef PG8_STAGE
#undef PG8_LDA
#undef PG8_LDB
#undef PG8_MMA
#undef PG8_WAIT_V
#undef PG8_WAIT_L
#undef PG8_BAR
#undef PG8_SCHED
}

typedef f32x4 AccT[2][2][4][2];

#ifndef E1MASK
#define E1MASK 31
#endif
#define E1B(x) (((E1MASK) >> (x)) & 1)
#ifndef P4MASK
#define P4MASK 7
#endif
#define P4B(x) (((P4MASK) >> (x)) & 1)
#define EPI_FENCE() asm volatile("" ::: "memory")
__device__ __forceinline__ u32x2 pk4(const f32x4 v) { u32x2 w; w.x = cvt_pk_bf16(v[0], v[1]); w.y = cvt_pk_bf16(v[2], v[3]); return w; }

struct EpiAda {
    float* C; const float* bias;
    __device__ __forceinline__ void operator()(const AccT& acc, const Unit& u, int wr, int wc, int fr, int fq) const {
        const int col0 = u.pn * BM + wc * 32 + 4 * fq;
        float* base = C + (size_t)(u.pm * BM + wr * 64 + fr) * 6144 + col0; const float* bp = bias + col0;
#pragma unroll
        for (int bj = 0; bj < 2; ++bj)
#pragma unroll
            for (int n = 0; n < 2; ++n) { const f32x4 bv = *(const f32x4*)(bp + bj * HALF + n * 16);
#pragma unroll
                for (int ai = 0; ai < 2; ++ai)
#pragma unroll
                    for (int m = 0; m < 4; ++m) *(f32x4*)(base + (size_t)(ai * HALF + m * 16) * 6144 + bj * HALF + n * 16) = acc[ai][bj][m][n] + bv;
                EPI_FENCE(); }
    }
};

struct Epi1 {
    bf16_t* MIX; bf16_t* KB; bf16_t* VT; bf16_t* VSB; bf16_t* XR;
    __device__ __forceinline__ void operator()(const AccT& acc, const Unit& u, int wr, int wc, int fr, int fq) const {
        const int rl = wr * 64 + fr, row0 = u.pm * BM + rl, cw = wc * 32 + 4 * fq; const int pn = u.pn, pm = u.pm;
        if (pn == 5 && pm < 64) {
            bf16_t* cp0 = VT + (size_t)cw * T_ + row0;
#pragma unroll
            for (int bj = 0; bj < 2; ++bj)
#pragma unroll
                for (int n = 0; n < 2; ++n) {
#pragma unroll
                    for (int e = 0; e < 4; ++e) { bf16_t* p = cp0 + (size_t)(bj * HALF + n * 16 + e) * T_;
#pragma unroll
                        for (int ai = 0; ai < 2; ++ai)
#pragma unroll
                            for (int m = 0; m < 4; ++m) p[ai * HALF + m * 16] = f2bf(acc[ai][bj][m][n][e]);
                        EPI_FENCE(); } }
            return;
        }
        bf16_t* base; int ld; float sc = 1.0f; bool gel = false;
        if (pn < 4) { base = MIX + (size_t)row0 * 2048 + pn * 256 + cw; ld = 2048; sc = QSCALE_; }
        else if (pn == 4) { base = KB + (size_t)row0 * 256 + cw; ld = 256; }
        else if (pn == 5) { base = VSB + (size_t)rl * 256 + cw; ld = 256; }
        else if (pn < 10) { base = XR + (size_t)row0 * 1024 + (pn - 6) * 256 + cw; ld = 1024; }
        else { base = MIX + (size_t)row0 * 2048 + 1024 + (pn - 10) * 256 + cw; ld = 2048; gel = true; }
        if (!gel) {
#pragma unroll
            for (int ai = 0; ai < 2; ++ai)
#pragma unroll
                for (int m = 0; m < 4; ++m) { bf16_t* rp = base + (size_t)(ai * HALF + m * 16) * ld;
#pragma unroll
                    for (int bj = 0; bj < 2; ++bj)
#pragma unroll
                        for (int n = 0; n < 2; ++n) *(u32x2*)(rp + bj * HALF + n * 16) = pk4(acc[ai][bj][m][n] * sc);
                    EPI_FENCE(); }
        } else {
#pragma unroll
            for (int ai = 0; ai < 2; ++ai)
#pragma unroll
                for (int m = 0; m < 4; ++m) { bf16_t* rp = base + (size_t)(ai * HALF + m * 16) * ld;
#pragma unroll
                    for (int bj = 0; bj < 2; ++bj)
#pragma unroll
                        for (int n = 0; n < 2; ++n) { const f32x4 v = acc[ai][bj][m][n]; u32x2 w; w.x = cvt_pk_bf16(gelu_t(v[0]), gelu_t(v[1])); w.y = cvt_pk_bf16(gelu_t(v[2]), gelu_t(v[3]));
                            *(u32x2*)(rp + bj * HALF + n * 16) = w; }
                    EPI_FENCE(); }
        }
    }
};

struct Epi2 {
    bf16_t* O; const float* SSA; const float* SSR;
    __device__ __forceinline__ void mid(AccT& acc, const Unit& u, int wr, int fr) const {
        const int row0 = u.pm * BM + wr * 64 + fr; const float* pa = SSA + row0; const float* pr = SSR + row0;
        float va[8], vr[8];
#pragma unroll
        for (int q = 0; q < 8; ++q) { va[q] = pa[(q >> 2) * HALF + (q & 3) * 16]; vr[q] = pr[(q >> 2) * HALF + (q & 3) * 16]; }
        EPI_FENCE();
#pragma unroll
        for (int ai = 0; ai < 2; ++ai)
#pragma unroll
            for (int m = 0; m < 4; ++m) {
                const float ra = va[ai * 4 + m] * (1.0f / 1024.0f) + EPS_, rr = vr[ai * 4 + m] * (1.0f / 1024.0f) + EPS_; const float ratio = sqrtf(rr * __builtin_amdgcn_rcpf(ra));
#pragma unroll
                for (int bj = 0; bj < 2; ++bj)
#pragma unroll
                    for (int n = 0; n < 2; ++n) acc[ai][bj][m][n] *= ratio; }
    }
    __device__ __forceinline__ void operator()(const AccT& acc, const Unit& u, int wr, int wc, int fr, int fq) const {
        const int row0 = u.pm * BM + wr * 64 + fr, col0 = u.pn * BM + wc * 32 + 4 * fq;
        bf16_t* base = O + (size_t)row0 * 1024 + col0; const float* pr = SSR + row0;
        float vr[8];
#pragma unroll
        for (int q = 0; q < 8; ++q) vr[q] = pr[(q >> 2) * HALF + (q & 3) * 16];
        EPI_FENCE();
#pragma unroll
        for (int ai = 0; ai < 2; ++ai)
#pragma unroll
            for (int m = 0; m < 4; ++m) { const float rs = rsqrtf(vr[ai * 4 + m] * (1.0f / 1024.0f) + EPS_); bf16_t* rp = base + (size_t)(ai * HALF + m * 16) * 1024;
#pragma unroll
                for (int bj = 0; bj < 2; ++bj)
#pragma unroll
                    for (int n = 0; n < 2; ++n) *(u32x2*)(rp + bj * HALF + n * 16) = pk4(acc[ai][bj][m][n] * rs);
                EPI_FENCE(); }
    }
};

struct Epi4 {
    bf16_t* F;
    __device__ __forceinline__ void operator()(const AccT& acc, const Unit& u, int wr, int wc, int fr, int fq) const {
        const int row0 = u.pm * BM + wr * 64 + fr, col0 = u.pn * BM + wc * 32 + 4 * fq;
        bf16_t* base = F + (size_t)row0 * 1024 + col0;
#pragma unroll
        for (int ai = 0; ai < 2; ++ai)
#pragma unroll
            for (int m = 0; m < 4; ++m) { bf16_t* rp = base + (size_t)(ai * HALF + m * 16) * 1024;
#pragma unroll
                for (int bj = 0; bj < 2; ++bj)
#pragma unroll
                    for (int n = 0; n < 2; ++n) *(u32x2*)(rp + bj * HALF + n * 16) = pk4(acc[ai][bj][m][n]);
                EPI_FENCE(); }
    }
};

template <int KS>
__device__ __forceinline__ void small_gemm_item(const bf16_t* A, int lda, const bf16_t* Bt, int ldb, float* OS, int nc, int ksp, const float* ss) {
    int tid = threadIdx.x; asm volatile("" : "+v"(tid));
    const int wid = tid >> 6, lane = tid & 63, fr = lane & 15, fq = lane >> 4;
    const int k0 = ksp * KS * 32, n0 = nc * 32, row = 16 * wid + fr;
    const bf16_t* ap = A + (size_t)row * lda + k0 + 8 * fq; const bf16_t* bp = Bt + (size_t)(n0 + fr) * ldb + k0 + 8 * fq;
    bf16x8 af[KS], b0[KS], b1[KS];
#pragma unroll
    for (int ks = 0; ks < KS; ++ks) { af[ks] = *(const bf16x8*)(ap + 32 * ks); b0[ks] = *(const bf16x8*)(bp + 32 * ks); b1[ks] = *(const bf16x8*)(bp + (size_t)16 * ldb + 32 * ks); }
    __builtin_amdgcn_sched_barrier(0);
    f32x4 c0 = {0.f, 0.f, 0.f, 0.f}, c1 = {0.f, 0.f, 0.f, 0.f};
#pragma unroll
    for (int ks = 0; ks < KS; ++ks) { c0 = __builtin_amdgcn_mfma_f32_16x16x32_bf16(b0[ks], af[ks], c0, 0, 0, 0); c1 = __builtin_amdgcn_mfma_f32_16x16x32_bf16(b1[ks], af[ks], c1, 0, 0, 0); }
    float sc = 1.0f; if (ss) sc = rsqrtf(ss[row] * (1.0f / 1024.0f) + EPS_);
    float* op = OS + (size_t)ksp * 131072 + (size_t)row * 1024 + n0 + 4 * fq;
    *(f32x4*)op = c0 * sc; *(f32x4*)(op + 16) = c1 * sc;
}

struct Epi3 {
    bf16_t* FIN; const float* fcw; const float* fcb; const float* sfc; float* out;
    __device__ __forceinline__ void operator()(const AccT& acc, const Unit& u, int wr, int wc, int fr, int fq) const {
        const bool sample = (u.pm == 66);
        const int tau = sample ? 16386 : 252 * u.pm;
        const int tb = tau + 126 * wr + 8 * fr - 2;
        const int j0 = 128 * u.pn + 32 * wc + 4 * fq;
#pragma unroll
        for (int n = 0; n < 2; ++n) {
            const int j = j0 + 16 * n; const float* wp = fcw + j; const float* bp = fcb + j;
            const f32x4 gw0 = *(const f32x4*)(wp), gw1 = *(const f32x4*)(wp + 5632), gw2 = *(const f32x4*)(wp + 2 * 5632), gb = *(const f32x4*)(bp);
            const f32x4 vw0 = *(const f32x4*)(wp + 2816), vw1 = *(const f32x4*)(wp + 5632 + 2816), vw2 = *(const f32x4*)(wp + 2 * 5632 + 2816), vb = *(const f32x4*)(bp + 2816);
            EPI_FENCE();
            if (!sample) {
                f32x4 g2, g1, v2, v1;
#pragma unroll
                for (int e = 0; e < 4; ++e) { g2[e] = __shfl_up(acc[1][0][2][n][e], 1, 16); g1[e] = __shfl_up(acc[1][0][3][n][e], 1, 16);
                                              v2[e] = __shfl_up(acc[1][1][2][n][e], 1, 16); v1[e] = __shfl_up(acc[1][1][3][n][e], 1, 16); }
                bf16_t* fp = FIN + (size_t)tb * 2816 + j;
#pragma unroll
                for (int s = 0; s < 8; ++s) {
                    const f32x4 g0 = acc[s >> 2][0][s & 3][n], v0 = acc[s >> 2][1][s & 3][n];
                    const int t = tb + s;
                    const bool valid = !(fr == 0 && s < 2) && t < T_;
                    if (valid) {
                        const f32x4 yg = gw0 * g2 + gw1 * g1 + gw2 * g0 + gb, yv = vw0 * v2 + vw1 * v1 + vw2 * v0 + vb;
                        u32x2 w; w.x = cvt_pk_bf16(gelu_t(yg[0]) * yv[0], gelu_t(yg[1]) * yv[1]); w.y = cvt_pk_bf16(gelu_t(yg[2]) * yv[2], gelu_t(yg[3]) * yv[3]);
                        *(u32x2*)(fp) = w;
                    }
                    g2 = g1; g1 = g0; v2 = v1; v1 = v0; fp += 2816;
                    EPI_FENCE();
                }
                if (u.pm == 65 && wr == 0 && fr == 0) {
                    float* ob = out + O_FP + j;
                    *(f32x4*)(ob) = acc[1][0][0][n]; *(f32x4*)(ob + 2816) = acc[1][1][0][n];
                    *(f32x4*)(ob + 5632) = acc[1][0][1][n]; *(f32x4*)(ob + 5632 + 2816) = acc[1][1][1][n];
                }
            } else if (wr == 0) {
                const float* sp = sfc + (size_t)(8 * fr) * 11264 + j; bf16_t* fp = FIN + (size_t)(T_ + 8 * fr) * 2816 + j; float* ob = out + O_FS + (size_t)(8 * fr) * 11264 + 5632 + j;
#pragma unroll
                for (int s = 0; s < 8; ++s) {
                    const f32x4 g0 = acc[s >> 2][0][s & 3][n], v0 = acc[s >> 2][1][s & 3][n];
                    const f32x4 sg0 = *(const f32x4*)(sp), sg1 = *(const f32x4*)(sp + 5632), sv0 = *(const f32x4*)(sp + 2816), sv1 = *(const f32x4*)(sp + 5632 + 2816);
                    const f32x4 yg = gw0 * sg0 + gw1 * sg1 + gw2 * g0 + gb, yv = vw0 * sv0 + vw1 * sv1 + vw2 * v0 + vb;
                    u32x2 w; w.x = cvt_pk_bf16(gelu_t(yg[0]) * yv[0], gelu_t(yg[1]) * yv[1]); w.y = cvt_pk_bf16(gelu_t(yg[2]) * yv[2], gelu_t(yg[3]) * yv[3]);
                    *(u32x2*)(fp) = w;
                    *(f32x4*)(ob) = g0; *(f32x4*)(ob + 2816) = v0;
                    sp += 11264; fp += 2816; ob += 11264;
                    EPI_FENCE();
                }
            }
            EPI_FENCE();
        }
    }
};

__device__ __forceinline__ void tr_tile(float* tl, const float* W, int ldw, bf16_t* Wt, int ldt, int k0, int n0, int dn0, const float* ks0, const float* ks1) {
    int tid = threadIdx.x; asm volatile("" : "+v"(tid));
    { const int r = tid >> 4, c4 = (tid & 15) * 4;
#pragma unroll
      for (int p = 0; p < 2; ++p) { const int row = p * 32 + r; const f32x4 v = *(const f32x4*)(W + (size_t)(k0 + row) * ldw + n0 + c4);
          float sc = 1.f; if (ks0) { const int k = k0 + row; sc = k < 1024 ? ks0[k] : ks1[k - 1024]; }
          tl[row * 65 + c4 + 0] = v[0] * sc; tl[row * 65 + c4 + 1] = v[1] * sc; tl[row * 65 + c4 + 2] = v[2] * sc; tl[row * 65 + c4 + 3] = v[3] * sc; } }
    __syncthreads();
    { const int n = tid >> 3, kc = (tid & 7) * 8; float f[8];
#pragma unroll
      for (int i = 0; i < 8; ++i) f[i] = tl[(kc + i) * 65 + n];
      u32x4 w; w.x = cvt_pk_bf16(f[0], f[1]); w.y = cvt_pk_bf16(f[2], f[3]); w.z = cvt_pk_bf16(f[4], f[5]); w.w = cvt_pk_bf16(f[6], f[7]);
      *(u32x4*)(Wt + (size_t)(dn0 + n) * ldt + k0 + kc) = w; }
    __syncthreads();
}

__device__ __forceinline__ void tr_group(float* tl, const float* W, int ldw, bf16_t* Wt, int ldt, int k0, int nbase, int mode, const float* ks0, const float* ks1) {
    int tid = threadIdx.x; asm volatile("" : "+v"(tid));
    { const int r = tid >> 4, c4 = (tid & 15) * 4; f32x4 v[4][2];
#pragma unroll
      for (int j = 0; j < 4; ++j)
#pragma unroll
          for (int p = 0; p < 2; ++p) v[j][p] = __builtin_nontemporal_load((const f32x4*)(W + (size_t)(k0 + p * 32 + r) * ldw + nbase + 64 * j + c4));
#pragma unroll
      for (int p = 0; p < 2; ++p) { const int row = p * 32 + r; float sc = 1.f; if (ks0) { const int k = k0 + row; sc = k < 1024 ? ks0[k] : ks1[k - 1024]; }
#pragma unroll
          for (int j = 0; j < 4; ++j) { float* t = tl + j * 4160 + row * 65 + c4; t[0] = v[j][p][0] * sc; t[1] = v[j][p][1] * sc; t[2] = v[j][p][2] * sc; t[3] = v[j][p][3] * sc; } } }
    __syncthreads();
    { const int n = tid >> 3, kc = (tid & 7) * 8;
#pragma unroll
      for (int j = 0; j < 4; ++j) { float f[8];
#pragma unroll
          for (int i = 0; i < 8; ++i) f[i] = tl[j * 4160 + (kc + i) * 65 + n];
          const int n0 = nbase + 64 * j; int dn0 = n0;
          if (mode == 1) dn0 = n0 < 2816 ? ((n0 >> 7) * 256 + (n0 & 127)) : ((((n0 - 2816) >> 7) * 256) + 128 + ((n0 - 2816) & 127));
          u32x4 w; w.x = cvt_pk_bf16(f[0], f[1]); w.y = cvt_pk_bf16(f[2], f[3]); w.z = cvt_pk_bf16(f[4], f[5]); w.w = cvt_pk_bf16(f[6], f[7]);
          *(u32x4*)(Wt + (size_t)(dn0 + n) * ldt + k0 + kc) = w; } }
    __syncthreads();
}

__device__ void phase0(const Params& P, float* ldsf) {
    char* ws = P.ws; const int G = gridDim.x, bid = blockIdx.x; int tid = threadIdx.x; asm volatile("" : "+v"(tid));
    for (int idx = bid; idx < 16 * 24; idx += G) { const int ng = idx % 24, kt = idx / 24;
        tr_group(ldsf, P.in[I_WADA], 6144, (bf16_t*)(ws + OFF_WT_ADA), 1024, kt * 64, ng * 256, 0, nullptr, nullptr); }
    const size_t gt = (size_t)bid * 512 + tid, gs = (size_t)G * 512;
    { bf16_t* A = (bf16_t*)(ws + OFF_A_ADA);
      for (size_t i = gt; i < (size_t)256 * 1024; i += gs) { const int r = (int)(i >> 10), c = (int)(i & 1023); float v = 0.f;
          if (r == 0) v = P.in[I_CP][c]; else if (r <= 128) v = P.in[I_CS][(size_t)(r - 1) * 1024 + c];
          A[i] = f2bf(v * sigmoid_f(v)); } }
    { float* sp = (float*)(ws + OFF_SP8); for (size_t i = gt; i < 1024; i += gs) sp[i] = 8.0f * log1pf(expf(-P.in[I_LAM][i])); }
    { float* ss = (float*)(ws + OFF_SS); for (size_t i = gt; i < (size_t)4 * MP_; i += gs) ss[i] = 0.f; }
    { float* __restrict__ o = P.out + O_CS; const float* __restrict__ s = P.in[I_SC];
#pragma unroll 4
      for (size_t i = gt; i < (size_t)128 * 2048; i += gs) { const size_t b = i >> 11, r = i & 2047; o[b * 3072 + r] = s[b * 3072 + 1024 + r]; } }
    { float* __restrict__ o = P.out + O_FS; const float* __restrict__ s = P.in[I_SF];
#pragma unroll 8
      for (size_t i = gt; i < (size_t)128 * 5632; i += gs) { const size_t b = i / 5632, r = i % 5632; o[b * 11264 + r] = s[b * 11264 + 5632 + r]; } }
    { unsigned* z = (unsigned*)(ws + OFF_HM0); for (size_t i = gt; i < 1024; i += gs) z[i] = 0u; }
}

__device__ void phase1(const Params& P, LAS unsigned char* lds, float* ldsf) {
    char* ws = P.ws; const int G = gridDim.x, bid = blockIdx.x;
    { Gemm g{(const bf16_t*)(ws + OFF_A_ADA), (const bf16_t*)(ws + OFF_WT_ADA), 1024}; Sched S; S.init(1, 24, G, bid);
      EpiAda E{(float*)(ws + OFF_MOD), P.in[I_BADA]}; gemm_phase<EpiAda, false, false>(lds, g, S, E); }
    __syncthreads();
    int wk, nw; if (G > 48) { if (bid < 24) return; wk = bid - 24; nw = G - 24; } else { wk = bid; nw = G; }
    for (int idx = wk; idx < 944; idx += nw) {
        if (idx < 224) { const int ng = idx % 14, kt = idx / 14; tr_group(ldsf, P.in[I_WIN], 3584, (bf16_t*)(ws + OFF_WT_IN), 1024, kt * 64, ng * 256, 0, nullptr, nullptr); }
        else if (idx < 352) { const int i2 = idx - 224, ng = i2 & 3, kt = i2 >> 2; tr_group(ldsf, P.in[I_WOUT], 1024, (bf16_t*)(ws + OFF_WT_OUT), 2048, kt * 64, ng * 256, 0, P.in[I_GAO], P.in[I_GRO]); }
        else if (idx < 704) { const int i2 = idx - 352, ng = i2 % 22, kt = i2 / 22; tr_group(ldsf, P.in[I_WUP], 5632, (bf16_t*)(ws + OFF_WT_UP), 1024, kt * 64, ng * 256, 1, nullptr, nullptr); }
        else if (idx < 880) { const int i2 = idx - 704, ng = i2 & 3, kt = i2 >> 2; tr_group(ldsf, P.in[I_WDOWN], 1024, (bf16_t*)(ws + OFF_WT_DOWN), 2816, kt * 64, ng * 256, 0, nullptr, nullptr); }
        else { const int i2 = (idx - 880) & 31, blk = i2 >> 2, kt = (i2 >> 1) & 1, ntile = i2 & 1; const bool isA = idx < 912;
            tr_tile(ldsf, P.in[isA ? I_WA : I_WI] + (size_t)blk * 16384, 128, (bf16_t*)(ws + (isA ? OFF_WT_A : OFF_WT_I)) + (size_t)blk * 16384, 128, kt * 64, ntile * 64, ntile * 64, nullptr, nullptr); }
    }
}

constexpr int NBR = 4;
__device__ __forceinline__ const float* xrow(const Params& P, int r) { return r < T_ ? P.in[I_XP] + (size_t)r * 1024 : P.in[I_XS] + (size_t)(r - T_) * 1024; }
constexpr int NB2 = 8;
template <bool PO>
__device__ __forceinline__ void phase2_batch(const Params& P, int r0, int nw, int lane) {
    char* ws = P.ws; const float* MOD = (const float*)(ws + OFF_MOD); bf16_t* H = (bf16_t*)(ws + OFF_HM);
    f32x4 v[NB2][4]; float ss[NB2];
#pragma unroll
    for (int b = 0; b < NB2; ++b) { const int r = r0 + b * nw; ss[b] = 0.f;
        if (PO || r < MR_) { const float* x = xrow(P, r);
#pragma unroll
            for (int i = 0; i < 4; ++i) v[b][i] = __builtin_nontemporal_load((const f32x4*)(x + i * 256 + lane * 4)); }
        else {
#pragma unroll
            for (int i = 0; i < 4; ++i) v[b][i] = (f32x4){0.f, 0.f, 0.f, 0.f}; } }
#pragma unroll
    for (int b = 0; b < NB2; ++b) {
#pragma unroll
        for (int i = 0; i < 4; ++i) ss[b] += (v[b][i][0] * v[b][i][0] + v[b][i][1] * v[b][i][1]) + (v[b][i][2] * v[b][i][2] + v[b][i][3] * v[b][i][3]);
        ss[b] = wave_sum(ss[b]); }
#pragma unroll
    for (int b = 0; b < NB2; ++b) { const int r = r0 + b * nw; if (!PO && r >= MP_) continue;
        if (!PO && r >= MR_) { for (int i = 0; i < 4; ++i) *(u32x2*)(H + (size_t)r * 1024 + i * 256 + lane * 4) = (u32x2){0u, 0u}; continue; }
        const float* md = MOD + (size_t)modrow(r) * 6144; const float rs = rsqrtf(ss[b] * (1.0f / 1024.0f) + EPS_);
#pragma unroll
        for (int i = 0; i < 4; ++i) { const int c = i * 256 + lane * 4; const f32x4 g = *(const f32x4*)(P.in[I_GPM] + c), sh = *(const f32x4*)(md + c), sc = *(const f32x4*)(md + 1024 + c);
            __builtin_nontemporal_store(pk4((v[b][i] * rs * g) * (sc + 1.0f) + sh), (u32x2*)(H + (size_t)r * 1024 + c)); } }
}
__device__ void phase2(const Params& P) {
    int tid = threadIdx.x; asm volatile("" : "+v"(tid));
    const int wid = __builtin_amdgcn_readfirstlane(tid >> 6), lane = tid & 63;
    const int nw = gridDim.x * 8;
    for (int r0 = blockIdx.x * 8 + wid; r0 < MP_; r0 += nw * NB2) {
        if (r0 + (NB2 - 1) * nw < T_) phase2_batch<true>(P, r0, nw, lane); else phase2_batch<false>(P, r0, nw, lane);
    }
}

__device__ __forceinline__ int crow(int r, int hi) { return (r & 3) + 8 * (r >> 2) + 4 * hi; }
__device__ void attn_prompt_item(const Params& P, char* lds, int qb, int kv) {
    char* ws = P.ws; bf16_t* MIX = (bf16_t*)(ws + OFF_MIX); const bf16_t* KB = (const bf16_t*)(ws + OFF_KB); const bf16_t* VT = (const bf16_t*)(ws + OFF_VT); float* SSA = (float*)(ws + OFF_SS);
    bf16_t* Ks = (bf16_t*)lds; bf16_t* Vs = (bf16_t*)(lds + 256 * 136 * 2);
    int tid = threadIdx.x; asm volatile("" : "+v"(tid));
    const int wid = tid >> 6, lane = tid & 63; int r32 = lane & 31, hi = lane >> 5;
    const int tbase = 128 * (qb - 1);
    if (qb > 0) {
        u32x4 kv_[8], vv_[8];
#pragma unroll
        for (int i = 0; i < 8; ++i) { const int id = i * 512 + tid; kv_[i] = *(const u32x4*)(KB + (size_t)(tbase + (id >> 4)) * 256 + kv * 128 + (id & 15) * 8);
            vv_[i] = *(const u32x4*)(VT + (size_t)(kv * 128 + (id >> 5)) * T_ + tbase + (id & 31) * 8); }
#pragma unroll
        for (int i = 0; i < 8; ++i) { const int id = i * 512 + tid; *(u32x4*)(Ks + (id >> 4) * 136 + (id & 15) * 8) = kv_[i];
            u32x2* dst = (u32x2*)(Vs + (id >> 5) * 260 + (id & 31) * 8); dst[0] = (u32x2){vv_[i].x, vv_[i].y}; dst[1] = (u32x2){vv_[i].z, vv_[i].w}; }
    } else {
#pragma unroll
        for (int i = 0; i < 8; ++i) { const int id = i * 512 + tid, row = id >> 4, c = id & 15; const int t = tbase + row;
            u32x4 v = {0u, 0u, 0u, 0u}; if (t >= 0) v = *(const u32x4*)(KB + (size_t)t * 256 + kv * 128 + c * 8);
            *(u32x4*)(Ks + row * 136 + c * 8) = v; }
#pragma unroll
        for (int i = 0; i < 8; ++i) { const int id = i * 512 + tid, d = id >> 5, c = id & 31; const int t = tbase + c * 8;
            u32x4 v = {0u, 0u, 0u, 0u}; if (t >= 0) v = *(const u32x4*)(VT + (size_t)(kv * 128 + d) * T_ + t);
            u32x2* dst = (u32x2*)(Vs + d * 260 + c * 8); dst[0] = (u32x2){v.x, v.y}; dst[1] = (u32x2){v.z, v.w}; }
    }
    __syncthreads();
#pragma unroll 1
    for (int it = 0; it < 2; ++it) {
        asm volatile("" : "+v"(r32), "+v"(hi));
        const int tile = wid + 8 * it, g = tile >> 2, w4 = tile & 3, head = kv * 4 + g;
        const int trow = 128 * qb + 32 * w4 + r32;
        bf16_t* qp = MIX + (size_t)trow * 2048 + head * 128;
        bf16x8 qr[8];
#pragma unroll
        for (int d0 = 0; d0 < 8; ++d0) qr[d0] = *(const bf16x8*)(qp + d0 * 16 + hi * 8);
        f32x16 p[5];
#pragma unroll
        for (int kt = 0; kt < 5; ++kt) {
            f32x16 a = {};
            const bf16_t* kp = Ks + (32 * (w4 + kt) + r32) * 136 + hi * 8;
#pragma unroll
            for (int d0 = 0; d0 < 8; ++d0) { const bf16x8 kf = *(const bf16x8*)(kp + d0 * 16); a = __builtin_amdgcn_mfma_f32_32x32x16_bf16(kf, qr[d0], a, 0, 0, 0); }
            p[kt] = a;
            EPI_FENCE();
        }
        const float slope2 = __builtin_amdgcn_exp2f(-(float)(head + 1)) * LOG2E_, sink2 = P.in[I_SINK][head] * LOG2E_;
        float mx = sink2;
#pragma unroll
        for (int kt = 0; kt < 5; ++kt)
#pragma unroll
            for (int r = 0; r < 16; ++r) { const int c = crow(r, hi); const int dist = 128 + r32 - 32 * kt - c; const int jb = 32 * (w4 + kt) + c;
                const bool valid = ((unsigned)dist < 128u) && (qb > 0 || jb >= 128);
                const float s = valid ? p[kt][r] - slope2 * (float)dist : -__builtin_inff(); p[kt][r] = s; mx = fmaxf(mx, s); }
        mx = fmaxf(mx, __shfl_xor(mx, 32));
        float l = 0.f;
        u32x4 pb[5][2];
#pragma unroll
        for (int kt = 0; kt < 5; ++kt) {
            float e[16];
#pragma unroll
            for (int r = 0; r < 16; ++r) { e[r] = __builtin_amdgcn_exp2f(p[kt][r] - mx); l += e[r]; }
#pragma unroll
            for (int s2 = 0; s2 < 2; ++s2) { pb[kt][s2].x = cvt_pk_bf16(e[8 * s2 + 0], e[8 * s2 + 1]); pb[kt][s2].y = cvt_pk_bf16(e[8 * s2 + 2], e[8 * s2 + 3]);
                pb[kt][s2].z = cvt_pk_bf16(e[8 * s2 + 4], e[8 * s2 + 5]); pb[kt][s2].w = cvt_pk_bf16(e[8 * s2 + 6], e[8 * s2 + 7]); }
        }
        l += __shfl_xor(l, 32); l += __builtin_amdgcn_exp2f(sink2 - mx);
        EPI_FENCE();
        f32x16 o[4] = {};
#pragma unroll
        for (int kt = 0; kt < 5; ++kt)
#pragma unroll
            for (int s2 = 0; s2 < 2; ++s2) {
                const bf16x8 pf = *reinterpret_cast<const bf16x8*>(&pb[kt][s2]);
#pragma unroll
                for (int db = 0; db < 4; ++db) { const bf16_t* vp = Vs + (32 * db + r32) * 260 + 32 * (w4 + kt) + 16 * s2 + 4 * hi;
                    const u32x2 lo = *(const u32x2*)vp, hh = *(const u32x2*)(vp + 8); u32x4 vw = {lo.x, lo.y, hh.x, hh.y};
                    o[db] = __builtin_amdgcn_mfma_f32_32x32x16_bf16(*reinterpret_cast<const bf16x8*>(&vw), pf, o[db], 0, 0, 0); }
                EPI_FENCE();
            }
        const float inv = 1.0f / l; float ss = 0.f;
#pragma unroll
        for (int db = 0; db < 4; ++db)
#pragma unroll
            for (int r4 = 0; r4 < 4; ++r4) { const float a = o[db][4 * r4] * inv, b = o[db][4 * r4 + 1] * inv, c = o[db][4 * r4 + 2] * inv, d = o[db][4 * r4 + 3] * inv;
                ss += (a * a + b * b) + (c * c + d * d); u32x2 w; w.x = cvt_pk_bf16(a, b); w.y = cvt_pk_bf16(c, d);
                *(u32x2*)(qp + 32 * db + 8 * r4 + 4 * hi) = w; }
        ss += __shfl_xor(ss, 32);
        if (hi == 0) atomicAdd(SSA + trow, ss);
    }
    __syncthreads();
}

__device__ void attn_sample_item(const Params& P, char* lds, int b, int kv) {
    char* ws = P.ws; bf16_t* MIX = (bf16_t*)(ws + OFF_MIX); const bf16_t* KB = (const bf16_t*)(ws + OFF_KB); const bf16_t* VSB = (const bf16_t*)(ws + OFF_VSB); float* SSA = (float*)(ws + OFF_SS);
    float* Kf = (float*)lds; float* Vf = Kf + 128 * 129; float* qs = Vf + 128 * 129; float* ps = qs + 512; float* red = ps + 512;
    int tid = threadIdx.x; asm volatile("" : "+v"(tid));
    const int g = tid >> 7, jd = tid & 127, head = kv * 4 + g;
    bf16_t* qp = MIX + (size_t)(T_ + b) * 2048 + head * 128;
    qs[tid] = bf2f(qp[jd]);
    { f32x4 kk[8], vv[8];
#pragma unroll
      for (int i = 0; i < 8; ++i) { const int id = i * 512 + tid, j = id >> 5, c4 = (id & 31) * 4;
          if (j < 127) { const size_t src = ((size_t)(b * 128 + j + 1) * 2 + kv) * 128 + c4; kk[i] = __builtin_nontemporal_load((const f32x4*)(P.in[I_CK] + src)); vv[i] = __builtin_nontemporal_load((const f32x4*)(P.in[I_CV] + src)); }
          else { const u32x2 kw = *(const u32x2*)(KB + (size_t)(T_ + b) * 256 + kv * 128 + c4), vw = *(const u32x2*)(VSB + (size_t)b * 256 + kv * 128 + c4);
              kk[i] = (f32x4){bflo(kw.x), bfhi(kw.x), bflo(kw.y), bfhi(kw.y)}; vv[i] = (f32x4){bflo(vw.x), bfhi(vw.x), bflo(vw.y), bfhi(vw.y)}; } }
#pragma unroll
      for (int i = 0; i < 8; ++i) { const int id = i * 512 + tid, j = id >> 5, c4 = (id & 31) * 4;
          const size_t dst = ((size_t)(b * 128 + j) * 2 + kv) * 128 + c4; __builtin_nontemporal_store(kk[i], (f32x4*)(P.out + O_KS + dst)); __builtin_nontemporal_store(vv[i], (f32x4*)(P.out + O_VS + dst));
#pragma unroll
          for (int e = 0; e < 4; ++e) { Kf[j * 129 + c4 + e] = kk[i][e]; Vf[j * 129 + c4 + e] = vv[i][e]; } } }
    __syncthreads();
    const float slope2 = __builtin_amdgcn_exp2f(-(float)(head + 1)) * LOG2E_, sink2 = P.in[I_SINK][head] * LOG2E_;
    float s = 0.f;
    for (int d = 0; d < 128; ++d) s += qs[g * 128 + d] * Kf[jd * 129 + d];
    s -= slope2 * (float)(127 - jd);
    ps[tid] = s;
    __syncthreads();
    float mx = sink2; for (int j = 0; j < 128; ++j) mx = fmaxf(mx, ps[g * 128 + j]);
    const float e = __builtin_amdgcn_exp2f(s - mx);
    __syncthreads();
    ps[tid] = e;
    __syncthreads();
    float l = __builtin_amdgcn_exp2f(sink2 - mx); for (int j = 0; j < 128; ++j) l += ps[g * 128 + j];
    float o = 0.f;
    for (int j = 0; j < 128; ++j) o += ps[g * 128 + j] * Vf[j * 129 + jd];
    o /= l;
    qp[jd] = f2bf(o);
    const float ss = wave_sum(o * o);
    if ((tid & 63) == 0) atomicAdd(SSA + T_ + b, ss);
    (void)red;
    __syncthreads();
}

template <bool SAMPLE>
__device__ void rnn1_item(const Params& P, char* lds, int tile, int nb, int rg) {
    char* ws = P.ws; constexpr bool sample = SAMPLE;
    const bf16_t* XR = (const bf16_t*)(ws + OFF_XR); bf16_t* MIX = (bf16_t*)(ws + OFF_MIX); bf16_t* LAT = (bf16_t*)(ws + OFF_HM); bf16_t* UT = (bf16_t*)(ws + OFF_U);
    const float* SP8 = (const float*)(ws + OFF_SP8); float* SSR = (float*)(ws + OFF_SS) + MP_;
    bf16_t* XC = (bf16_t*)lds; bf16_t* WA = XC + 128 * 136; bf16_t* WI = WA + 128 * 136;
    float* As = (float*)lds; float* Us = As + 128 * 129; float* sgA = Us + 128 * 129; float* sgE = sgA + 512; float* bl = sgE + 512;
    int tid = threadIdx.x; asm volatile("" : "+v"(tid));
    const int wid = tid >> 6, lane = tid & 63, fr = lane & 15, fq = lane >> 4;
    const int t0 = tile * 128, ch0 = nb * 128;
    float blv = 0.f; if (tid < 384) blv = tid < 128 ? P.in[I_BA][ch0 + tid] : (tid < 256 ? P.in[I_BI][ch0 + tid - 128] : SP8[ch0 + tid - 256]);
    if (!sample) {
        const int c8 = (tid & 15) * 8, ch = ch0 + c8;
        u32x4 xv[4][4];
        if (tile > 0) {
#pragma unroll
            for (int i = 0; i < 4; ++i)
#pragma unroll
                for (int k = 0; k < 4; ++k) xv[i][k] = *(const u32x4*)(XR + (size_t)(t0 + i * 32 + (tid >> 4) - 3 + k) * 1024 + ch);
        } else {
#pragma unroll
            for (int i = 0; i < 4; ++i)
#pragma unroll
                for (int k = 0; k < 4; ++k) { const int tt = i * 32 + (tid >> 4) - 3 + k; xv[i][k] = (u32x4){0u, 0u, 0u, 0u}; if (tt >= 0) xv[i][k] = *(const u32x4*)(XR + (size_t)tt * 1024 + ch); }
        }
        f32x4 cw[4][2], cb[2];
#pragma unroll
        for (int k = 0; k < 4; ++k) { cw[k][0] = *(const f32x4*)(P.in[I_CW] + k * 1024 + ch); cw[k][1] = *(const f32x4*)(P.in[I_CW] + k * 1024 + ch + 4); }
        cb[0] = *(const f32x4*)(P.in[I_CB] + ch); cb[1] = *(const f32x4*)(P.in[I_CB] + ch + 4);
#pragma unroll
        for (int i = 0; i < 4; ++i) { const int row = i * 32 + (tid >> 4);
            f32x4 x0 = cb[0], x1 = cb[1];
#pragma unroll
            for (int k = 0; k < 4; ++k) { const u32x4 v = xv[i][k];
                x0 += cw[k][0] * (f32x4){bflo(v.x), bfhi(v.x), bflo(v.y), bfhi(v.y)}; x1 += cw[k][1] * (f32x4){bflo(v.z), bfhi(v.z), bflo(v.w), bfhi(v.w)}; }
            u32x4 w; w.x = cvt_pk_bf16(x0[0], x0[1]); w.y = cvt_pk_bf16(x0[2], x0[3]); w.z = cvt_pk_bf16(x1[0], x1[1]); w.w = cvt_pk_bf16(x1[2], x1[3]);
            *(u32x4*)(XC + row * 136 + c8) = w; }
    } else if (tid < 256) {
        const int row = tid >> 4, c8 = (tid & 15) * 8, ch = ch0 + c8, b = 16 * rg + row;
        float xc[8];
        { const f32x4 b0 = *(const f32x4*)(P.in[I_CB] + ch), b1 = *(const f32x4*)(P.in[I_CB] + ch + 4);
          xc[0] = b0[0]; xc[1] = b0[1]; xc[2] = b0[2]; xc[3] = b0[3]; xc[4] = b1[0]; xc[5] = b1[1]; xc[6] = b1[2]; xc[7] = b1[3]; }
#pragma unroll
        for (int k = 0; k < 3; ++k) { const float* sp = P.in[I_SC] + (size_t)b * 3072 + k * 1024 + ch; const f32x4 x0 = *(const f32x4*)sp, x1 = *(const f32x4*)(sp + 4);
            const f32x4 w0 = *(const f32x4*)(P.in[I_CW] + k * 1024 + ch), w1 = *(const f32x4*)(P.in[I_CW] + k * 1024 + ch + 4);
#pragma unroll
            for (int e = 0; e < 4; ++e) { xc[e] += w0[e] * x0[e]; xc[4 + e] += w1[e] * x1[e]; } }
        { const u32x4 v = *(const u32x4*)(XR + (size_t)(T_ + b) * 1024 + ch);
          const f32x4 x0 = {bflo(v.x), bfhi(v.x), bflo(v.y), bfhi(v.y)}, x1 = {bflo(v.z), bfhi(v.z), bflo(v.w), bfhi(v.w)};
          float* oc = P.out + O_CS + (size_t)b * 3072 + 2048 + ch; *(f32x4*)oc = x0; *(f32x4*)(oc + 4) = x1;
          const f32x4 w0 = *(const f32x4*)(P.in[I_CW] + 3 * 1024 + ch), w1 = *(const f32x4*)(P.in[I_CW] + 3 * 1024 + ch + 4);
#pragma unroll
          for (int e = 0; e < 4; ++e) { xc[e] += w0[e] * x0[e]; xc[4 + e] += w1[e] * x1[e]; } }
        u32x4 w; w.x = cvt_pk_bf16(xc[0], xc[1]); w.y = cvt_pk_bf16(xc[2], xc[3]); w.z = cvt_pk_bf16(xc[4], xc[5]); w.w = cvt_pk_bf16(xc[6], xc[7]);
        *(u32x4*)(XC + row * 136 + c8) = w;
    }
    if (tid < 384) bl[tid] = blv;
    { u32x4 wa_[4], wi_[4];
#pragma unroll
      for (int i = 0; i < 4; ++i) { const int id = i * 512 + tid; wa_[i] = *(const u32x4*)((const bf16_t*)(ws + OFF_WT_A) + (size_t)nb * 16384 + id * 8); wi_[i] = *(const u32x4*)((const bf16_t*)(ws + OFF_WT_I) + (size_t)nb * 16384 + id * 8); }
#pragma unroll
      for (int i = 0; i < 4; ++i) { const int id = i * 512 + tid, d = id >> 4, c8 = (id & 15) * 8; *(u32x4*)(WA + d * 136 + c8) = wa_[i]; *(u32x4*)(WI + d * 136 + c8) = wi_[i]; } }
    __syncthreads();
    constexpr bool active = true;
    constexpr int NT = SAMPLE ? 1 : 8;
    const int dofs = SAMPLE ? 16 * wid : 0;
    const int row = SAMPLE ? fr : 16 * wid + fr;
    f32x4 aa[NT], ai[NT]; u32x2 xcw[NT];
    if (active) {
        bf16x8 xf[4];
#pragma unroll
        for (int ks = 0; ks < 4; ++ks) xf[ks] = *(const bf16x8*)(XC + row * 136 + 32 * ks + 8 * fq);
#pragma unroll
        for (int nt = 0; nt < NT; ++nt) { f32x4 a = {0.f, 0.f, 0.f, 0.f}, b = {0.f, 0.f, 0.f, 0.f};
#pragma unroll
            for (int ks = 0; ks < 4; ++ks) { const bf16x8 wa = *(const bf16x8*)(WA + (dofs + 16 * nt + fr) * 136 + 32 * ks + 8 * fq), wi = *(const bf16x8*)(WI + (dofs + 16 * nt + fr) * 136 + 32 * ks + 8 * fq);
                a = __builtin_amdgcn_mfma_f32_16x16x32_bf16(wa, xf[ks], a, 0, 0, 0); b = __builtin_amdgcn_mfma_f32_16x16x32_bf16(wi, xf[ks], b, 0, 0, 0); }
            aa[nt] = a; ai[nt] = b; xcw[nt] = *(const u32x2*)(XC + row * 136 + dofs + 16 * nt + 4 * fq); }
    }
    __syncthreads();
    if (active) {
        float ssr = 0.f; const int brow = 16 * rg + fr;
#pragma unroll
        for (int nt = 0; nt < NT; ++nt) { const int d = dofs + 16 * nt + 4 * fq, ch = ch0 + d;
            const f32x4 ba = *(const f32x4*)(bl + d), bi = *(const f32x4*)(bl + 128 + d), sp = *(const f32x4*)(bl + 256 + d);
            const float xv[4] = {bflo(xcw[nt].x), bfhi(xcw[nt].x), bflo(xcw[nt].y), bfhi(xcw[nt].y)};
            float la[4], uu[4], av[4];
#pragma unroll
            for (int e = 0; e < 4; ++e) { const float r = sigmoid_f(aa[nt][e] + ba[e]), ig = sigmoid_f(ai[nt][e] + bi[e]);
                la[e] = -r * sp[e]; av[e] = __builtin_amdgcn_exp2f(LOG2E_ * la[e]);
                const float x2 = 2.0f * la[e];
                const float pol = -x2 * (1.0f + x2 * 0.5f * (1.0f + x2 * (1.0f / 3.0f) * (1.0f + x2 * 0.25f * (1.0f + x2 * 0.2f))));
                const float em = x2 > -0.25f ? pol : 1.0f - av[e] * av[e];
                uu[e] = __builtin_amdgcn_sqrtf(fmaxf(em, 0.f)) * (ig * xv[e]); }
            if (!sample) {
#pragma unroll
                for (int e = 0; e < 4; ++e) { As[row * 129 + d + e] = la[e]; Us[row * 129 + d + e] = uu[e]; }
            } else {
                const f32x4 h0 = *(const f32x4*)(P.in[I_SH] + (size_t)brow * 1024 + ch);
                bf16_t* gp = MIX + (size_t)(T_ + brow) * 2048 + 1024 + ch; const u32x2 gw = *(const u32x2*)gp; const float gy[4] = {bflo(gw.x), bfhi(gw.x), bflo(gw.y), bfhi(gw.y)};
                f32x4 h; float rn[4];
#pragma unroll
                for (int e = 0; e < 4; ++e) { h[e] = av[e] * h0[e] + uu[e]; rn[e] = h[e] * gy[e]; ssr += rn[e] * rn[e]; }
                *(f32x4*)(P.out + O_HS + (size_t)brow * 1024 + ch) = h;
                u32x2 w; w.x = cvt_pk_bf16(rn[0], rn[1]); w.y = cvt_pk_bf16(rn[2], rn[3]); *(u32x2*)gp = w;
            } }
        if (sample) { ssr += __shfl_xor(ssr, 16); ssr += __shfl_xor(ssr, 32); if (fq == 0) atomicAdd(SSR + T_ + brow, ssr); }
    }
    __syncthreads();
    if (sample) return;
    { const int s = tid >> 7, c = tid & 127; float A = 1.f, E = 0.f; unsigned lw[16], uw[16];
#pragma unroll
      for (int j = 0; j < 32; j += 2) { const float l0 = As[(32 * s + j) * 129 + c], u0 = Us[(32 * s + j) * 129 + c], l1 = As[(32 * s + j + 1) * 129 + c], u1 = Us[(32 * s + j + 1) * 129 + c];
          const float a0 = __builtin_amdgcn_exp2f(LOG2E_ * l0), a1 = __builtin_amdgcn_exp2f(LOG2E_ * l1);
          E = a0 * E + u0; A *= a0; E = a1 * E + u1; A *= a1; lw[j >> 1] = cvt_pk_bf16(l0, l1); uw[j >> 1] = cvt_pk_bf16(u0, u1); }
      ((float*)(ws + OFF_SEGA))[(size_t)(tile * 4 + s) * 1024 + ch0 + c] = A; ((float*)(ws + OFF_SEGE))[(size_t)(tile * 4 + s) * 1024 + ch0 + c] = E;
      sgA[tid] = A; sgE[tid] = E;
      u32x4* lp = (u32x4*)(LAT + (size_t)(ch0 + c) * T_ + t0 + 32 * s); u32x4* up = (u32x4*)(UT + (size_t)(ch0 + c) * T_ + t0 + 32 * s);
#pragma unroll
      for (int q = 0; q < 4; ++q) { lp[q] = (u32x4){lw[4 * q], lw[4 * q + 1], lw[4 * q + 2], lw[4 * q + 3]}; up[q] = (u32x4){uw[4 * q], uw[4 * q + 1], uw[4 * q + 2], uw[4 * q + 3]}; } }
    __syncthreads();
    if (tid < 128) { float A = 1.f, E = 0.f;
#pragma unroll
        for (int s = 0; s < 4; ++s) { const float a = sgA[s * 128 + tid], e = sgE[s * 128 + tid]; E = a * E + e; A *= a; }
        ((float*)(ws + OFF_TILEA))[(size_t)tile * 1024 + ch0 + tid] = A; ((float*)(ws + OFF_TILEE))[(size_t)tile * 1024 + ch0 + tid] = E; }
    __syncthreads();
}

__device__ void rnn2_item(const Params& P, char* lds, int tile, int nb) {
    char* ws = P.ws; bf16_t* MIX = (bf16_t*)(ws + OFF_MIX); const bf16_t* LAT = (const bf16_t*)(ws + OFF_HM); const bf16_t* UT = (const bf16_t*)(ws + OFF_U);
    const float* SEGA = (const float*)(ws + OFF_SEGA); const float* SEGE = (const float*)(ws + OFF_SEGE); const float* TA = (const float*)(ws + OFF_TILEA); const float* TE = (const float*)(ws + OFF_TILEE);
    float* SSR = (float*)(ws + OFF_SS) + MP_;
    float* pa = (float*)lds; float* pe = pa + 512; float* sq = pe + 512; bf16_t* GY = (bf16_t*)(sq + 128 * 129);
    int tid = threadIdx.x; asm volatile("" : "+v"(tid));
    const int s = tid >> 7, c = tid & 127, ch = nb * 128 + c;
    const int t0 = tile * 128, tb = t0 + 32 * s;
    u32x4 gyv[4];
#pragma unroll
    for (int i = 0; i < 4; ++i) { const int id = i * 512 + tid, row = id >> 4, c8 = (id & 15) * 8; gyv[i] = *(const u32x4*)(MIX + (size_t)(t0 + row) * 2048 + 1024 + nb * 128 + c8); }
    u32x4 lav[4], uv[4];
    { const u32x4* lp = (const u32x4*)(LAT + (size_t)ch * T_ + tb); const u32x4* up = (const u32x4*)(UT + (size_t)ch * T_ + tb);
#pragma unroll
      for (int q = 0; q < 4; ++q) { lav[q] = lp[q]; uv[q] = up[q]; } }
    { float A = 1.f, E = 0.f; const int lo = s * 32, hi = min(lo + 32, tile);
      for (int k0 = lo; k0 < hi; k0 += 16) { float av[16], ev[16];
#pragma unroll
          for (int i = 0; i < 16; ++i) { const int k = min(k0 + i, hi - 1); av[i] = TA[(size_t)k * 1024 + ch]; ev[i] = TE[(size_t)k * 1024 + ch]; }
#pragma unroll
          for (int i = 0; i < 16; ++i) { const bool on = k0 + i < hi; const float a = on ? av[i] : 1.f, e = on ? ev[i] : 0.f; E = a * E + e; A *= a; } }
      pa[tid] = A; pe[tid] = E; }
#pragma unroll
    for (int i = 0; i < 4; ++i) { const int id = i * 512 + tid, row = id >> 4, c8 = (id & 15) * 8; *(u32x4*)(GY + row * 136 + c8) = gyv[i]; }
    __syncthreads();
    float h = 0.f;
#pragma unroll
    for (int q = 0; q < 4; ++q) h = pa[q * 128 + c] * h + pe[q * 128 + c];
    { float sa[3], se[3];
#pragma unroll
      for (int s2 = 0; s2 < 3; ++s2) { const int sx = min(s2, max(s - 1, 0)); sa[s2] = SEGA[(size_t)(tile * 4 + sx) * 1024 + ch]; se[s2] = SEGE[(size_t)(tile * 4 + sx) * 1024 + ch]; }
#pragma unroll
      for (int s2 = 0; s2 < 3; ++s2) if (s2 < s) h = sa[s2] * h + se[s2]; }
#pragma unroll
    for (int q = 0; q < 4; ++q) {
        const unsigned lw[4] = {lav[q].x, lav[q].y, lav[q].z, lav[q].w}, uw[4] = {uv[q].x, uv[q].y, uv[q].z, uv[q].w};
#pragma unroll
        for (int p = 0; p < 4; ++p)
#pragma unroll
            for (int hh = 0; hh < 2; ++hh) { const int j = 8 * q + 2 * p + hh; const float la = hh ? bfhi(lw[p]) : bflo(lw[p]), u = hh ? bfhi(uw[p]) : bflo(uw[p]);
                bf16_t* g = GY + (32 * s + j) * 136 + c;
                h = __builtin_amdgcn_exp2f(LOG2E_ * la) * h + u; const float rn = h * bf2f(*g); *g = f2bf(rn); sq[(32 * s + j) * 129 + c] = rn * rn; }
    }
    if (tile == 127 && s == 3) P.out[O_HP + ch] = h;
    __syncthreads();
#pragma unroll
    for (int i = 0; i < 4; ++i) { const int id = i * 512 + tid, row = id >> 4, c8 = (id & 15) * 8; *(u32x4*)(MIX + (size_t)(t0 + row) * 2048 + 1024 + nb * 128 + c8) = *(const u32x4*)(GY + row * 136 + c8); }
    { const int row = tid >> 2, q = tid & 3; float a = 0.f;
#pragma unroll 8
      for (int j = 0; j < 32; ++j) a += sq[row * 129 + q * 32 + ((j + 8 * q) & 31)];
      a += __shfl_xor(a, 1); a += __shfl_xor(a, 2);
      if (q == 0) atomicAdd(SSR + tile * 128 + row, a); }
    __syncthreads();
}

__device__ void state_out_prompt(const Params& P) {
    char* ws = P.ws; const bf16_t* KB = (const bf16_t*)(ws + OFF_KB); const bf16_t* VT = (const bf16_t*)(ws + OFF_VT); const bf16_t* XR = (const bf16_t*)(ws + OFF_XR);
    int tid = threadIdx.x; asm volatile("" : "+v"(tid));
    const size_t gt = (size_t)blockIdx.x * 512 + tid, gs = (size_t)gridDim.x * 512;
    for (size_t i = gt; i < 32768; i += gs) { const int j = (int)(i >> 8), c = (int)(i & 255);
        P.out[O_KP + i] = bf2f(KB[(size_t)(T_ - 128 + j) * 256 + c]); P.out[O_VP + i] = bf2f(VT[(size_t)c * T_ + (T_ - 128 + j)]); }
    for (size_t i = gt; i < 3072; i += gs) P.out[O_CP + i] = bf2f(XR[(size_t)(T_ - 3) * 1024 + i]);
}

template <bool PO>
__device__ __forceinline__ void ld_row16(const bf16_t* B, const float* S, int r, int lane, f32x4 (&o)[4]) {
    if (PO || r < T_) {
        u32x2 w[4];
#pragma unroll
        for (int i = 0; i < 4; ++i) w[i] = *(const u32x2*)(B + (size_t)r * 1024 + i * 256 + lane * 4);
#pragma unroll
        for (int i = 0; i < 4; ++i) o[i] = (f32x4){bflo(w[i].x), bfhi(w[i].x), bflo(w[i].y), bfhi(w[i].y)};
    } else {
        const float* p = S + (size_t)(r - T_) * 1024 + lane * 4;
#pragma unroll
        for (int i = 0; i < 4; ++i) o[i] = (f32x4){0.f, 0.f, 0.f, 0.f};
#pragma unroll
        for (int k0 = 0; k0 < 8; k0 += 2) { f32x4 t[2][4];
#pragma unroll
            for (int k = 0; k < 2; ++k)
#pragma unroll
                for (int i = 0; i < 4; ++i) t[k][i] = *(const f32x4*)(p + (size_t)(k0 + k) * 131072 + i * 256);
#pragma unroll
            for (int i = 0; i < 4; ++i) o[i] += t[0][i] + t[1][i]; }
    }
}
template <bool PO>
__device__ __forceinline__ void phase7_batch(const Params& P, int r0, int nw, int lane) {
    char* ws = P.ws; const float* MOD = (const float*)(ws + OFF_MOD);
    const bf16_t* O = (const bf16_t*)(ws + OFF_XR); bf16_t* H = (bf16_t*)(ws + OFF_HM); const float* OS2 = (const float*)(ws + OFF_OS2);
    f32x4 v[NBR][4], ov[NBR][4]; float sso[NBR], ss[NBR];
#pragma unroll
    for (int b = 0; b < NBR; ++b) { const int r = r0 + b * nw;
        if (PO || r < MR_) { const float* x = xrow(P, r);
#pragma unroll
            for (int i = 0; i < 4; ++i) v[b][i] = __builtin_nontemporal_load((const f32x4*)(x + i * 256 + lane * 4));
            ld_row16<PO>(O, OS2, r, lane, ov[b]); }
        else {
#pragma unroll
            for (int i = 0; i < 4; ++i) { v[b][i] = (f32x4){0.f, 0.f, 0.f, 0.f}; ov[b][i] = (f32x4){0.f, 0.f, 0.f, 0.f}; } } }
#pragma unroll
    for (int b = 0; b < NBR; ++b) { sso[b] = 0.f;
#pragma unroll
        for (int i = 0; i < 4; ++i) sso[b] += (ov[b][i][0] * ov[b][i][0] + ov[b][i][1] * ov[b][i][1]) + (ov[b][i][2] * ov[b][i][2] + ov[b][i][3] * ov[b][i][3]);
        sso[b] = wave_sum(sso[b]); }
#pragma unroll
    for (int b = 0; b < NBR; ++b) { const int r = r0 + b * nw; ss[b] = 0.f; if (!PO && r >= MR_) continue;
        const float* md = MOD + (size_t)modrow(r) * 6144; const float rso = rsqrtf(sso[b] * (1.0f / 1024.0f) + EPS_);
#pragma unroll
        for (int i = 0; i < 4; ++i) { const int c = i * 256 + lane * 4; const f32x4 g1 = *(const f32x4*)(md + 2048 + c), gp = *(const f32x4*)(P.in[I_GPOM] + c);
            v[b][i] = v[b][i] + g1 * ((ov[b][i] * rso) * gp); ss[b] += (v[b][i][0] * v[b][i][0] + v[b][i][1] * v[b][i][1]) + (v[b][i][2] * v[b][i][2] + v[b][i][3] * v[b][i][3]); }
        ss[b] = wave_sum(ss[b]); }
#pragma unroll
    for (int b = 0; b < NBR; ++b) { const int r = r0 + b * nw; if (!PO && r >= MP_) continue;
        if (!PO && r >= MR_) { for (int i = 0; i < 4; ++i) *(u32x2*)(H + (size_t)r * 1024 + i * 256 + lane * 4) = (u32x2){0u, 0u}; continue; }
        const float* md = MOD + (size_t)modrow(r) * 6144; const float rs = rsqrtf(ss[b] * (1.0f / 1024.0f) + EPS_);
#pragma unroll
        for (int i = 0; i < 4; ++i) { const int c = i * 256 + lane * 4; const f32x4 g = *(const f32x4*)(P.in[I_GPF] + c), sh = *(const f32x4*)(md + 3072 + c), sc = *(const f32x4*)(md + 4096 + c);
            __builtin_nontemporal_store(pk4((v[b][i] * rs * g) * (sc + 1.0f) + sh), (u32x2*)(H + (size_t)r * 1024 + c)); } }
}
__device__ void phase7(const Params& P) {
    int tid = threadIdx.x; asm volatile("" : "+v"(tid));
    const int wid = __builtin_amdgcn_readfirstlane(tid >> 6), lane = tid & 63;
    const int nw = gridDim.x * 8;
    for (int r0 = blockIdx.x * 8 + wid; r0 < MP_; r0 += nw * NBR) {
        if (r0 + (NBR - 1) * nw < T_) phase7_batch<true>(P, r0, nw, lane); else phase7_batch<false>(P, r0, nw, lane);
    }
}

constexpr int NB10 = 2;
template <bool PO>
__device__ __forceinline__ void phase10_batch(const Params& P, int r0, int nw, int lane) {
    char* ws = P.ws; const float* MOD = (const float*)(ws + OFF_MOD);
    const bf16_t* O = (const bf16_t*)(ws + OFF_XR); const bf16_t* F = (const bf16_t*)(ws + OFF_HM); const float* OS2 = (const float*)(ws + OFF_OS2); const float* OS4 = (const float*)(ws + OFF_OS4);
    f32x4 xv[NB10][4], ov[NB10][4], fv[NB10][4]; float sso[NB10], ssf[NB10];
#pragma unroll
    for (int b = 0; b < NB10; ++b) { const int r = r0 + b * nw;
        if (PO || r < MR_) { const float* x = xrow(P, r);
#pragma unroll
            for (int i = 0; i < 4; ++i) xv[b][i] = __builtin_nontemporal_load((const f32x4*)(x + i * 256 + lane * 4));
            ld_row16<PO>(O, OS2, r, lane, ov[b]); ld_row16<PO>(F, OS4, r, lane, fv[b]); }
        else {
#pragma unroll
            for (int i = 0; i < 4; ++i) { xv[b][i] = (f32x4){0.f, 0.f, 0.f, 0.f}; ov[b][i] = (f32x4){0.f, 0.f, 0.f, 0.f}; fv[b][i] = (f32x4){0.f, 0.f, 0.f, 0.f}; } } }
#pragma unroll
    for (int b = 0; b < NB10; ++b) { sso[b] = 0.f; ssf[b] = 0.f;
#pragma unroll
        for (int i = 0; i < 4; ++i) { sso[b] += (ov[b][i][0] * ov[b][i][0] + ov[b][i][1] * ov[b][i][1]) + (ov[b][i][2] * ov[b][i][2] + ov[b][i][3] * ov[b][i][3]);
            ssf[b] += (fv[b][i][0] * fv[b][i][0] + fv[b][i][1] * fv[b][i][1]) + (fv[b][i][2] * fv[b][i][2] + fv[b][i][3] * fv[b][i][3]); }
        sso[b] = wave_sum(sso[b]); ssf[b] = wave_sum(ssf[b]); }
#pragma unroll
    for (int b = 0; b < NB10; ++b) { const int r = r0 + b * nw; if (!PO && r >= MR_) continue;
        const float* md = MOD + (size_t)modrow(r) * 6144; float* y = r < T_ ? P.out + O_YP + (size_t)r * 1024 : P.out + O_YS + (size_t)(r - T_) * 1024;
        const float rso = rsqrtf(sso[b] * (1.0f / 1024.0f) + EPS_), rsf = rsqrtf(ssf[b] * (1.0f / 1024.0f) + EPS_);
#pragma unroll
        for (int i = 0; i < 4; ++i) { const int c = i * 256 + lane * 4;
            const f32x4 g1 = *(const f32x4*)(md + 2048 + c), gp = *(const f32x4*)(P.in[I_GPOM] + c), g2 = *(const f32x4*)(md + 5120 + c), gf = *(const f32x4*)(P.in[I_GPOF] + c);
            const f32x4 x1 = xv[b][i] + g1 * ((ov[b][i] * rso) * gp);
            __builtin_nontemporal_store(x1 + g2 * ((fv[b][i] * rsf) * gf), (f32x4*)(y + c)); } }
}
constexpr int NBF = 3;
__device__ __forceinline__ f32x4 up4(const u32x2 w) { return (f32x4){bflo(w.x), bfhi(w.x), bflo(w.y), bfhi(w.y)}; }
__device__ __forceinline__ void phase10_fast(const Params& P, int r0, int nw, int lane) {
    char* ws = P.ws; const float* md = (const float*)(ws + OFF_MOD);
    const bf16_t* O = (const bf16_t*)(ws + OFF_XR); const bf16_t* F = (const bf16_t*)(ws + OFF_HM);
    f32x4 xv[NBF][4]; u32x2 ow[NBF][4], fw[NBF][4]; float sso[NBF], ssf[NBF];
#pragma unroll
    for (int b = 0; b < NBF; ++b) { const int r = r0 + b * nw; const float* x = P.in[I_XP] + (size_t)r * 1024;
#pragma unroll
        for (int i = 0; i < 4; ++i) { const int c = i * 256 + lane * 4; xv[b][i] = __builtin_nontemporal_load((const f32x4*)(x + c));
            ow[b][i] = *(const u32x2*)(O + (size_t)r * 1024 + c); fw[b][i] = *(const u32x2*)(F + (size_t)r * 1024 + c); } }
#pragma unroll
    for (int b = 0; b < NBF; ++b) { sso[b] = 0.f; ssf[b] = 0.f;
#pragma unroll
        for (int i = 0; i < 4; ++i) { const f32x4 o = up4(ow[b][i]), f = up4(fw[b][i]);
            sso[b] += (o[0] * o[0] + o[1] * o[1]) + (o[2] * o[2] + o[3] * o[3]); ssf[b] += (f[0] * f[0] + f[1] * f[1]) + (f[2] * f[2] + f[3] * f[3]); }
        sso[b] = wave_sum(sso[b]); ssf[b] = wave_sum(ssf[b]); }
#pragma unroll
    for (int i = 0; i < 4; ++i) { const int c = i * 256 + lane * 4;
        const f32x4 g1 = *(const f32x4*)(md + 2048 + c), gp = *(const f32x4*)(P.in[I_GPOM] + c), g2 = *(const f32x4*)(md + 5120 + c), gf = *(const f32x4*)(P.in[I_GPOF] + c);
        const f32x4 a1 = g1 * gp, a2 = g2 * gf;
#pragma unroll
        for (int b = 0; b < NBF; ++b) { const int r = r0 + b * nw;
            const float rso = rsqrtf(sso[b] * (1.0f / 1024.0f) + EPS_), rsf = rsqrtf(ssf[b] * (1.0f / 1024.0f) + EPS_);
            const f32x4 x1 = xv[b][i] + a1 * (up4(ow[b][i]) * rso);
            __builtin_nontemporal_store(x1 + a2 * (up4(fw[b][i]) * rsf), (f32x4*)(P.out + O_YP + (size_t)r * 1024 + c)); } }
}
__device__ void phase10(const Params& P) {
    int tid = threadIdx.x; asm volatile("" : "+v"(tid));
    const int wid = __builtin_amdgcn_readfirstlane(tid >> 6), lane = tid & 63;
    const int nw = gridDim.x * 8;
    int r0 = blockIdx.x * 8 + wid;
    for (; r0 + (NBF - 1) * nw < T_; r0 += nw * NBF) phase10_fast(P, r0, nw, lane);
    for (; r0 < MR_; r0 += nw * NB10) {
        if (r0 + (NB10 - 1) * nw < T_) phase10_batch<true>(P, r0, nw, lane); else phase10_batch<false>(P, r0, nw, lane);
    }
}

#define XB_TMO      128
#define XB_XCNT(j)  (256  + 64 * (j))
#define XB_XSUB(j)  (1280 + 64 * (j))
#define XB_XGEN(j)  (2304 + 64 * (j))
#define XB_TOP      3328
#define XB_TOPGEN   3392
#define XCD_BAR_WORDS 3456
#define XB_SPIN_CAP (1u << 22)
__device__ __forceinline__ unsigned xb_ld(unsigned* p)              { return __hip_atomic_load(p, __ATOMIC_RELAXED, __HIP_MEMORY_SCOPE_AGENT); }
__device__ __forceinline__ unsigned xb_add(unsigned* p, unsigned v) { return __hip_atomic_fetch_add(p, v, __ATOMIC_RELAXED, __HIP_MEMORY_SCOPE_AGENT); }
__device__ __forceinline__ unsigned xb_xcc_id() { return (unsigned)__builtin_amdgcn_s_getreg((3 << 11) | 20) & 0xFu; }
#define XB_SPIN(cond, bar) do { unsigned _sp = 0; while (cond) { __builtin_amdgcn_s_sleep(1); \
    if ((++_sp & 255u) == 0u) { if (xb_ld(&(bar)[XB_TMO])) break; if (_sp > XB_SPIN_CAP) { atomicAdd(&(bar)[XB_TMO], 1u); break; } } } } while (0)
struct XcdBarrier { unsigned* bar; unsigned x; volatile LAS unsigned* st; };
__device__ __forceinline__ XcdBarrier xcd_barrier_post(unsigned* bar, volatile LAS unsigned* st) {
    XcdBarrier b; b.bar = bar; b.x = xb_xcc_id(); b.st = st;
    if (threadIdx.x == 0) (void)xb_add(&bar[XB_XCNT(b.x)], 1u);
    return b;
}
__device__ __forceinline__ void xcd_barrier_complete(unsigned* bar, unsigned x, unsigned& nloc, unsigned& nx) {
    const unsigned G = gridDim.x * gridDim.y * gridDim.z;
    unsigned sum, cnt, mine, sp = 0u;
    for (;;) {
        sum = 0u; cnt = 0u; mine = 0u;
#pragma unroll
        for (unsigned j = 0; j < 16; ++j) { const unsigned c = xb_ld(&bar[XB_XCNT(j)]); sum += c; cnt += (c > 0u) ? 1u : 0u; mine = (j == x) ? c : mine; }
        if (sum == G) break;
        __builtin_amdgcn_s_sleep(1);
        if ((++sp & 255u) == 0u) { if (xb_ld(&bar[XB_TMO])) break; if (sp > XB_SPIN_CAP) { atomicAdd(&bar[XB_TMO], 1u); break; } }
    }
    nloc = mine > 0u ? mine : 1u; nx = cnt > 0u ? cnt : 1u;
}
__device__ __forceinline__ void xcd_barrier(const XcdBarrier& b) {
    asm volatile("s_waitcnt vmcnt(0)" ::: "memory");
    __syncthreads();
    if (threadIdx.x == 0) {
        unsigned* bar = b.bar;
        __builtin_amdgcn_s_waitcnt(0);
        unsigned nloc = b.st[0], nx = b.st[1];
        if (nloc == 0u) { xcd_barrier_complete(bar, b.x, nloc, nx); b.st[0] = nloc; b.st[1] = nx; }
        const unsigned old = xb_add(&bar[XB_XSUB(b.x)], 1u);
        const unsigned gen = old / nloc;
        if (old + 1u == (gen + 1u) * nloc) {
            __builtin_amdgcn_fence(__ATOMIC_RELEASE, "agent");
            asm volatile("s_waitcnt vmcnt(0)" ::: "memory");
            const unsigned og = xb_add(&bar[XB_TOP], 1u);
            const unsigned tg = og / nx;
            if (og + 1u == (tg + 1u) * nx) xb_add(&bar[XB_TOPGEN], 1u);
            else XB_SPIN(xb_ld(&bar[XB_TOPGEN]) == tg, bar);
            __builtin_amdgcn_fence(__ATOMIC_ACQUIRE, "agent");
            xb_add(&bar[XB_XGEN(b.x)], 1u);
            asm volatile("s_waitcnt vmcnt(0)" ::: "memory");
        } else {
            XB_SPIN(xb_ld(&bar[XB_XGEN(b.x)]) == gen, bar);
            __builtin_amdgcn_fence(__ATOMIC_ACQUIRE, "agent");
            asm volatile("s_waitcnt vmcnt(0)" ::: "memory");
        }
    }
    __syncthreads();
}

template <bool COOP>
__global__ void __launch_bounds__(512) hymba_mega(Params P, int ph_lo, int ph_hi) {
    extern __shared__ __attribute__((aligned(16))) char lds_raw[];
    LAS unsigned char* lds = (LAS unsigned char*)lds_raw;
    char* ws = P.ws; const int G = gridDim.x, bid = blockIdx.x;
    XcdBarrier xb; xb.bar = (unsigned*)(ws + OFF_BAR); xb.x = 0; xb.st = (volatile LAS unsigned*)(lds + LDS_BYTES - 16);
    if (COOP) { if (threadIdx.x == 0) { xb.st[0] = 0u; xb.st[1] = 0u; } __syncthreads(); xb = xcd_barrier_post((unsigned*)(ws + OFF_BAR), (volatile LAS unsigned*)(lds + LDS_BYTES - 16)); }
#if MK_PROBE
    unsigned long long tprev = __builtin_amdgcn_s_memrealtime(), tacc = 0ull;
#endif
#if MK_PROBE_ID
    unsigned long long tacc2 = 0ull;
#endif
    for (int ph = ph_lo; ph < ph_hi; ++ph) {
        switch (ph) {
        case 0: if constexpr (PH_ON(0)) phase0(P, (float*)lds_raw); break;
        case 1: if constexpr (PH_ON(1)) phase1(P, lds, (float*)lds_raw); break;
        case 2: if constexpr (PH_ON(2)) phase2(P); break;
        case 3: if constexpr (PH_ON(3)) { Gemm g{(const bf16_t*)(ws + OFF_HM), (const bf16_t*)(ws + OFF_WT_IN), 1024}; Sched S; S.init(65, 14, G, bid);
                  Epi1 E{(bf16_t*)(ws + OFF_MIX), (bf16_t*)(ws + OFF_KB), (bf16_t*)(ws + OFF_VT), (bf16_t*)(ws + OFF_VSB), (bf16_t*)(ws + OFF_XR)};
                  PB_BEGIN(5); gemm_phase<Epi1, false, false>(lds, g, S, E); PB_END(5); } break;
        case 4: if constexpr (PH_ON(4)) {
                  const int flip = (bid >> 3) & 1;
#pragma unroll 1
                  for (int st = 0; st < 3; ++st) { const int which = flip ? 2 - st : st;
                      if (which == 0) { for (int it = bid; it < 256; it += G) attn_prompt_item(P, lds_raw, it >> 1, it & 1); }
                      else if (which == 1) { for (int it = bid; it < 256; it += G) attn_sample_item(P, lds_raw, it >> 1, it & 1); }
                      else { for (int it = bid; it < 1024 + 64; it += G) { if (it < 1024) rnn1_item<false>(P, lds_raw, it >> 3, it & 7, 0); else rnn1_item<true>(P, lds_raw, 128, (it - 1024) & 7, (it - 1024) >> 3); } } }
                  state_out_prompt(P); } break;
        case 5: if constexpr (PH_ON(5)) { for (int it = bid; it < 128 * 8; it += G) rnn2_item(P, lds_raw, it >> 3, it & 7); } break;
        case 6: if constexpr (PH_ON(6)) { Gemm g{(const bf16_t*)(ws + OFF_MIX), (const bf16_t*)(ws + OFF_WT_OUT), 2048}; Sched S; S.init(64, 4, G, bid);
                  Epi2 E{(bf16_t*)(ws + OFF_XR), (const float*)(ws + OFF_SS), (const float*)(ws + OFF_SS) + MP_};
                  PB_BEGIN(1); gemm_phase<Epi2, false, true>(lds, g, S, E); PB_END(1);
                  PB_BEGIN(2); for (int it = bid; it < 256; it += G) small_gemm_item<8>((const bf16_t*)(ws + OFF_MIX) + (size_t)T_ * 2048, 2048, (const bf16_t*)(ws + OFF_WT_OUT), 2048, (float*)(ws + OFF_OS2), it >> 3, it & 7,
                                                                          (const float*)(ws + OFF_SS) + ((it & 7) < 4 ? 0 : MP_) + T_); PB_END(2); } break;
        case 7: if constexpr (PH_ON(7)) phase7(P); break;
        case 8: if constexpr (PH_ON(8)) { Gemm g{(const bf16_t*)(ws + OFF_HM), (const bf16_t*)(ws + OFF_WT_UP), 1024}; Sched S; S.init(67, 22, G, bid);
                  Epi3 E{(bf16_t*)(ws + OFF_MIX), P.in[I_FCW], P.in[I_FCB], P.in[I_SF], P.out};
                  PB_BEGIN(6); gemm_phase<Epi3, true, false>(lds, g, S, E); PB_END(6); } break;
        case 9: if constexpr (PH_ON(9)) { Gemm g{(const bf16_t*)(ws + OFF_MIX), (const bf16_t*)(ws + OFF_WT_DOWN), 2816}; Sched S; S.init(64, 4, G, bid);
                  Epi4 E{(bf16_t*)(ws + OFF_HM)};
                  PB_BEGIN(3); gemm_phase<Epi4, false, false>(lds, g, S, E); PB_END(3);
                  PB_BEGIN(4); for (int it = bid; it < 256; it += G) small_gemm_item<11>((const bf16_t*)(ws + OFF_MIX) + (size_t)T_ * 2816, 2816, (const bf16_t*)(ws + OFF_WT_DOWN), 2816, (float*)(ws + OFF_OS4), it >> 3, it & 7, nullptr); PB_END(4); } break;
        case 10: if constexpr (PH_ON(10)) phase10(P); break;
        }
        if (COOP) { if (ph + 1 < ph_hi) xcd_barrier(xb); }
#if MK_PROBE
        { const unsigned long long tn = __builtin_amdgcn_s_memrealtime(); if ((MK_PROBE >> ph) & 1) tacc += tn - tprev; tprev = tn; }
#endif
    }
#if MK_PROBE_ID
    if (bid == 0 && threadIdx.x == 0) { const unsigned long long t0 = __builtin_amdgcn_s_memrealtime(); while (__builtin_amdgcn_s_memrealtime() - t0 < 4ull * tacc2) __builtin_amdgcn_s_sleep(8); }
#endif
#if MK_PROBE
    if (bid == 0 && threadIdx.x == 0) { const unsigned long long t0 = __builtin_amdgcn_s_memrealtime(); while (__builtin_amdgcn_s_memrealtime() - t0 < 4ull * tacc) __builtin_amdgcn_s_sleep(8); }
#endif
}

extern "C" void kernel_launch(void* const* d_in, const int* in_sizes, int n_in, void* d_out, int out_size, void* d_ws, size_t ws_size, hipStream_t stream) {
    (void)in_sizes; (void)out_size;
    if (n_in != 31 || ws_size < WS_NEED) { fprintf(stderr, "hymba_mega: bad arguments (n_in %d, ws %zu < %zu)\n", n_in, ws_size, (size_t)WS_NEED); return; }
    Params P{};
    for (int i = 0; i < 31; ++i) P.in[i] = (const float*)d_in[i];
    P.out = (float*)d_out; P.ws = (char*)d_ws;
#if MK_COOP
    static int grid_blocks = 0;
    if (!grid_blocks) {
        (void)hipFuncSetAttribute((const void*)hymba_mega<true>, hipFuncAttributeMaxDynamicSharedMemorySize, LDS_BYTES);
        int dev = 0, cus = 0, per_cu = 0; (void)hipGetDevice(&dev); (void)hipDeviceGetAttribute(&cus, hipDeviceAttributeMultiprocessorCount, dev);
        (void)hipOccupancyMaxActiveBlocksPerMultiprocessor(&per_cu, (const void*)hymba_mega<true>, 512, LDS_BYTES);
        if (per_cu < 1) per_cu = 1; if (per_cu > 1) per_cu = 1;
        grid_blocks = cus * per_cu;
    }
    (void)hipMemsetAsync((char*)d_ws + OFF_BAR, 0, 16384, stream);
    int lo = 0, hi = 11; void* args[] = {&P, &lo, &hi};
    hipError_t e = hipLaunchCooperativeKernel((const void*)hymba_mega<true>, dim3(grid_blocks), dim3(512), args, LDS_BYTES, stream);
    if (e != hipSuccess) fprintf(stderr, "cooperative launch failed: %s (grid %d)\n", hipGetErrorString(e), grid_blocks);
#else
    static bool attr = false;
    if (!attr) { attr = true; (void)hipFuncSetAttribute((const void*)hymba_mega<false>, hipFuncAttributeMaxDynamicSharedMemorySize, LDS_BYTES); }
    for (int ph = 0; ph < 11; ++ph) hymba_mega<false><<<dim3(256), dim3(512), LDS_BYTES, stream>>>(P, ph, ph + 1);
#endif
}
```

```cpp
#include <hip/hip_runtime.h>
#include <hip/hip_cooperative_groups.h>
#include <cstdio>
#include <cstdint>
namespace cg = cooperative_groups;

#ifndef MK_COOP
#define MK_COOP 1
#endif
#ifndef MK_PROBE
#define MK_PROBE 0
#endif
#ifndef MK_PROBE_ID
#define MK_PROBE_ID 0
#endif
#if MK_PROBE_ID
#define PB_BEGIN(id) unsigned long long _pb##id = 0; if (((MK_PROBE_ID) >> (id)) & 1) _pb##id = __builtin_amdgcn_s_memrealtime()
#define PB_END(id) if (((MK_PROBE_ID) >> (id)) & 1) tacc2 += __builtin_amdgcn_s_memrealtime() - _pb##id
#else
#define PB_BEGIN(id)
#define PB_END(id)
#endif
#ifndef MK_PHMASK
#define MK_PHMASK 0x7ff
#endif
#define PH_ON(x) (((MK_PHMASK) >> (x)) & 1)

#define LAS __attribute__((address_space(3)))
typedef unsigned short bf16_t;
typedef short bf16x8 __attribute__((ext_vector_type(8)));
typedef short s16x4 __attribute__((ext_vector_type(4)));
typedef float f32x4 __attribute__((ext_vector_type(4)));
typedef float f32x16 __attribute__((ext_vector_type(16)));
typedef unsigned u32x4 __attribute__((ext_vector_type(4)));
typedef unsigned u32x2 __attribute__((ext_vector_type(2)));

constexpr int T_ = 16384, SB_ = 128, MR_ = 16512, MP_ = 16640;
constexpr float EPS_ = 1e-6f;
constexpr float LOG2E_ = 1.4426950408889634f;
constexpr float QSCALE_ = 0.08838834764831845f * 1.4426950408889634f;
constexpr int LDS_BYTES = 140288;

constexpr size_t OFF_WT_ADA = 0;
constexpr size_t OFF_A_ADA = OFF_WT_ADA + (size_t)6144 * 1024 * 2;
constexpr size_t OFF_MOD = OFF_A_ADA + (size_t)256 * 1024 * 2;
constexpr size_t OFF_WT_IN = OFF_MOD + (size_t)256 * 6144 * 4;
constexpr size_t OFF_WT_OUT = OFF_WT_IN + (size_t)3584 * 1024 * 2;
constexpr size_t OFF_WT_UP = OFF_WT_OUT + (size_t)1024 * 2048 * 2;
constexpr size_t OFF_WT_DOWN = OFF_WT_UP + (size_t)5632 * 1024 * 2;
constexpr size_t OFF_WT_A = OFF_WT_DOWN + (size_t)1024 * 2816 * 2;
constexpr size_t OFF_WT_I = OFF_WT_A + (size_t)8 * 128 * 128 * 2;
constexpr size_t OFF_SP8 = OFF_WT_I + (size_t)8 * 128 * 128 * 2;
constexpr size_t OFF_SS = OFF_SP8 + 4096;
constexpr size_t OFF_SEGA = OFF_SS + (size_t)4 * MP_ * 4;
constexpr size_t OFF_SEGE = OFF_SEGA + (size_t)512 * 1024 * 4;
constexpr size_t OFF_TILEA = OFF_SEGE + (size_t)512 * 1024 * 4;
constexpr size_t OFF_TILEE = OFF_TILEA + (size_t)128 * 1024 * 4;
constexpr size_t OFF_VSB = OFF_TILEE + (size_t)128 * 1024 * 4;
constexpr size_t OFF_OS2 = OFF_VSB + (size_t)256 * 256 * 2;
constexpr size_t OFF_OS4 = OFF_OS2 + (size_t)8 * 128 * 1024 * 4;
constexpr size_t OFF_BAR = OFF_OS4 + (size_t)8 * 128 * 1024 * 4;
constexpr size_t OFF_MIX = OFF_BAR + 16384;
constexpr size_t OFF_U = OFF_MIX + (size_t)MP_ * 2048 * 2;
constexpr size_t OFF_KB = OFF_U + (size_t)MP_ * 1024 * 2;
constexpr size_t OFF_VT = OFF_KB + (size_t)MP_ * 256 * 2;
constexpr size_t OFF_XR = OFF_VT + (size_t)256 * T_ * 2;
constexpr size_t OFF_HM0 = OFF_XR + (size_t)MP_ * 1024 * 2;
constexpr size_t OFF_HM = OFF_HM0 + 4096;
constexpr size_t WS_NEED = OFF_HM + (size_t)MP_ * 1024 * 2;
static_assert(WS_NEED <= (size_t)256 * 1024 * 1024, "workspace");
static_assert(OFF_MIX + (size_t)MP_ * 2816 * 2 <= OFF_KB, "FIN alias");

constexpr size_t O_YP = 0, O_YS = O_YP + (size_t)T_ * 1024, O_KP = O_YS + 128 * 1024, O_VP = O_KP + 32768, O_HP = O_VP + 32768,
                 O_CP = O_HP + 1024, O_FP = O_CP + 3072, O_KS = O_FP + 11264, O_VS = O_KS + 4194304, O_HS = O_VS + 4194304,
                 O_CS = O_HS + 131072, O_FS = O_CS + 393216;

struct Params { const float* in[31]; float* out; char* ws; };
enum { I_XP = 0, I_XS, I_CK, I_CV, I_SH, I_SC, I_SF, I_CP, I_CS, I_WADA, I_BADA, I_GPM, I_WIN, I_CW, I_CB, I_WA, I_BA, I_WI, I_BI, I_LAM, I_SINK,
       I_GAO, I_GRO, I_WOUT, I_GPOM, I_GPF, I_WUP, I_FCW, I_FCB, I_WDOWN, I_GPOF };

__device__ __forceinline__ unsigned cvt_pk_bf16(float lo, float hi) { unsigned r; asm volatile("v_cvt_pk_bf16_f32 %0, %1, %2" : "=v"(r) : "v"(lo), "v"(hi)); return r; }
__device__ __forceinline__ float bf2f(unsigned b) { return __uint_as_float(b << 16); }
__device__ __forceinline__ float bflo(unsigned w) { return __uint_as_float(w << 16); }
__device__ __forceinline__ float bfhi(unsigned w) { return __uint_as_float(w & 0xffff0000u); }
__device__ __forceinline__ bf16_t f2bf(float f) { return (bf16_t)(cvt_pk_bf16(f, 0.f) & 0xffffu); }
__device__ __forceinline__ float gelu_t(float x) { const float u = x * (1.0f + 0.044715f * x * x); const float e = __builtin_amdgcn_exp2f(-2.302208198f * u); return x * __builtin_amdgcn_rcpf(1.0f + e); }
__device__ __forceinline__ float sigmoid_f(float x) { return __builtin_amdgcn_rcpf(1.0f + __builtin_amdgcn_exp2f(-LOG2E_ * x)); }
__device__ __forceinline__ float wave_sum(float v) { v += __shfl_xor(v, 1); v += __shfl_xor(v, 2); v += __shfl_xor(v, 4); v += __shfl_xor(v, 8); v += __shfl_xor(v, 16); v += __shfl_xor(v, 32); return v; }
__device__ __forceinline__ int modrow(int r) { return r < T_ ? 0 : r - T_ + 1; }

constexpr int BM = 256, BK = 64, HALF = 128, HTB = HALF * BK * 2, STAGE_BYTES = 8 * HTB, NXCD = 8, WGM = 8;
__device__ __forceinline__ int lds_byte(int r, int c) { const int st = (r >> 4) * 2 + (c >> 5), rr = r & 15, cc = c & 31, ob = rr * 64 + cc * 2; return st * 1024 + (ob ^ (((ob >> 9) & 1) << 5)); }
__device__ __forceinline__ void stage_rc(int b, int& R, int& C) { const int st = b / 1024, sb = b % 1024, swz = sb ^ (((sb >> 9) & 1) << 5); R = (st >> 1) * 16 + swz / 64; C = (st & 1) * 32 + (swz % 64) / 2; }
struct Unit { int pm, pn; };
struct Gemm { const bf16_t* A; const bf16_t* Bt; int K; };
struct Sched {
    int nM, nN, nwg, G, c;
    __device__ void init(int nM_, int nN_, int G_, int c_) { nM = nM_; nN = nN_; nwg = nM * nN; G = G_; c = c_; }
    __device__ bool next(int i, Unit& u) const {
        const long L = (long)i * G + c; if (L >= nwg) return false;
        int wgid = (int)L; { const int q = nwg / NXCD, r = nwg % NXCD, xcd = wgid % NXCD, off = wgid / NXCD; wgid = (xcd < r ? xcd * (q + 1) : r * (q + 1) + (xcd - r) * q) + off; }
        const int nig = WGM * nN, gid = wgid / nig, fm = gid * WGM, gsz = (nM - fm) < WGM ? (nM - fm) : WGM;
        u.pm = fm + ((wgid % nig) % gsz); u.pn = (wgid % nig) / gsz; return true;
    }
};
template <bool APERM> __device__ __forceinline__ size_t tileA_off(int pm, int K) {
    if (APERM) return (size_t)(pm < 66 ? 252 * pm : 16386) * (size_t)K * 2 - (size_t)2 * K * 2;
    return (size_t)pm * 256 * (size_t)K * 2;
}

template <class Epi, bool APERM, bool MID>
__device__ __forceinline__ void gemm_phase(LAS unsigned char* lds, const Gemm g, const Sched& S, const Epi& E) {
    int tid = threadIdx.x; asm volatile("" : "+v"(tid));
    const int wid = __builtin_amdgcn_readfirstlane(tid >> 6), lane = tid & 63, wr = wid >> 2, wc = wid & 3, fr = lane & 15, fq = lane >> 4;
    const int K = g.K, nt = K / BK;
    unsigned voffA[2], voffB[2];
#pragma unroll
    for (int i = 0; i < 2; ++i) { int R, C; stage_rc(tid * 16 + i * 8192, R, C);
        const int Ra = APERM ? (126 * (R >> 6) + 8 * (R & 15) + ((R >> 4) & 3)) : R;
        voffA[i] = (unsigned)(Ra * K + C) * 2u; voffB[i] = (unsigned)(R * K + C) * 2u; }
    const size_t kstep = (size_t)(BK * 2);
    const size_t hstepB = (size_t)HALF * K * 2;
    const size_t hstepA = APERM ? (size_t)4 * K * 2 : hstepB;
    const size_t tstepB = 2 * hstepB;
    const unsigned ldsw = (unsigned)wid * 1024u;
    const int aoff = lds_byte(wr * 64 + fr, fq * 8), boff = lds_byte(wc * 32 + fr, fq * 8);
#define PG8_SA(b, h) (((b) * 2 + (h)) * HTB)
#define PG8_SB(b, h) ((4 + (b) * 2 + (h)) * HTB)
#define PG8_STAGE(bufoff, gbase, voff) do { _Pragma("unroll") for (int _i = 0; _i < 2; ++_i) \
        __builtin_amdgcn_global_load_lds((const unsigned*)((const char*)(gbase) + (voff)[_i]), (LAS unsigned*)(lds + (bufoff) + ldsw + _i * 8192), 16, 0, 0); } while (0)
#define PG8_LDA(dst, b, h) do { _Pragma("unroll") for (int m = 0; m < 4; ++m) _Pragma("unroll") for (int k = 0; k < 2; ++k) dst[m][k] = *(const LAS bf16x8*)(lds + PG8_SA(b, h) + aoff + m * 2048 + k * 1024); } while (0)
#define PG8_LDB(dst, b, h) do { _Pragma("unroll") for (int n = 0; n < 2; ++n) _Pragma("unroll") for (int k = 0; k < 2; ++k) dst[n][k] = *(const LAS bf16x8*)(lds + PG8_SB(b, h) + boff + n * 2048 + k * 1024); } while (0)
#define PG8_MMA(ai, bj, At, Bt) do { __builtin_amdgcn_s_setprio(1); _Pragma("unroll") for (int m = 0; m < 4; ++m) _Pragma("unroll") for (int n = 0; n < 2; ++n) _Pragma("unroll") for (int k = 0; k < 2; ++k) \
        acc[ai][bj][m][n] = __builtin_amdgcn_mfma_f32_16x16x32_bf16(Bt[n][k], At[m][k], acc[ai][bj][m][n], 0, 0, 0); __builtin_amdgcn_s_setprio(0); } while (0)
#define PG8_WAIT_V(n) asm volatile("s_waitcnt vmcnt(" #n ")" ::: "memory")
#define PG8_WAIT_L(n) asm volatile("s_waitcnt lgkmcnt(" #n ")" ::: "memory")
#define PG8_BAR __builtin_amdgcn_s_barrier()
#define PG8_SCHED __builtin_amdgcn_sched_barrier(0)
    Unit cur, nxt; int ui = 0;
    if (!S.next(0, cur)) return;
    f32x4 acc[2][2][4][2];
#pragma unroll
    for (int a = 0; a < 2; ++a)
#pragma unroll
        for (int b = 0; b < 2; ++b)
#pragma unroll
            for (int m = 0; m < 4; ++m)
#pragma unroll
                for (int n = 0; n < 2; ++n) acc[a][b][m][n] = (f32x4){0.f, 0.f, 0.f, 0.f};
    bf16x8 At[4][2], B0[2][2], B1[2][2];
    const char* cA = (const char*)g.A + tileA_off<APERM>(cur.pm, K); const char* cB = (const char*)g.Bt + (size_t)cur.pn * tstepB;
    PG8_STAGE(PG8_SB(0, 0), cB, voffB); PG8_STAGE(PG8_SA(0, 0), cA, voffA); PG8_STAGE(PG8_SB(0, 1), cB + hstepB, voffB); PG8_STAGE(PG8_SA(0, 1), cA + hstepA, voffA);
    if (wr == 1) PG8_BAR;
    PG8_WAIT_V(4); PG8_BAR;
    PG8_STAGE(PG8_SB(1, 0), cB + kstep, voffB); PG8_STAGE(PG8_SA(1, 0), cA + kstep, voffA); PG8_STAGE(PG8_SB(1, 1), cB + hstepB + kstep, voffB);
    PG8_WAIT_V(6); PG8_BAR;
    for (;;) {
        const bool has_next = S.next(ui + 1, nxt);
        const char* nA = has_next ? (const char*)g.A + tileA_off<APERM>(nxt.pm, K) : cA; const char* nB = has_next ? (const char*)g.Bt + (size_t)nxt.pn * tstepB : cB;
        for (int t = 0; t < nt; t += 2) {
            const bool last = (t == nt - 2);
            const char* a1 = cA + (size_t)(t + 1) * kstep;
            const char* a2 = last ? nA : cA + (size_t)(t + 2) * kstep; const char* b2 = last ? nB : cB + (size_t)(t + 2) * kstep;
            const char* a3 = a2 + kstep; const char* b3 = b2 + kstep;
            if constexpr (MID) { if (t == (nt >> 1)) E.mid(acc, cur, wr, fr); }
            PG8_LDB(B0, 0, 0); PG8_SCHED; PG8_LDA(At, 0, 0); PG8_STAGE(PG8_SA(1, 1), a1 + hstepA, voffA);
            PG8_WAIT_L(8); PG8_BAR; PG8_WAIT_L(0); PG8_MMA(0, 0, At, B0); PG8_BAR; PG8_SCHED;
            PG8_LDB(B1, 0, 1); PG8_STAGE(PG8_SB(0, 0), b2, voffB);
            PG8_BAR; PG8_WAIT_L(0); PG8_MMA(0, 1, At, B1); PG8_BAR;
            PG8_LDA(At, 0, 1); PG8_STAGE(PG8_SA(0, 0), a2, voffA);
            PG8_BAR; PG8_WAIT_L(0); PG8_MMA(1, 0, At, B0); PG8_BAR; PG8_SCHED;
            PG8_STAGE(PG8_SB(0, 1), b2 + hstepB, voffB);
            PG8_WAIT_V(6); PG8_BAR; PG8_MMA(1, 1, At, B1); PG8_BAR;
            PG8_LDB(B0, 1, 0); PG8_SCHED; PG8_LDA(At, 1, 0); PG8_STAGE(PG8_SA(0, 1), a2 + hstepA, voffA);
            PG8_WAIT_L(8); PG8_BAR; PG8_WAIT_L(0); PG8_MMA(0, 0, At, B0); PG8_BAR; PG8_SCHED;
            PG8_LDB(B1, 1, 1); PG8_STAGE(PG8_SB(1, 0), b3, voffB);
            PG8_BAR; PG8_WAIT_L(0); PG8_MMA(0, 1, At, B1); PG8_BAR;
            PG8_LDA(At, 1, 1); PG8_STAGE(PG8_SA(1, 0), a3, voffA);
            PG8_BAR; PG8_WAIT_L(0); PG8_MMA(1, 0, At, B0); PG8_BAR; PG8_SCHED;
            PG8_STAGE(PG8_SB(1, 1), b3 + hstepB, voffB);
            PG8_WAIT_V(6); PG8_BAR; PG8_MMA(1, 1, At, B1); PG8_BAR;
        }
        E(acc, cur, wr, wc, fr, fq);
        if (!has_next) break;
#pragma unroll
        for (int a = 0; a < 2; ++a)
#pragma unroll
            for (int b = 0; b < 2; ++b)
#pragma unroll
                for (int m = 0; m < 4; ++m)
#pragma unroll
                    for (int n = 0; n < 2; ++n) acc[a][b][m][n] = (f32x4){0.f, 0.f, 0.f, 0.f};
        cur = nxt; cA = nA; cB = nB; ++ui;
    }
    PG8_WAIT_V(0);
    if (wr == 0) PG8_BAR;
    PG8_BAR;
#undef PG8_SA
#undef PG8_SB
#undef PG8_STAGE
#undef PG8_LDA
#undef PG8_LDB
#undef PG8_MMA
#undef PG8_WAIT_V
#undef PG8_WAIT_L
#undef PG8_BAR
#undef PG8_SCHED
}

typedef f32x4 AccT[2][2][4][2];

#ifndef E1MASK
#define E1MASK 31
#endif
#define E1B(x) (((E1MASK) >> (x)) & 1)
#ifndef P4MASK
#define P4MASK 7
#endif
#define P4B(x) (((P4MASK) >> (x)) & 1)
#define EPI_FENCE() asm volatile("" ::: "memory")
__device__ __forceinline__ u32x2 pk4(const f32x4 v) { u32x2 w; w.x = cvt_pk_bf16(v[0], v[1]); w.y = cvt_pk_bf16(v[2], v[3]); return w; }

struct EpiAda {
    float* C; const float* bias;
    __device__ __forceinline__ void operator()(const AccT& acc, const Unit& u, int wr, int wc, int fr, int fq) const {
        const int col0 = u.pn * BM + wc * 32 + 4 * fq;
        float* base = C + (size_t)(u.pm * BM + wr * 64 + fr) * 6144 + col0; const float* bp = bias + col0;
#pragma unroll
        for (int bj = 0; bj < 2; ++bj)
#pragma unroll
            for (int n = 0; n < 2; ++n) { const f32x4 bv = *(const f32x4*)(bp + bj * HALF + n * 16);
#pragma unroll
                for (int ai = 0; ai < 2; ++ai)
#pragma unroll
                    for (int m = 0; m < 4; ++m) *(f32x4*)(base + (size_t)(ai * HALF + m * 16) * 6144 + bj * HALF + n * 16) = acc[ai][bj][m][n] + bv;
                EPI_FENCE(); }
    }
};

struct Epi1 {
    bf16_t* MIX; bf16_t* KB; bf16_t* VT; bf16_t* VSB; bf16_t* XR;
    __device__ __forceinline__ void operator()(const AccT& acc, const Unit& u, int wr, int wc, int fr, int fq) const {
        const int rl = wr * 64 + fr, row0 = u.pm * BM + rl, cw = wc * 32 + 4 * fq; const int pn = u.pn, pm = u.pm;
        if (pn == 5 && pm < 64) {
            bf16_t* cp0 = VT + (size_t)cw * T_ + row0;
#pragma unroll
            for (int bj = 0; bj < 2; ++bj)
#pragma unroll
                for (int n = 0; n < 2; ++n) {
#pragma unroll
                    for (int e = 0; e < 4; ++e) { bf16_t* p = cp0 + (size_t)(bj * HALF + n * 16 + e) * T_;
#pragma unroll
                        for (int ai = 0; ai < 2; ++ai)
#pragma unroll
                            for (int m = 0; m < 4; ++m) p[ai * HALF + m * 16] = f2bf(acc[ai][bj][m][n][e]);
                        EPI_FENCE(); } }
            return;
        }
        bf16_t* base; int ld; float sc = 1.0f; bool gel = false;
        if (pn < 4) { base = MIX + (size_t)row0 * 2048 + pn * 256 + cw; ld = 2048; sc = QSCALE_; }
        else if (pn == 4) { base = KB + (size_t)row0 * 256 + cw; ld = 256; }
        else if (pn == 5) { base = VSB + (size_t)rl * 256 + cw; ld = 256; }
        else if (pn < 10) { base = XR + (size_t)row0 * 1024 + (pn - 6) * 256 + cw; ld = 1024; }
        else { base = MIX + (size_t)row0 * 2048 + 1024 + (pn - 10) * 256 + cw; ld = 2048; gel = true; }
        if (!gel) {
#pragma unroll
            for (int ai = 0; ai < 2; ++ai)
#pragma unroll
                for (int m = 0; m < 4; ++m) { bf16_t* rp = base + (size_t)(ai * HALF + m * 16) * ld;
#pragma unroll
                    for (int bj = 0; bj < 2; ++bj)
#pragma unroll
                        for (int n = 0; n < 2; ++n) *(u32x2*)(rp + bj * HALF + n * 16) = pk4(acc[ai][bj][m][n] * sc);
                    EPI_FENCE(); }
        } else {
#pragma unroll
            for (int ai = 0; ai < 2; ++ai)
#pragma unroll
                for (int m = 0; m < 4; ++m) { bf16_t* rp = base + (size_t)(ai * HALF + m * 16) * ld;
#pragma unroll
                    for (int bj = 0; bj < 2; ++bj)
#pragma unroll
                        for (int n = 0; n < 2; ++n) { const f32x4 v = acc[ai][bj][m][n]; u32x2 w; w.x = cvt_pk_bf16(gelu_t(v[0]), gelu_t(v[1])); w.y = cvt_pk_bf16(gelu_t(v[2]), gelu_t(v[3]));
                            *(u32x2*)(rp + bj * HALF + n * 16) = w; }
                    EPI_FENCE(); }
        }
    }
};

struct Epi2 {
    bf16_t* O; const float* SSA; const float* SSR;
    __device__ __forceinline__ void mid(AccT& acc, const Unit& u, int wr, int fr) const {
        const int row0 = u.pm * BM + wr * 64 + fr; const float* pa = SSA + row0; const float* pr = SSR + row0;
        float va[8], vr[8];
#pragma unroll
        for (int q = 0; q < 8; ++q) { va[q] = pa[(q >> 2) * HALF + (q & 3) * 16]; vr[q] = pr[(q >> 2) * HALF + (q & 3) * 16]; }
        EPI_FENCE();
#pragma unroll
        for (int ai = 0; ai < 2; ++ai)
#pragma unroll
            for (int m = 0; m < 4; ++m) {
                const float ra = va[ai * 4 + m] * (1.0f / 1024.0f) + EPS_, rr = vr[ai * 4 + m] * (1.0f / 1024.0f) + EPS_; const float ratio = sqrtf(rr * __builtin_amdgcn_rcpf(ra));
#pragma unroll
                for (int bj = 0; bj < 2; ++bj)
#pragma unroll
                    for (int n = 0; n < 2; ++n) acc[ai][bj][m][n] *= ratio; }
    }
    __device__ __forceinline__ void operator()(const AccT& acc, const Unit& u, int wr, int wc, int fr, int fq) const {
        const int row0 = u.pm * BM + wr * 64 + fr, col0 = u.pn * BM + wc * 32 + 4 * fq;
        bf16_t* base = O + (size_t)row0 * 1024 + col0; const float* pr = SSR + row0;
        float vr[8];
#pragma unroll
        for (int q = 0; q < 8; ++q) vr[q] = pr[(q >> 2) * HALF + (q & 3) * 16];
        EPI_FENCE();
#pragma unroll
        for (int ai = 0; ai < 2; ++ai)
#pragma unroll
            for (int m = 0; m < 4; ++m) { const float rs = rsqrtf(vr[ai * 4 + m] * (1.0f / 1024.0f) + EPS_); bf16_t* rp = base + (size_t)(ai * HALF + m * 16) * 1024;
#pragma unroll
                for (int bj = 0; bj < 2; ++bj)
#pragma unroll
                    for (int n = 0; n < 2; ++n) *(u32x2*)(rp + bj * HALF + n * 16) = pk4(acc[ai][bj][m][n] * rs);
                EPI_FENCE(); }
    }
};

struct Epi4 {
    bf16_t* F;
    __device__ __forceinline__ void operator()(const AccT& acc, const Unit& u, int wr, int wc, int fr, int fq) const {
        const int row0 = u.pm * BM + wr * 64 + fr, col0 = u.pn * BM + wc * 32 + 4 * fq;
        bf16_t* base = F + (size_t)row0 * 1024 + col0;
#pragma unroll
        for (int ai = 0; ai < 2; ++ai)
#pragma unroll
            for (int m = 0; m < 4; ++m) { bf16_t* rp = base + (size_t)(ai * HALF + m * 16) * 1024;
#pragma unroll
                for (int bj = 0; bj < 2; ++bj)
#pragma unroll
                    for (int n = 0; n < 2; ++n) *(u32x2*)(rp + bj * HALF + n * 16) = pk4(acc[ai][bj][m][n]);
                EPI_FENCE(); }
    }
};

template <int KS>
__device__ __forceinline__ void small_gemm_item(const bf16_t* A, int lda, const bf16_t* Bt, int ldb, float* OS, int nc, int ksp, const float* ss) {
    int tid = threadIdx.x; asm volatile("" : "+v"(tid));
    const int wid = tid >> 6, lane = tid & 63, fr = lane & 15, fq = lane >> 4;
    const int k0 = ksp * KS * 32, n0 = nc * 32, row = 16 * wid + fr;
    const bf16_t* ap = A + (size_t)row * lda + k0 + 8 * fq; const bf16_t* bp = Bt + (size_t)(n0 + fr) * ldb + k0 + 8 * fq;
    bf16x8 af[KS], b0[KS], b1[KS];
#pragma unroll
    for (int ks = 0; ks < KS; ++ks) { af[ks] = *(const bf16x8*)(ap + 32 * ks); b0[ks] = *(const bf16x8*)(bp + 32 * ks); b1[ks] = *(const bf16x8*)(bp + (size_t)16 * ldb + 32 * ks); }
    __builtin_amdgcn_sched_barrier(0);
    f32x4 c0 = {0.f, 0.f, 0.f, 0.f}, c1 = {0.f, 0.f, 0.f, 0.f};
#pragma unroll
    for (int ks = 0; ks < KS; ++ks) { c0 = __builtin_amdgcn_mfma_f32_16x16x32_bf16(b0[ks], af[ks], c0, 0, 0, 0); c1 = __builtin_amdgcn_mfma_f32_16x16x32_bf16(b1[ks], af[ks], c1, 0, 0, 0); }
    float sc = 1.0f; if (ss) sc = rsqrtf(ss[row] * (1.0f / 1024.0f) + EPS_);
    float* op = OS + (size_t)ksp * 131072 + (size_t)row * 1024 + n0 + 4 * fq;
    *(f32x4*)op = c0 * sc; *(f32x4*)(op + 16) = c1 * sc;
}

struct Epi3 {
    bf16_t* FIN; const float* fcw; const float* fcb; const float* sfc; float* out;
    __device__ __forceinline__ void operator()(const AccT& acc, const Unit& u, int wr, int wc, int fr, int fq) const {
        const bool sample = (u.pm == 66);
        const int tau = sample ? 16386 : 252 * u.pm;
        const int tb = tau + 126 * wr + 8 * fr - 2;
        const int j0 = 128 * u.pn + 32 * wc + 4 * fq;
#pragma unroll
        for (int n = 0; n < 2; ++n) {
            const int j = j0 + 16 * n; const float* wp = fcw + j; const float* bp = fcb + j;
            const f32x4 gw0 = *(const f32x4*)(wp), gw1 = *(const f32x4*)(wp + 5632), gw2 = *(const f32x4*)(wp + 2 * 5632), gb = *(const f32x4*)(bp);
            const f32x4 vw0 = *(const f32x4*)(wp + 2816), vw1 = *(const f32x4*)(wp + 5632 + 2816), vw2 = *(const f32x4*)(wp + 2 * 5632 + 2816), vb = *(const f32x4*)(bp + 2816);
            EPI_FENCE();
            if (!sample) {
                f32x4 g2, g1, v2, v1;
#pragma unroll
                for (int e = 0; e < 4; ++e) { g2[e] = __shfl_up(acc[1][0][2][n][e], 1, 16); g1[e] = __shfl_up(acc[1][0][3][n][e], 1, 16);
                                              v2[e] = __shfl_up(acc[1][1][2][n][e], 1, 16); v1[e] = __shfl_up(acc[1][1][3][n][e], 1, 16); }
                bf16_t* fp = FIN + (size_t)tb * 2816 + j;
#pragma unroll
                for (int s = 0; s < 8; ++s) {
                    const f32x4 g0 = acc[s >> 2][0][s & 3][n], v0 = acc[s >> 2][1][s & 3][n];
                    const int t = tb + s;
                    const bool valid = !(fr == 0 && s < 2) && t < T_;
                    if (valid) {
                        const f32x4 yg = gw0 * g2 + gw1 * g1 + gw2 * g0 + gb, yv = vw0 * v2 + vw1 * v1 + vw2 * v0 + vb;
                        u32x2 w; w.x = cvt_pk_bf16(gelu_t(yg[0]) * yv[0], gelu_t(yg[1]) * yv[1]); w.y = cvt_pk_bf16(gelu_t(yg[2]) * yv[2], gelu_t(yg[3]) * yv[3]);
                        *(u32x2*)(fp) = w;
                    }
                    g2 = g1; g1 = g0; v2 = v1; v1 = v0; fp += 2816;
                    EPI_FENCE();
                }
                if (u.pm == 65 && wr == 0 && fr == 0) {
                    float* ob = out + O_FP + j;
                    *(f32x4*)(ob) = acc[1][0][0][n]; *(f32x4*)(ob + 2816) = acc[1][1][0][n];
                    *(f32x4*)(ob + 5632) = acc[1][0][1][n]; *(f32x4*)(ob + 5632 + 2816) = acc[1][1][1][n];
                }
            } else if (wr == 0) {
                const float* sp = sfc + (size_t)(8 * fr) * 11264 + j; bf16_t* fp = FIN + (size_t)(T_ + 8 * fr) * 2816 + j; float* ob = out + O_FS + (size_t)(8 * fr) * 11264 + 5632 + j;
#pragma unroll
                for (int s = 0; s < 8; ++s) {
                    const f32x4 g0 = acc[s >> 2][0][s & 3][n], v0 = acc[s >> 2][1][s & 3][n];
                    const f32x4 sg0 = *(const f32x4*)(sp), sg1 = *(const f32x4*)(sp + 5632), sv0 = *(const f32x4*)(sp + 2816), sv1 = *(const f32x4*)(sp + 5632 + 2816);
                    const f32x4 yg = gw0 * sg0 + gw1 * sg1 + gw2 * g0 + gb, yv = vw0 * sv0 + vw1 * sv1 + vw2 * v0 + vb;
                    u32x2 w; w.x = cvt_pk_bf16(gelu_t(yg[0]) * yv[0], gelu_t(yg[1]) * yv[1]); w.y = cvt_pk_bf16(gelu_t(yg[2]) * yv[2], gelu_t(yg[3]) * yv[3]);
                    *(u32x2*)(fp) = w;
                    *(f32x4*)(ob) = g0; *(f32x4*)(ob + 2816) = v0;
                    sp += 11264; fp += 2816; ob += 11264;
                    EPI_FENCE();
                }
            }
            EPI_FENCE();
        }
    }
};

__device__ __forceinline__ void tr_tile(float* tl, const float* W, int ldw, bf16_t* Wt, int ldt, int k0, int n0, int dn0, const float* ks0, const float* ks1) {
    int tid = threadIdx.x; asm volatile("" : "+v"(tid));
    { const int r = tid >> 4, c4 = (tid & 15) * 4;
#pragma unroll
      for (int p = 0; p < 2; ++p) { const int row = p * 32 + r; const f32x4 v = *(const f32x4*)(W + (size_t)(k0 + row) * ldw + n0 + c4);
          float sc = 1.f; if (ks0) { const int k = k0 + row; sc = k < 1024 ? ks0[k] : ks1[k - 1024]; }
          tl[row * 65 + c4 + 0] = v[0] * sc; tl[row * 65 + c4 + 1] = v[1] * sc; tl[row * 65 + c4 + 2] = v[2] * sc; tl[row * 65 + c4 + 3] = v[3] * sc; } }
    __syncthreads();
    { const int n = tid >> 3, kc = (tid & 7) * 8; float f[8];
#pragma unroll
      for (int i = 0; i < 8; ++i) f[i] = tl[(kc + i) * 65 + n];
      u32x4 w; w.x = cvt_pk_bf16(f[0], f[1]); w.y = cvt_pk_bf16(f[2], f[3]); w.z = cvt_pk_bf16(f[4], f[5]); w.w = cvt_pk_bf16(f[6], f[7]);
      *(u32x4*)(Wt + (size_t)(dn0 + n) * ldt + k0 + kc) = w; }
    __syncthreads();
}

__device__ __forceinline__ void tr_group(float* tl, const float* W, int ldw, bf16_t* Wt, int ldt, int k0, int nbase, int mode, const float* ks0, const float* ks1) {
    int tid = threadIdx.x; asm volatile("" : "+v"(tid));
    { const int r = tid >> 4, c4 = (tid & 15) * 4; f32x4 v[4][2];
#pragma unroll
      for (int j = 0; j < 4; ++j)
#pragma unroll
          for (int p = 0; p < 2; ++p) v[j][p] = __builtin_nontemporal_load((const f32x4*)(W + (size_t)(k0 + p * 32 + r) * ldw + nbase + 64 * j + c4));
#pragma unroll
      for (int p = 0; p < 2; ++p) { const int row = p * 32 + r; float sc = 1.f; if (ks0) { const int k = k0 + row; sc = k < 1024 ? ks0[k] : ks1[k - 1024]; }
#pragma unroll
          for (int j = 0; j < 4; ++j) { float* t = tl + j * 4160 + row * 65 + c4; t[0] = v[j][p][0] * sc; t[1] = v[j][p][1] * sc; t[2] = v[j][p][2] * sc; t[3] = v[j][p][3] * sc; } } }
    __syncthreads();
    { const int n = tid >> 3, kc = (tid & 7) * 8;
#pragma unroll
      for (int j = 0; j < 4; ++j) { float f[8];
#pragma unroll
          for (int i = 0; i < 8; ++i) f[i] = tl[j * 4160 + (kc + i) * 65 + n];
          const int n0 = nbase + 64 * j; int dn0 = n0;
          if (mode == 1) dn0 = n0 < 2816 ? ((n0 >> 7) * 256 + (n0 & 127)) : ((((n0 - 2816) >> 7) * 256) + 128 + ((n0 - 2816) & 127));
          u32x4 w; w.x = cvt_pk_bf16(f[0], f[1]); w.y = cvt_pk_bf16(f[2], f[3]); w.z = cvt_pk_bf16(f[4], f[5]); w.w = cvt_pk_bf16(f[6], f[7]);
          *(u32x4*)(Wt + (size_t)(dn0 + n) * ldt + k0 + kc) = w; } }
    __syncthreads();
}

__device__ void phase0(const Params& P, float* ldsf) {
    char* ws = P.ws; const int G = gridDim.x, bid = blockIdx.x; int tid = threadIdx.x; asm volatile("" : "+v"(tid));
    for (int idx = bid; idx < 16 * 24; idx += G) { const int ng = idx % 24, kt = idx / 24;
        tr_group(ldsf, P.in[I_WADA], 6144, (bf16_t*)(ws + OFF_WT_ADA), 1024, kt * 64, ng * 256, 0, nullptr, nullptr); }
    const size_t gt = (size_t)bid * 512 + tid, gs = (size_t)G * 512;
    { bf16_t* A = (bf16_t*)(ws + OFF_A_ADA);
      for (size_t i = gt; i < (size_t)256 * 1024; i += gs) { const int r = (int)(i >> 10), c = (int)(i & 1023); float v = 0.f;
          if (r == 0) v = P.in[I_CP][c]; else if (r <= 128) v = P.in[I_CS][(size_t)(r - 1) * 1024 + c];
          A[i] = f2bf(v * sigmoid_f(v)); } }
    { float* sp = (float*)(ws + OFF_SP8); for (size_t i = gt; i < 1024; i += gs) sp[i] = 8.0f * log1pf(expf(-P.in[I_LAM][i])); }
    { float* ss = (float*)(ws + OFF_SS); for (size_t i = gt; i < (size_t)4 * MP_; i += gs) ss[i] = 0.f; }
    { float* __restrict__ o = P.out + O_CS; const float* __restrict__ s = P.in[I_SC];
#pragma unroll 4
      for (size_t i = gt; i < (size_t)128 * 2048; i += gs) { const size_t b = i >> 11, r = i & 2047; o[b * 3072 + r] = s[b * 3072 + 1024 + r]; } }
    { float* __restrict__ o = P.out + O_FS; const float* __restrict__ s = P.in[I_SF];
#pragma unroll 8
      for (size_t i = gt; i < (size_t)128 * 5632; i += gs) { const size_t b = i / 5632, r = i % 5632; o[b * 11264 + r] = s[b * 11264 + 5632 + r]; } }
    { unsigned* z = (unsigned*)(ws + OFF_HM0); for (size_t i = gt; i < 1024; i += gs) z[i] = 0u; }
}

__device__ void phase1(const Params& P, LAS unsigned char* lds, float* ldsf) {
    char* ws = P.ws; const int G = gridDim.x, bid = blockIdx.x;
    { Gemm g{(const bf16_t*)(ws + OFF_A_ADA), (const bf16_t*)(ws + OFF_WT_ADA), 1024}; Sched S; S.init(1, 24, G, bid);
      EpiAda E{(float*)(ws + OFF_MOD), P.in[I_BADA]}; gemm_phase<EpiAda, false, false>(lds, g, S, E); }
    __syncthreads();
    int wk, nw; if (G > 48) { if (bid < 24) return; wk = bid - 24; nw = G - 24; } else { wk = bid; nw = G; }
    for (int idx = wk; idx < 944; idx += nw) {
        if (idx < 224) { const int ng = idx % 14, kt = idx / 14; tr_group(ldsf, P.in[I_WIN], 3584, (bf16_t*)(ws + OFF_WT_IN), 1024, kt * 64, ng * 256, 0, nullptr, nullptr); }
        else if (idx < 352) { const int i2 = idx - 224, ng = i2 & 3, kt = i2 >> 2; tr_group(ldsf, P.in[I_WOUT], 1024, (bf16_t*)(ws + OFF_WT_OUT), 2048, kt * 64, ng * 256, 0, P.in[I_GAO], P.in[I_GRO]); }
        else if (idx < 704) { const int i2 = idx - 352, ng = i2 % 22, kt = i2 / 22; tr_group(ldsf, P.in[I_WUP], 5632, (bf16_t*)(ws + OFF_WT_UP), 1024, kt * 64, ng * 256, 1, nullptr, nullptr); }
        else if (idx < 880) { const int i2 = idx - 704, ng = i2 & 3, kt = i2 >> 2; tr_group(ldsf, P.in[I_WDOWN], 1024, (bf16_t*)(ws + OFF_WT_DOWN), 2816, kt * 64, ng * 256, 0, nullptr, nullptr); }
        else { const int i2 = (idx - 880) & 31, blk = i2 >> 2, kt = (i2 >> 1) & 1, ntile = i2 & 1; const bool isA = idx < 912;
            tr_tile(ldsf, P.in[isA ? I_WA : I_WI] + (size_t)blk * 16384, 128, (bf16_t*)(ws + (isA ? OFF_WT_A : OFF_WT_I)) + (size_t)blk * 16384, 128, kt * 64, ntile * 64, ntile * 64, nullptr, nullptr); }
    }
}

constexpr int NBR = 4;
__device__ __forceinline__ const float* xrow(const Params& P, int r) { return r < T_ ? P.in[I_XP] + (size_t)r * 1024 : P.in[I_XS] + (size_t)(r - T_) * 1024; }
constexpr int NB2 = 8;
template <bool PO>
__device__ __forceinline__ void phase2_batch(const Params& P, int r0, int nw, int lane) {
    char* ws = P.ws; const float* MOD = (const float*)(ws + OFF_MOD); bf16_t* H = (bf16_t*)(ws + OFF_HM);
    f32x4 v[NB2][4]; float ss[NB2];
#pragma unroll
    for (int b = 0; b < NB2; ++b) { const int r = r0 + b * nw; ss[b] = 0.f;
        if (PO || r < MR_) { const float* x = xrow(P, r);
#pragma unroll
            for (int i = 0; i < 4; ++i) v[b][i] = __builtin_nontemporal_load((const f32x4*)(x + i * 256 + lane * 4)); }
        else {
#pragma unroll
            for (int i = 0; i < 4; ++i) v[b][i] = (f32x4){0.f, 0.f, 0.f, 0.f}; } }
#pragma unroll
    for (int b = 0; b < NB2; ++b) {
#pragma unroll
        for (int i = 0; i < 4; ++i) ss[b] += (v[b][i][0] * v[b][i][0] + v[b][i][1] * v[b][i][1]) + (v[b][i][2] * v[b][i][2] + v[b][i][3] * v[b][i][3]);
        ss[b] = wave_sum(ss[b]); }
#pragma unroll
    for (int b = 0; b < NB2; ++b) { const int r = r0 + b * nw; if (!PO && r >= MP_) continue;
        if (!PO && r >= MR_) { for (int i = 0; i < 4; ++i) *(u32x2*)(H + (size_t)r * 1024 + i * 256 + lane * 4) = (u32x2){0u, 0u}; continue; }
        const float* md = MOD + (size_t)modrow(r) * 6144; const float rs = rsqrtf(ss[b] * (1.0f / 1024.0f) + EPS_);
#pragma unroll
        for (int i = 0; i < 4; ++i) { const int c = i * 256 + lane * 4; const f32x4 g = *(const f32x4*)(P.in[I_GPM] + c), sh = *(const f32x4*)(md + c), sc = *(const f32x4*)(md + 1024 + c);
            __builtin_nontemporal_store(pk4((v[b][i] * rs * g) * (sc + 1.0f) + sh), (u32x2*)(H + (size_t)r * 1024 + c)); } }
}
__device__ void phase2(const Params& P) {
    int tid = threadIdx.x; asm volatile("" : "+v"(tid));
    const int wid = __builtin_amdgcn_readfirstlane(tid >> 6), lane = tid & 63;
    const int nw = gridDim.x * 8;
    for (int r0 = blockIdx.x * 8 + wid; r0 < MP_; r0 += nw * NB2) {
        if (r0 + (NB2 - 1) * nw < T_) phase2_batch<true>(P, r0, nw, lane); else phase2_batch<false>(P, r0, nw, lane);
    }
}

__device__ __forceinline__ int crow(int r, int hi) { return (r & 3) + 8 * (r >> 2) + 4 * hi; }
__device__ void attn_prompt_item(const Params& P, char* lds, int qb, int kv) {
    char* ws = P.ws; bf16_t* MIX = (bf16_t*)(ws + OFF_MIX); const bf16_t* KB = (const bf16_t*)(ws + OFF_KB); const bf16_t* VT = (const bf16_t*)(ws + OFF_VT); float* SSA = (float*)(ws + OFF_SS);
    bf16_t* Ks = (bf16_t*)lds; bf16_t* Vs = (bf16_t*)(lds + 256 * 136 * 2);
    int tid = threadIdx.x; asm volatile("" : "+v"(tid));
    const int wid = tid >> 6, lane = tid & 63; int r32 = lane & 31, hi = lane >> 5;
    const int tbase = 128 * (qb - 1);
    if (qb > 0) {
        u32x4 kv_[8], vv_[8];
#pragma unroll
        for (int i = 0; i < 8; ++i) { const int id = i * 512 + tid; kv_[i] = *(const u32x4*)(KB + (size_t)(tbase + (id >> 4)) * 256 + kv * 128 + (id & 15) * 8);
            vv_[i] = *(const u32x4*)(VT + (size_t)(kv * 128 + (id >> 5)) * T_ + tbase + (id & 31) * 8); }
#pragma unroll
        for (int i = 0; i < 8; ++i) { const int id = i * 512 + tid; *(u32x4*)(Ks + (id >> 4) * 136 + (id & 15) * 8) = kv_[i];
            u32x2* dst = (u32x2*)(Vs + (id >> 5) * 260 + (id & 31) * 8); dst[0] = (u32x2){vv_[i].x, vv_[i].y}; dst[1] = (u32x2){vv_[i].z, vv_[i].w}; }
    } else {
#pragma unroll
        for (int i = 0; i < 8; ++i) { const int id = i * 512 + tid, row = id >> 4, c = id & 15; const int t = tbase + row;
            u32x4 v = {0u, 0u, 0u, 0u}; if (t >= 0) v = *(const u32x4*)(KB + (size_t)t * 256 + kv * 128 + c * 8);
            *(u32x4*)(Ks + row * 136 + c * 8) = v; }
#pragma unroll
        for (int i = 0; i < 8; ++i) { const int id = i * 512 + tid, d = id >> 5, c = id & 31; const int t = tbase + c * 8;
            u32x4 v = {0u, 0u, 0u, 0u}; if (t >= 0) v = *(const u32x4*)(VT + (size_t)(kv * 128 + d) * T_ + t);
            u32x2* dst = (u32x2*)(Vs + d * 260 + c * 8); dst[0] = (u32x2){v.x, v.y}; dst[1] = (u32x2){v.z, v.w}; }
    }
    __syncthreads();
#pragma unroll 1
    for (int it = 0; it < 2; ++it) {
        asm volatile("" : "+v"(r32), "+v"(hi));
        const int tile = wid + 8 * it, g = tile >> 2, w4 = tile & 3, head = kv * 4 + g;
        const int trow = 128 * qb + 32 * w4 + r32;
        bf16_t* qp = MIX + (size_t)trow * 2048 + head * 128;
        bf16x8 qr[8];
#pragma unroll
        for (int d0 = 0; d0 < 8; ++d0) qr[d0] = *(const bf16x8*)(qp + d0 * 16 + hi * 8);
        f32x16 p[5];
#pragma unroll
        for (int kt = 0; kt < 5; ++kt) {
            f32x16 a = {};
            const bf16_t* kp = Ks + (32 * (w4 + kt) + r32) * 136 + hi * 8;
#pragma unroll
            for (int d0 = 0; d0 < 8; ++d0) { const bf16x8 kf = *(const bf16x8*)(kp + d0 * 16); a = __builtin_amdgcn_mfma_f32_32x32x16_bf16(kf, qr[d0], a, 0, 0, 0); }
            p[kt] = a;
            EPI_FENCE();
        }
        const float slope2 = __builtin_amdgcn_exp2f(-(float)(head + 1)) * LOG2E_, sink2 = P.in[I_SINK][head] * LOG2E_;
        float mx = sink2;
#pragma unroll
        for (int kt = 0; kt < 5; ++kt)
#pragma unroll
            for (int r = 0; r < 16; ++r) { const int c = crow(r, hi); const int dist = 128 + r32 - 32 * kt - c; const int jb = 32 * (w4 + kt) + c;
                const bool valid = ((unsigned)dist < 128u) && (qb > 0 || jb >= 128);
                const float s = valid ? p[kt][r] - slope2 * (float)dist : -__builtin_inff(); p[kt][r] = s; mx = fmaxf(mx, s); }
        mx = fmaxf(mx, __shfl_xor(mx, 32));
        float l = 0.f;
        u32x4 pb[5][2];
#pragma unroll
        for (int kt = 0; kt < 5; ++kt) {
            float e[16];
#pragma unroll
            for (int r = 0; r < 16; ++r) { e[r] = __builtin_amdgcn_exp2f(p[kt][r] - mx); l += e[r]; }
#pragma unroll
            for (int s2 = 0; s2 < 2; ++s2) { pb[kt][s2].x = cvt_pk_bf16(e[8 * s2 + 0], e[8 * s2 + 1]); pb[kt][s2].y = cvt_pk_bf16(e[8 * s2 + 2], e[8 * s2 + 3]);
                pb[kt][s2].z = cvt_pk_bf16(e[8 * s2 + 4], e[8 * s2 + 5]); pb[kt][s2].w = cvt_pk_bf16(e[8 * s2 + 6], e[8 * s2 + 7]); }
        }
        l += __shfl_xor(l, 32); l += __builtin_amdgcn_exp2f(sink2 - mx);
        EPI_FENCE();
        f32x16 o[4] = {};
#pragma unroll
        for (int kt = 0; kt < 5; ++kt)
#pragma unroll
            for (int s2 = 0; s2 < 2; ++s2) {
                const bf16x8 pf = *reinterpret_cast<const bf16x8*>(&pb[kt][s2]);
#pragma unroll
                for (int db = 0; db < 4; ++db) { const bf16_t* vp = Vs + (32 * db + r32) * 260 + 32 * (w4 + kt) + 16 * s2 + 4 * hi;
                    const u32x2 lo = *(const u32x2*)vp, hh = *(const u32x2*)(vp + 8); u32x4 vw = {lo.x, lo.y, hh.x, hh.y};
                    o[db] = __builtin_amdgcn_mfma_f32_32x32x16_bf16(*reinterpret_cast<const bf16x8*>(&vw), pf, o[db], 0, 0, 0); }
                EPI_FENCE();
            }
        const float inv = 1.0f / l; float ss = 0.f;
#pragma unroll
        for (int db = 0; db < 4; ++db)
#pragma unroll
            for (int r4 = 0; r4 < 4; ++r4) { const float a = o[db][4 * r4] * inv, b = o[db][4 * r4 + 1] * inv, c = o[db][4 * r4 + 2] * inv, d = o[db][4 * r4 + 3] * inv;
                ss += (a * a + b * b) + (c * c + d * d); u32x2 w; w.x = cvt_pk_bf16(a, b); w.y = cvt_pk_bf16(c, d);
                *(u32x2*)(qp + 32 * db + 8 * r4 + 4 * hi) = w; }
        ss += __shfl_xor(ss, 32);
        if (hi == 0) atomicAdd(SSA + trow, ss);
    }
    __syncthreads();
}

__device__ void attn_sample_item(const Params& P, char* lds, int b, int kv) {
    char* ws = P.ws; bf16_t* MIX = (bf16_t*)(ws + OFF_MIX); const bf16_t* KB = (const bf16_t*)(ws + OFF_KB); const bf16_t* VSB = (const bf16_t*)(ws + OFF_VSB); float* SSA = (float*)(ws + OFF_SS);
    float* Kf = (float*)lds; float* Vf = Kf + 128 * 129; float* qs = Vf + 128 * 129; float* ps = qs + 512; float* red = ps + 512;
    int tid = threadIdx.x; asm volatile("" : "+v"(tid));
    const int g = tid >> 7, jd = tid & 127, head = kv * 4 + g;
    bf16_t* qp = MIX + (size_t)(T_ + b) * 2048 + head * 128;
    qs[tid] = bf2f(qp[jd]);
    { f32x4 kk[8], vv[8];
#pragma unroll
      for (int i = 0; i < 8; ++i) { const int id = i * 512 + tid, j = id >> 5, c4 = (id & 31) * 4;
          if (j < 127) { const size_t src = ((size_t)(b * 128 + j + 1) * 2 + kv) * 128 + c4; kk[i] = __builtin_nontemporal_load((const f32x4*)(P.in[I_CK] + src)); vv[i] = __builtin_nontemporal_load((const f32x4*)(P.in[I_CV] + src)); }
          else { const u32x2 kw = *(const u32x2*)(KB + (size_t)(T_ + b) * 256 + kv * 128 + c4), vw = *(const u32x2*)(VSB + (size_t)b * 256 + kv * 128 + c4);
              kk[i] = (f32x4){bflo(kw.x), bfhi(kw.x), bflo(kw.y), bfhi(kw.y)}; vv[i] = (f32x4){bflo(vw.x), bfhi(vw.x), bflo(vw.y), bfhi(vw.y)}; } }
#pragma unroll
      for (int i = 0; i < 8; ++i) { const int id = i * 512 + tid, j = id >> 5, c4 = (id & 31) * 4;
          const size_t dst = ((size_t)(b * 128 + j) * 2 + kv) * 128 + c4; __builtin_nontemporal_store(kk[i], (f32x4*)(P.out + O_KS + dst)); __builtin_nontemporal_store(vv[i], (f32x4*)(P.out + O_VS + dst));
#pragma unroll
          for (int e = 0; e < 4; ++e) { Kf[j * 129 + c4 + e] = kk[i][e]; Vf[j * 129 + c4 + e] = vv[i][e]; } } }
    __syncthreads();
    const float slope2 = __builtin_amdgcn_exp2f(-(float)(head + 1)) * LOG2E_, sink2 = P.in[I_SINK][head] * LOG2E_;
    float s = 0.f;
    for (int d = 0; d < 128; ++d) s += qs[g * 128 + d] * Kf[jd * 129 + d];
    s -= slope2 * (float)(127 - jd);
    ps[tid] = s;
    __syncthreads();
    float mx = sink2; for (int j = 0; j < 128; ++j) mx = fmaxf(mx, ps[g * 128 + j]);
    const float e = __builtin_amdgcn_exp2f(s - mx);
    __syncthreads();
    ps[tid] = e;
    __syncthreads();
    float l = __builtin_amdgcn_exp2f(sink2 - mx); for (int j = 0; j < 128; ++j) l += ps[g * 128 + j];
    float o = 0.f;
    for (int j = 0; j < 128; ++j) o += ps[g * 128 + j] * Vf[j * 129 + jd];
    o /= l;
    qp[jd] = f2bf(o);
    const float ss = wave_sum(o * o);
    if ((tid & 63) == 0) atomicAdd(SSA + T_ + b, ss);
    (void)red;
    __syncthreads();
}

template <bool SAMPLE>
__device__ void rnn1_item(const Params& P, char* lds, int tile, int nb, int rg) {
    char* ws = P.ws; constexpr bool sample = SAMPLE;
    const bf16_t* XR = (const bf16_t*)(ws + OFF_XR); bf16_t* MIX = (bf16_t*)(ws + OFF_MIX); bf16_t* LAT = (bf16_t*)(ws + OFF_HM); bf16_t* UT = (bf16_t*)(ws + OFF_U);
    const float* SP8 = (const float*)(ws + OFF_SP8); float* SSR = (float*)(ws + OFF_SS) + MP_;
    bf16_t* XC = (bf16_t*)lds; bf16_t* WA = XC + 128 * 136; bf16_t* WI = WA + 128 * 136;
    float* As = (float*)lds; float* Us = As + 128 * 129; float* sgA = Us + 128 * 129; float* sgE = sgA + 512; float* bl = sgE + 512;
    int tid = threadIdx.x; asm volatile("" : "+v"(tid));
    const int wid = tid >> 6, lane = tid & 63, fr = lane & 15, fq = lane >> 4;
    const int t0 = tile * 128, ch0 = nb * 128;
    float blv = 0.f; if (tid < 384) blv = tid < 128 ? P.in[I_BA][ch0 + tid] : (tid < 256 ? P.in[I_BI][ch0 + tid - 128] : SP8[ch0 + tid - 256]);
    if (!sample) {
        const int c8 = (tid & 15) * 8, ch = ch0 + c8;
        u32x4 xv[4][4];
        if (tile > 0) {
#pragma unroll
            for (int i = 0; i < 4; ++i)
#pragma unroll
                for (int k = 0; k < 4; ++k) xv[i][k] = *(const u32x4*)(XR + (size_t)(t0 + i * 32 + (tid >> 4) - 3 + k) * 1024 + ch);
        } else {
#pragma unroll
            for (int i = 0; i < 4; ++i)
#pragma unroll
                for (int k = 0; k < 4; ++k) { const int tt = i * 32 + (tid >> 4) - 3 + k; xv[i][k] = (u32x4){0u, 0u, 0u, 0u}; if (tt >= 0) xv[i][k] = *(const u32x4*)(XR + (size_t)tt * 1024 + ch); }
        }
        f32x4 cw[4][2], cb[2];
#pragma unroll
        for (int k = 0; k < 4; ++k) { cw[k][0] = *(const f32x4*)(P.in[I_CW] + k * 1024 + ch); cw[k][1] = *(const f32x4*)(P.in[I_CW] + k * 1024 + ch + 4); }
        cb[0] = *(const f32x4*)(P.in[I_CB] + ch); cb[1] = *(const f32x4*)(P.in[I_CB] + ch + 4);
#pragma unroll
        for (int i = 0; i < 4; ++i) { const int row = i * 32 + (tid >> 4);
            f32x4 x0 = cb[0], x1 = cb[1];
#pragma unroll
            for (int k = 0; k < 4; ++k) { const u32x4 v = xv[i][k];
                x0 += cw[k][0] * (f32x4){bflo(v.x), bfhi(v.x), bflo(v.y), bfhi(v.y)}; x1 += cw[k][1] * (f32x4){bflo(v.z), bfhi(v.z), bflo(v.w), bfhi(v.w)}; }
            u32x4 w; w.x = cvt_pk_bf16(x0[0], x0[1]); w.y = cvt_pk_bf16(x0[2], x0[3]); w.z = cvt_pk_bf16(x1[0], x1[1]); w.w = cvt_pk_bf16(x1[2], x1[3]);
            *(u32x4*)(XC + row * 136 + c8) = w; }
    } else if (tid < 256) {
        const int row = tid >> 4, c8 = (tid & 15) * 8, ch = ch0 + c8, b = 16 * rg + row;
        float xc[8];
        { const f32x4 b0 = *(const f32x4*)(P.in[I_CB] + ch), b1 = *(const f32x4*)(P.in[I_CB] + ch + 4);
          xc[0] = b0[0]; xc[1] = b0[1]; xc[2] = b0[2]; xc[3] = b0[3]; xc[4] = b1[0]; xc[5] = b1[1]; xc[6] = b1[2]; xc[7] = b1[3]; }
#pragma unroll
        for (int k = 0; k < 3; ++k) { const float* sp = P.in[I_SC] + (size_t)b * 3072 + k * 1024 + ch; const f32x4 x0 = *(const f32x4*)sp, x1 = *(const f32x4*)(sp + 4);
            const f32x4 w0 = *(const f32x4*)(P.in[I_CW] + k * 1024 + ch), w1 = *(const f32x4*)(P.in[I_CW] + k * 1024 + ch + 4);
#pragma unroll
            for (int e = 0; e < 4; ++e) { xc[e] += w0[e] * x0[e]; xc[4 + e] += w1[e] * x1[e]; } }
        { const u32x4 v = *(const u32x4*)(XR + (size_t)(T_ + b) * 1024 + ch);
          const f32x4 x0 = {bflo(v.x), bfhi(v.x), bflo(v.y), bfhi(v.y)}, x1 = {bflo(v.z), bfhi(v.z), bflo(v.w), bfhi(v.w)};
          float* oc = P.out + O_CS + (size_t)b * 3072 + 2048 + ch; *(f32x4*)oc = x0; *(f32x4*)(oc + 4) = x1;
          const f32x4 w0 = *(const f32x4*)(P.in[I_CW] + 3 * 1024 + ch), w1 = *(const f32x4*)(P.in[I_CW] + 3 * 1024 + ch + 4);
#pragma unroll
          for (int e = 0; e < 4; ++e) { xc[e] += w0[e] * x0[e]; xc[4 + e] += w1[e] * x1[e]; } }
        u32x4 w; w.x = cvt_pk_bf16(xc[0], xc[1]); w.y = cvt_pk_bf16(xc[2], xc[3]); w.z = cvt_pk_bf16(xc[4], xc[5]); w.w = cvt_pk_bf16(xc[6], xc[7]);
        *(u32x4*)(XC + row * 136 + c8) = w;
    }
    if (tid < 384) bl[tid] = blv;
    { u32x4 wa_[4], wi_[4];
#pragma unroll
      for (int i = 0; i < 4; ++i) { const int id = i * 512 + tid; wa_[i] = *(const u32x4*)((const bf16_t*)(ws + OFF_WT_A) + (size_t)nb * 16384 + id * 8); wi_[i] = *(const u32x4*)((const bf16_t*)(ws + OFF_WT_I) + (size_t)nb * 16384 + id * 8); }
#pragma unroll
      for (int i = 0; i < 4; ++i) { const int id = i * 512 + tid, d = id >> 4, c8 = (id & 15) * 8; *(u32x4*)(WA + d * 136 + c8) = wa_[i]; *(u32x4*)(WI + d * 136 + c8) = wi_[i]; } }
    __syncthreads();
    constexpr bool active = true;
    constexpr int NT = SAMPLE ? 1 : 8;
    const int dofs = SAMPLE ? 16 * wid : 0;
    const int row = SAMPLE ? fr : 16 * wid + fr;
    f32x4 aa[NT], ai[NT]; u32x2 xcw[NT];
    if (active) {
        bf16x8 xf[4];
#pragma unroll
        for (int ks = 0; ks < 4; ++ks) xf[ks] = *(const bf16x8*)(XC + row * 136 + 32 * ks + 8 * fq);
#pragma unroll
        for (int nt = 0; nt < NT; ++nt) { f32x4 a = {0.f, 0.f, 0.f, 0.f}, b = {0.f, 0.f, 0.f, 0.f};
#pragma unroll
            for (int ks = 0; ks < 4; ++ks) { const bf16x8 wa = *(const bf16x8*)(WA + (dofs + 16 * nt + fr) * 136 + 32 * ks + 8 * fq), wi = *(const bf16x8*)(WI + (dofs + 16 * nt + fr) * 136 + 32 * ks + 8 * fq);
                a = __builtin_amdgcn_mfma_f32_16x16x32_bf16(wa, xf[ks], a, 0, 0, 0); b = __builtin_amdgcn_mfma_f32_16x16x32_bf16(wi, xf[ks], b, 0, 0, 0); }
            aa[nt] = a; ai[nt] = b; xcw[nt] = *(const u32x2*)(XC + row * 136 + dofs + 16 * nt + 4 * fq); }
    }
    __syncthreads();
    if (active) {
        float ssr = 0.f; const int brow = 16 * rg + fr;
#pragma unroll
        for (int nt = 0; nt < NT; ++nt) { const int d = dofs + 16 * nt + 4 * fq, ch = ch0 + d;
            const f32x4 ba = *(const f32x4*)(bl + d), bi = *(const f32x4*)(bl + 128 + d), sp = *(const f32x4*)(bl + 256 + d);
            const float xv[4] = {bflo(xcw[nt].x), bfhi(xcw[nt].x), bflo(xcw[nt].y), bfhi(xcw[nt].y)};
            float la[4], uu[4], av[4];
#pragma unroll
            for (int e = 0; e < 4; ++e) { const float r = sigmoid_f(aa[nt][e] + ba[e]), ig = sigmoid_f(ai[nt][e] + bi[e]);
                la[e] = -r * sp[e]; av[e] = __builtin_amdgcn_exp2f(LOG2E_ * la[e]);
                const float x2 = 2.0f * la[e];
                const float pol = -x2 * (1.0f + x2 * 0.5f * (1.0f + x2 * (1.0f / 3.0f) * (1.0f + x2 * 0.25f * (1.0f + x2 * 0.2f))));
                const float em = x2 > -0.25f ? pol : 1.0f - av[e] * av[e];
                uu[e] = __builtin_amdgcn_sqrtf(fmaxf(em, 0.f)) * (ig * xv[e]); }
            if (!sample) {
#pragma unroll
                for (int e = 0; e < 4; ++e) { As[row * 129 + d + e] = la[e]; Us[row * 129 + d + e] = uu[e]; }
            } else {
                const f32x4 h0 = *(const f32x4*)(P.in[I_SH] + (size_t)brow * 1024 + ch);
                bf16_t* gp = MIX + (size_t)(T_ + brow) * 2048 + 1024 + ch; const u32x2 gw = *(const u32x2*)gp; const float gy[4] = {bflo(gw.x), bfhi(gw.x), bflo(gw.y), bfhi(gw.y)};
                f32x4 h; float rn[4];
#pragma unroll
                for (int e = 0; e < 4; ++e) { h[e] = av[e] * h0[e] + uu[e]; rn[e] = h[e] * gy[e]; ssr += rn[e] * rn[e]; }
                *(f32x4*)(P.out + O_HS + (size_t)brow * 1024 + ch) = h;
                u32x2 w; w.x = cvt_pk_bf16(rn[0], rn[1]); w.y = cvt_pk_bf16(rn[2], rn[3]); *(u32x2*)gp = w;
            } }
        if (sample) { ssr += __shfl_xor(ssr, 16); ssr += __shfl_xor(ssr, 32); if (fq == 0) atomicAdd(SSR + T_ + brow, ssr); }
    }
    __syncthreads();
    if (sample) return;
    { const int s = tid >> 7, c = tid & 127; float A = 1.f, E = 0.f; unsigned lw[16], uw[16];
#pragma unroll
      for (int j = 0; j < 32; j += 2) { const float l0 = As[(32 * s + j) * 129 + c], u0 = Us[(32 * s + j) * 129 + c], l1 = As[(32 * s + j + 1) * 129 + c], u1 = Us[(32 * s + j + 1) * 129 + c];
          const float a0 = __builtin_amdgcn_exp2f(LOG2E_ * l0), a1 = __builtin_amdgcn_exp2f(LOG2E_ * l1);
          E = a0 * E + u0; A *= a0; E = a1 * E + u1; A *= a1; lw[j >> 1] = cvt_pk_bf16(l0, l1); uw[j >> 1] = cvt_pk_bf16(u0, u1); }
      ((float*)(ws + OFF_SEGA))[(size_t)(tile * 4 + s) * 1024 + ch0 + c] = A; ((float*)(ws + OFF_SEGE))[(size_t)(tile * 4 + s) * 1024 + ch0 + c] = E;
      sgA[tid] = A; sgE[tid] = E;
      u32x4* lp = (u32x4*)(LAT + (size_t)(ch0 + c) * T_ + t0 + 32 * s); u32x4* up = (u32x4*)(UT + (size_t)(ch0 + c) * T_ + t0 + 32 * s);
#pragma unroll
      for (int q = 0; q < 4; ++q) { lp[q] = (u32x4){lw[4 * q], lw[4 * q + 1], lw[4 * q + 2], lw[4 * q + 3]}; up[q] = (u32x4){uw[4 * q], uw[4 * q + 1], uw[4 * q + 2], uw[4 * q + 3]}; } }
    __syncthreads();
    if (tid < 128) { float A = 1.f, E = 0.f;
#pragma unroll
        for (int s = 0; s < 4; ++s) { const float a = sgA[s * 128 + tid], e = sgE[s * 128 + tid]; E = a * E + e; A *= a; }
        ((float*)(ws + OFF_TILEA))[(size_t)tile * 1024 + ch0 + tid] = A; ((float*)(ws + OFF_TILEE))[(size_t)tile * 1024 + ch0 + tid] = E; }
    __syncthreads();
}

__device__ void rnn2_item(const Params& P, char* lds, int tile, int nb) {
    char* ws = P.ws; bf16_t* MIX = (bf16_t*)(ws + OFF_MIX); const bf16_t* LAT = (const bf16_t*)(ws + OFF_HM); const bf16_t* UT = (const bf16_t*)(ws + OFF_U);
    const float* SEGA = (const float*)(ws + OFF_SEGA); const float* SEGE = (const float*)(ws + OFF_SEGE); const float* TA = (const float*)(ws + OFF_TILEA); const float* TE = (const float*)(ws + OFF_TILEE);
    float* SSR = (float*)(ws + OFF_SS) + MP_;
    float* pa = (float*)lds; float* pe = pa + 512; float* sq = pe + 512; bf16_t* GY = (bf16_t*)(sq + 128 * 129);
    int tid = threadIdx.x; asm volatile("" : "+v"(tid));
    const int s = tid >> 7, c = tid & 127, ch = nb * 128 + c;
    const int t0 = tile * 128, tb = t0 + 32 * s;
    u32x4 gyv[4];
#pragma unroll
    for (int i = 0; i < 4; ++i) { const int id = i * 512 + tid, row = id >> 4, c8 = (id & 15) * 8; gyv[i] = *(const u32x4*)(MIX + (size_t)(t0 + row) * 2048 + 1024 + nb * 128 + c8); }
    u32x4 lav[4], uv[4];
    { const u32x4* lp = (const u32x4*)(LAT + (size_t)ch * T_ + tb); const u32x4* up = (const u32x4*)(UT + (size_t)ch * T_ + tb);
#pragma unroll
      for (int q = 0; q < 4; ++q) { lav[q] = lp[q]; uv[q] = up[q]; } }
    { float A = 1.f, E = 0.f; const int lo = s * 32, hi = min(lo + 32, tile);
      for (int k0 = lo; k0 < hi; k0 += 16) { float av[16], ev[16];
#pragma unroll
          for (int i = 0; i < 16; ++i) { const int k = min(k0 + i, hi - 1); av[i] = TA[(size_t)k * 1024 + ch]; ev[i] = TE[(size_t)k * 1024 + ch]; }
#pragma unroll
          for (int i = 0; i < 16; ++i) { const bool on = k0 + i < hi; const float a = on ? av[i] : 1.f, e = on ? ev[i] : 0.f; E = a * E + e; A *= a; } }
      pa[tid] = A; pe[tid] = E; }
#pragma unroll
    for (int i = 0; i < 4; ++i) { const int id = i * 512 + tid, row = id >> 4, c8 = (id & 15) * 8; *(u32x4*)(GY + row * 136 + c8) = gyv[i]; }
    __syncthreads();
    float h = 0.f;
#pragma unroll
    for (int q = 0; q < 4; ++q) h = pa[q * 128 + c] * h + pe[q * 128 + c];
    { float sa[3], se[3];
#pragma unroll
      for (int s2 = 0; s2 < 3; ++s2) { const int sx = min(s2, max(s - 1, 0)); sa[s2] = SEGA[(size_t)(tile * 4 + sx) * 1024 + ch]; se[s2] = SEGE[(size_t)(tile * 4 + sx) * 1024 + ch]; }
#pragma unroll
      for (int s2 = 0; s2 < 3; ++s2) if (s2 < s) h = sa[s2] * h + se[s2]; }
#pragma unroll
    for (int q = 0; q < 4; ++q) {
        const unsigned lw[4] = {lav[q].x, lav[q].y, lav[q].z, lav[q].w}, uw[4] = {uv[q].x, uv[q].y, uv[q].z, uv[q].w};
#pragma unroll
        for (int p = 0; p < 4; ++p)
#pragma unroll
            for (int hh = 0; hh < 2; ++hh) { const int j = 8 * q + 2 * p + hh; const float la = hh ? bfhi(lw[p]) : bflo(lw[p]), u = hh ? bfhi(uw[p]) : bflo(uw[p]);
                bf16_t* g = GY + (32 * s + j) * 136 + c;
                h = __builtin_amdgcn_exp2f(LOG2E_ * la) * h + u; const float rn = h * bf2f(*g); *g = f2bf(rn); sq[(32 * s + j) * 129 + c] = rn * rn; }
    }
    if (tile == 127 && s == 3) P.out[O_HP + ch] = h;
    __syncthreads();
#pragma unroll
    for (int i = 0; i < 4; ++i) { const int id = i * 512 + tid, row = id >> 4, c8 = (id & 15) * 8; *(u32x4*)(MIX + (size_t)(t0 + row) * 2048 + 1024 + nb * 128 + c8) = *(const u32x4*)(GY + row * 136 + c8); }
    { const int row = tid >> 2, q = tid & 3; float a = 0.f;
#pragma unroll 8
      for (int j = 0; j < 32; ++j) a += sq[row * 129 + q * 32 + ((j + 8 * q) & 31)];
      a += __shfl_xor(a, 1); a += __shfl_xor(a, 2);
      if (q == 0) atomicAdd(SSR + tile * 128 + row, a); }
    __syncthreads();
}

__device__ void state_out_prompt(const Params& P) {
    char* ws = P.ws; const bf16_t* KB = (const bf16_t*)(ws + OFF_KB); const bf16_t* VT = (const bf16_t*)(ws + OFF_VT); const bf16_t* XR = (const bf16_t*)(ws + OFF_XR);
    int tid = threadIdx.x; asm volatile("" : "+v"(tid));
    const size_t gt = (size_t)blockIdx.x * 512 + tid, gs = (size_t)gridDim.x * 512;
    for (size_t i = gt; i < 32768; i += gs) { const int j = (int)(i >> 8), c = (int)(i & 255);
        P.out[O_KP + i] = bf2f(KB[(size_t)(T_ - 128 + j) * 256 + c]); P.out[O_VP + i] = bf2f(VT[(size_t)c * T_ + (T_ - 128 + j)]); }
    for (size_t i = gt; i < 3072; i += gs) P.out[O_CP + i] = bf2f(XR[(size_t)(T_ - 3) * 1024 + i]);
}

template <bool PO>
__device__ __forceinline__ void ld_row16(const bf16_t* B, const float* S, int r, int lane, f32x4 (&o)[4]) {
    if (PO || r < T_) {
        u32x2 w[4];
#pragma unroll
        for (int i = 0; i < 4; ++i) w[i] = *(const u32x2*)(B + (size_t)r * 1024 + i * 256 + lane * 4);
#pragma unroll
        for (int i = 0; i < 4; ++i) o[i] = (f32x4){bflo(w[i].x), bfhi(w[i].x), bflo(w[i].y), bfhi(w[i].y)};
    } else {
        const float* p = S + (size_t)(r - T_) * 1024 + lane * 4;
#pragma unroll
        for (int i = 0; i < 4; ++i) o[i] = (f32x4){0.f, 0.f, 0.f, 0.f};
#pragma unroll
        for (int k0 = 0; k0 < 8; k0 += 2) { f32x4 t[2][4];
#pragma unroll
            for (int k = 0; k < 2; ++k)
#pragma unroll
                for (int i = 0; i < 4; ++i) t[k][i] = *(const f32x4*)(p + (size_t)(k0 + k) * 131072 + i * 256);
#pragma unroll
            for (int i = 0; i < 4; ++i) o[i] += t[0][i] + t[1][i]; }
    }
}
template <bool PO>
__device__ __forceinline__ void phase7_batch(const Params& P, int r0, int nw, int lane) {
    char* ws = P.ws; const float* MOD = (const float*)(ws + OFF_MOD);
    const bf16_t* O = (const bf16_t*)(ws + OFF_XR); bf16_t* H = (bf16_t*)(ws + OFF_HM); const float* OS2 = (const float*)(ws + OFF_OS2);
    f32x4 v[NBR][4], ov[NBR][4]; float sso[NBR], ss[NBR];
#pragma unroll
    for (int b = 0; b < NBR; ++b) { const int r = r0 + b * nw;
        if (PO || r < MR_) { const float* x = xrow(P, r);
#pragma unroll
            for (int i = 0; i < 4; ++i) v[b][i] = __builtin_nontemporal_load((const f32x4*)(x + i * 256 + lane * 4));
            ld_row16<PO>(O, OS2, r, lane, ov[b]); }
        else {
#pragma unroll
            for (int i = 0; i < 4; ++i) { v[b][i] = (f32x4){0.f, 0.f, 0.f, 0.f}; ov[b][i] = (f32x4){0.f, 0.f, 0.f, 0.f}; } } }
#pragma unroll
    for (int b = 0; b < NBR; ++b) { sso[b] = 0.f;
#pragma unroll
        for (int i = 0; i < 4; ++i) sso[b] += (ov[b][i][0] * ov[b][i][0] + ov[b][i][1] * ov[b][i][1]) + (ov[b][i][2] * ov[b][i][2] + ov[b][i][3] * ov[b][i][3]);
        sso[b] = wave_sum(sso[b]); }
#pragma unroll
    for (int b = 0; b < NBR; ++b) { const int r = r0 + b * nw; ss[b] = 0.f; if (!PO && r >= MR_) continue;
        const float* md = MOD + (size_t)modrow(r) * 6144; const float rso = rsqrtf(sso[b] * (1.0f / 1024.0f) + EPS_);
#pragma unroll
        for (int i = 0; i < 4; ++i) { const int c = i * 256 + lane * 4; const f32x4 g1 = *(const f32x4*)(md + 2048 + c), gp = *(const f32x4*)(P.in[I_GPOM] + c);
            v[b][i] = v[b][i] + g1 * ((ov[b][i] * rso) * gp); ss[b] += (v[b][i][0] * v[b][i][0] + v[b][i][1] * v[b][i][1]) + (v[b][i][2] * v[b][i][2] + v[b][i][3] * v[b][i][3]); }
        ss[b] = wave_sum(ss[b]); }
#pragma unroll
    for (int b = 0; b < NBR; ++b) { const int r = r0 + b * nw; if (!PO && r >= MP_) continue;
        if (!PO && r >= MR_) { for (int i = 0; i < 4; ++i) *(u32x2*)(H + (size_t)r * 1024 + i * 256 + lane * 4) = (u32x2){0u, 0u}; continue; }
        const float* md = MOD + (size_t)modrow(r) * 6144; const float rs = rsqrtf(ss[b] * (1.0f / 1024.0f) + EPS_);
#pragma unroll
        for (int i = 0; i < 4; ++i) { const int c = i * 256 + lane * 4; const f32x4 g = *(const f32x4*)(P.in[I_GPF] + c), sh = *(const f32x4*)(md + 3072 + c), sc = *(const f32x4*)(md + 4096 + c);
            __builtin_nontemporal_store(pk4((v[b][i] * rs * g) * (sc + 1.0f) + sh), (u32x2*)(H + (size_t)r * 1024 + c)); } }
}
__device__ void phase7(const Params& P) {
    int tid = threadIdx.x; asm volatile("" : "+v"(tid));
    const int wid = __builtin_amdgcn_readfirstlane(tid >> 6), lane = tid & 63;
    const int nw = gridDim.x * 8;
    for (int r0 = blockIdx.x * 8 + wid; r0 < MP_; r0 += nw * NBR) {
        if (r0 + (NBR - 1) * nw < T_) phase7_batch<true>(P, r0, nw, lane); else phase7_batch<false>(P, r0, nw, lane);
    }
}

constexpr int NB10 = 2;
template <bool PO>
__device__ __forceinline__ void phase10_batch(const Params& P, int r0, int nw, int lane) {
    char* ws = P.ws; const float* MOD = (const float*)(ws + OFF_MOD);
    const bf16_t* O = (const bf16_t*)(ws + OFF_XR); const bf16_t* F = (const bf16_t*)(ws + OFF_HM); const float* OS2 = (const float*)(ws + OFF_OS2); const float* OS4 = (const float*)(ws + OFF_OS4);
    f32x4 xv[NB10][4], ov[NB10][4], fv[NB10][4]; float sso[NB10], ssf[NB10];
#pragma unroll
    for (int b = 0; b < NB10; ++b) { const int r = r0 + b * nw;
        if (PO || r < MR_) { const float* x = xrow(P, r);
#pragma unroll
            for (int i = 0; i < 4; ++i) xv[b][i] = __builtin_nontemporal_load((const f32x4*)(x + i * 256 + lane * 4));
            ld_row16<PO>(O, OS2, r, lane, ov[b]); ld_row16<PO>(F, OS4, r, lane, fv[b]); }
        else {
#pragma unroll
            for (int i = 0; i < 4; ++i) { xv[b][i] = (f32x4){0.f, 0.f, 0.f, 0.f}; ov[b][i] = (f32x4){0.f, 0.f, 0.f, 0.f}; fv[b][i] = (f32x4){0.f, 0.f, 0.f, 0.f}; } } }
#pragma unroll
    for (int b = 0; b < NB10; ++b) { sso[b] = 0.f; ssf[b] = 0.f;
#pragma unroll
        for (int i = 0; i < 4; ++i) { sso[b] += (ov[b][i][0] * ov[b][i][0] + ov[b][i][1] * ov[b][i][1]) + (ov[b][i][2] * ov[b][i][2] + ov[b][i][3] * ov[b][i][3]);
            ssf[b] += (fv[b][i][0] * fv[b][i][0] + fv[b][i][1] * fv[b][i][1]) + (fv[b][i][2] * fv[b][i][2] + fv[b][i][3] * fv[b][i][3]); }
        sso[b] = wave_sum(sso[b]); ssf[b] = wave_sum(ssf[b]); }
#pragma unroll
    for (int b = 0; b < NB10; ++b) { const int r = r0 + b * nw; if (!PO && r >= MR_) continue;
        const float* md = MOD + (size_t)modrow(r) * 6144; float* y = r < T_ ? P.out + O_YP + (size_t)r * 1024 : P.out + O_YS + (size_t)(r - T_) * 1024;
        const float rso = rsqrtf(sso[b] * (1.0f / 1024.0f) + EPS_), rsf = rsqrtf(ssf[b] * (1.0f / 1024.0f) + EPS_);
#pragma unroll
        for (int i = 0; i < 4; ++i) { const int c = i * 256 + lane * 4;
            const f32x4 g1 = *(const f32x4*)(md + 2048 + c), gp = *(const f32x4*)(P.in[I_GPOM] + c), g2 = *(const f32x4*)(md + 5120 + c), gf = *(const f32x4*)(P.in[I_GPOF] + c);
            const f32x4 x1 = xv[b][i] + g1 * ((ov[b][i] * rso) * gp);
            __builtin_nontemporal_store(x1 + g2 * ((fv[b][i] * rsf) * gf), (f32x4*)(y + c)); } }
}
constexpr int NBF = 3;
__device__ __forceinline__ f32x4 up4(const u32x2 w) { return (f32x4){bflo(w.x), bfhi(w.x), bflo(w.y), bfhi(w.y)}; }
__device__ __forceinline__ void phase10_fast(const Params& P, int r0, int nw, int lane) {
    char* ws = P.ws; const float* md = (const float*)(ws + OFF_MOD);
    const bf16_t* O = (const bf16_t*)(ws + OFF_XR); const bf16_t* F = (const bf16_t*)(ws + OFF_HM);
    f32x4 xv[NBF][4]; u32x2 ow[NBF][4], fw[NBF][4]; float sso[NBF], ssf[NBF];
#pragma unroll
    for (int b = 0; b < NBF; ++b) { const int r = r0 + b * nw; const float* x = P.in[I_XP] + (size_t)r * 1024;
#pragma unroll
        for (int i = 0; i < 4; ++i) { const int c = i * 256 + lane * 4; xv[b][i] = __builtin_nontemporal_load((const f32x4*)(x + c));
            ow[b][i] = *(const u32x2*)(O + (size_t)r * 1024 + c); fw[b][i] = *(const u32x2*)(F + (size_t)r * 1024 + c); } }
#pragma unroll
    for (int b = 0; b < NBF; ++b) { sso[b] = 0.f; ssf[b] = 0.f;
#pragma unroll
        for (int i = 0; i < 4; ++i) { const f32x4 o = up4(ow[b][i]), f = up4(fw[b][i]);
            sso[b] += (o[0] * o[0] + o[1] * o[1]) + (o[2] * o[2] + o[3] * o[3]); ssf[b] += (f[0] * f[0] + f[1] * f[1]) + (f[2] * f[2] + f[3] * f[3]); }
        sso[b] = wave_sum(sso[b]); ssf[b] = wave_sum(ssf[b]); }
#pragma unroll
    for (int i = 0; i < 4; ++i) { const int c = i * 256 + lane * 4;
        const f32x4 g1 = *(const f32x4*)(md + 2048 + c), gp = *(const f32x4*)(P.in[I_GPOM] + c), g2 = *(const f32x4*)(md + 5120 + c), gf = *(const f32x4*)(P.in[I_GPOF] + c);
        const f32x4 a1 = g1 * gp, a2 = g2 * gf;
#pragma unroll
        for (int b = 0; b < NBF; ++b) { const int r = r0 + b * nw;
            const float rso = rsqrtf(sso[b] * (1.0f / 1024.0f) + EPS_), rsf = rsqrtf(ssf[b] * (1.0f / 1024.0f) + EPS_);
            const f32x4 x1 = xv[b][i] + a1 * (up4(ow[b][i]) * rso);
            __builtin_nontemporal_store(x1 + a2 * (up4(fw[b][i]) * rsf), (f32x4*)(P.out + O_YP + (size_t)r * 1024 + c)); } }
}
__device__ void phase10(const Params& P) {
    int tid = threadIdx.x; asm volatile("" : "+v"(tid));
    const int wid = __builtin_amdgcn_readfirstlane(tid >> 6), lane = tid & 63;
    const int nw = gridDim.x * 8;
    int r0 = blockIdx.x * 8 + wid;
    for (; r0 + (NBF - 1) * nw < T_; r0 += nw * NBF) phase10_fast(P, r0, nw, lane);
    for (; r0 < MR_; r0 += nw * NB10) {
        if (r0 + (NB10 - 1) * nw < T_) phase10_batch<true>(P, r0, nw, lane); else phase10_batch<false>(P, r0, nw, lane);
    }
}

#define XB_TMO      128
#define XB_XCNT(j)  (256  + 64 * (j))
#define XB_XSUB(j)  (1280 + 64 * (j))
#define XB_XGEN(j)  (2304 + 64 * (j))
#define XB_TOP      3328
#define XB_TOPGEN   3392
#define XCD_BAR_WORDS 3456
#define XB_SPIN_CAP (1u << 22)
__device__ __forceinline__ unsigned xb_ld(unsigned* p)              { return __hip_atomic_load(p, __ATOMIC_RELAXED, __HIP_MEMORY_SCOPE_AGENT); }
__device__ __forceinline__ unsigned xb_add(unsigned* p, unsigned v) { return __hip_atomic_fetch_add(p, v, __ATOMIC_RELAXED, __HIP_MEMORY_SCOPE_AGENT); }
__device__ __forceinline__ unsigned xb_xcc_id() { return (unsigned)__builtin_amdgcn_s_getreg((3 << 11) | 20) & 0xFu; }
#define XB_SPIN(cond, bar) do { unsigned _sp = 0; while (cond) { __builtin_amdgcn_s_sleep(1); \
    if ((++_sp & 255u) == 0u) { if (xb_ld(&(bar)[XB_TMO])) break; if (_sp > XB_SPIN_CAP) { atomicAdd(&(bar)[XB_TMO], 1u); break; } } } } while (0)
struct XcdBarrier { unsigned* bar; unsigned x; volatile LAS unsigned* st; };
__device__ __forceinline__ XcdBarrier xcd_barrier_post(unsigned* bar, volatile LAS unsigned* st) {
    XcdBarrier b; b.bar = bar; b.x = xb_xcc_id(); b.st = st;
    if (threadIdx.x == 0) (void)xb_add(&bar[XB_XCNT(b.x)], 1u);
    return b;
}
__device__ __forceinline__ void xcd_barrier_complete(unsigned* bar, unsigned x, unsigned& nloc, unsigned& nx) {
    const unsigned G = gridDim.x * gridDim.y * gridDim.z;
    unsigned sum, cnt, mine, sp = 0u;
    for (;;) {
        sum = 0u; cnt = 0u; mine = 0u;
#pragma unroll
        for (unsigned j = 0; j < 16; ++j) { const unsigned c = xb_ld(&bar[XB_XCNT(j)]); sum += c; cnt += (c > 0u) ? 1u : 0u; mine = (j == x) ? c : mine; }
        if (sum == G) break;
        __builtin_amdgcn_s_sleep(1);
        if ((++sp & 255u) == 0u) { if (xb_ld(&bar[XB_TMO])) break; if (sp > XB_SPIN_CAP) { atomicAdd(&bar[XB_TMO], 1u); break; } }
    }
    nloc = mine > 0u ? mine : 1u; nx = cnt > 0u ? cnt : 1u;
}
__device__ __forceinline__ void xcd_barrier(const XcdBarrier& b) {
    asm volatile("s_waitcnt vmcnt(0)" ::: "memory");
    __syncthreads();
    if (threadIdx.x == 0) {
        unsigned* bar = b.bar;
        __builtin_amdgcn_s_waitcnt(0);
        unsigned nloc = b.st[0], nx = b.st[1];
        if (nloc == 0u) { xcd_barrier_complete(bar, b.x, nloc, nx); b.st[0] = nloc; b.st[1] = nx; }
        const unsigned old = xb_add(&bar[XB_XSUB(b.x)], 1u);
        const unsigned gen = old / nloc;
        if (old + 1u == (gen + 1u) * nloc) {
            __builtin_amdgcn_fence(__ATOMIC_RELEASE, "agent");
            asm volatile("s_waitcnt vmcnt(0)" ::: "memory");
            const unsigned og = xb_add(&bar[XB_TOP], 1u);
            const unsigned tg = og / nx;
            if (og + 1u == (tg + 1u) * nx) xb_add(&bar[XB_TOPGEN], 1u);
            else XB_SPIN(xb_ld(&bar[XB_TOPGEN]) == tg, bar);
            __builtin_amdgcn_fence(__ATOMIC_ACQUIRE, "agent");
            xb_add(&bar[XB_XGEN(b.x)], 1u);
            asm volatile("s_waitcnt vmcnt(0)" ::: "memory");
        } else {
            XB_SPIN(xb_ld(&bar[XB_XGEN(b.x)]) == gen, bar);
            __builtin_amdgcn_fence(__ATOMIC_ACQUIRE, "agent");
            asm volatile("s_waitcnt vmcnt(0)" ::: "memory");
        }
    }
    __syncthreads();
}

template <bool COOP>
__global__ void __launch_bounds__(512) hymba_mega(Params P, int ph_lo, int ph_hi) {
    extern __shared__ __attribute__((aligned(16))) char lds_raw[];
    LAS unsigned char* lds = (LAS unsigned char*)lds_raw;
    char* ws = P.ws; const int G = gridDim.x, bid = blockIdx.x;
    XcdBarrier xb; xb.bar = (unsigned*)(ws + OFF_BAR); xb.x = 0; xb.st = (volatile LAS unsigned*)(lds + LDS_BYTES - 16);
    if (COOP) { if (threadIdx.x == 0) { xb.st[0] = 0u; xb.st[1] = 0u; } __syncthreads(); xb = xcd_barrier_post((unsigned*)(ws + OFF_BAR), (volatile LAS unsigned*)(lds + LDS_BYTES - 16)); }
#if MK_PROBE
    unsigned long long tprev = __builtin_amdgcn_s_memrealtime(), tacc = 0ull;
#endif
#if MK_PROBE_ID
    unsigned long long tacc2 = 0ull;
#endif
    for (int ph = ph_lo; ph < ph_hi; ++ph) {
        switch (ph) {
        case 0: if constexpr (PH_ON(0)) phase0(P, (float*)lds_raw); break;
        case 1: if constexpr (PH_ON(1)) phase1(P, lds, (float*)lds_raw); break;
        case 2: if constexpr (PH_ON(2)) phase2(P); break;
        case 3: if constexpr (PH_ON(3)) { Gemm g{(const bf16_t*)(ws + OFF_HM), (const bf16_t*)(ws + OFF_WT_IN), 1024}; Sched S; S.init(65, 14, G, bid);
                  Epi1 E{(bf16_t*)(ws + OFF_MIX), (bf16_t*)(ws + OFF_KB), (bf16_t*)(ws + OFF_VT), (bf16_t*)(ws + OFF_VSB), (bf16_t*)(ws + OFF_XR)};
                  PB_BEGIN(5); gemm_phase<Epi1, false, false>(lds, g, S, E); PB_END(5); } break;
        case 4: if constexpr (PH_ON(4)) {
                  const int cls = (bid >> 3) % 3;
#pragma unroll 1
                  for (int st = 0; st < 3; ++st) { int which = st + cls; if (which >= 3) which -= 3;
                      if (which == 0) { for (int it = bid; it < 256; it += G) attn_prompt_item(P, lds_raw, it >> 1, it & 1); }
                      else if (which == 1) { for (int it = bid; it < 256; it += G) attn_sample_item(P, lds_raw, it >> 1, it & 1); }
                      else { for (int it = bid; it < 1024 + 64; it += G) { if (it < 1024) rnn1_item<false>(P, lds_raw, it >> 3, it & 7, 0); else rnn1_item<true>(P, lds_raw, 128, (it - 1024) & 7, (it - 1024) >> 3); } } }
                  state_out_prompt(P); } break;
        case 5: if constexpr (PH_ON(5)) { for (int it = bid; it < 128 * 8; it += G) rnn2_item(P, lds_raw, it >> 3, it & 7); } break;
        case 6: if constexpr (PH_ON(6)) { Gemm g{(const bf16_t*)(ws + OFF_MIX), (const bf16_t*)(ws + OFF_WT_OUT), 2048}; Sched S; S.init(64, 4, G, bid);
                  Epi2 E{(bf16_t*)(ws + OFF_XR), (const float*)(ws + OFF_SS), (const float*)(ws + OFF_SS) + MP_};
                  PB_BEGIN(1); gemm_phase<Epi2, false, true>(lds, g, S, E); PB_END(1);
                  PB_BEGIN(2); for (int it = bid; it < 256; it += G) small_gemm_item<8>((const bf16_t*)(ws + OFF_MIX) + (size_t)T_ * 2048, 2048, (const bf16_t*)(ws + OFF_WT_OUT), 2048, (float*)(ws + OFF_OS2), it >> 3, it & 7,
                                                                          (const float*)(ws + OFF_SS) + ((it & 7) < 4 ? 0 : MP_) + T_); PB_END(2); } break;
        case 7: if constexpr (PH_ON(7)) phase7(P); break;
        case 8: if constexpr (PH_ON(8)) { Gemm g{(const bf16_t*)(ws + OFF_HM), (const bf16_t*)(ws + OFF_WT_UP), 1024}; Sched S; S.init(67, 22, G, bid);
                  Epi3 E{(bf16_t*)(ws + OFF_MIX), P.in[I_FCW], P.in[I_FCB], P.in[I_SF], P.out};
                  PB_BEGIN(6); gemm_phase<Epi3, true, false>(lds, g, S, E); PB_END(6); } break;
        case 9: if constexpr (PH_ON(9)) { Gemm g{(const bf16_t*)(ws + OFF_MIX), (const bf16_t*)(ws + OFF_WT_DOWN), 2816}; Sched S; S.init(64, 4, G, bid);
                  Epi4 E{(bf16_t*)(ws + OFF_HM)};
                  PB_BEGIN(3); gemm_phase<Epi4, false, false>(lds, g, S, E); PB_END(3);
                  PB_BEGIN(4); for (int it = bid; it < 256; it += G) small_gemm_item<11>((const bf16_t*)(ws + OFF_MIX) + (size_t)T_ * 2816, 2816, (const bf16_t*)(ws + OFF_WT_DOWN), 2816, (float*)(ws + OFF_OS4), it >> 3, it & 7, nullptr); PB_END(4); } break;
        case 10: if constexpr (PH_ON(10)) phase10(P); break;
        }
        if (COOP) { if (ph + 1 < ph_hi) xcd_barrier(xb); }
#if MK_PROBE
        { const unsigned long long tn = __builtin_amdgcn_s_memrealtime(); if ((MK_PROBE >> ph) & 1) tacc += tn - tprev; tprev = tn; }
#endif
    }
#if MK_PROBE_ID
    if (bid == 0 && threadIdx.x == 0) { const unsigned long long t0 = __builtin_amdgcn_s_memrealtime(); while (__builtin_amdgcn_s_memrealtime() - t0 < 4ull * tacc2) __builtin_amdgcn_s_sleep(8); }
#endif
#if MK_PROBE
    if (bid == 0 && threadIdx.x == 0) { const unsigned long long t0 = __builtin_amdgcn_s_memrealtime(); while (__builtin_amdgcn_s_memrealtime() - t0 < 4ull * tacc) __builtin_amdgcn_s_sleep(8); }
#endif
}

extern "C" void kernel_launch(void* const* d_in, const int* in_sizes, int n_in, void* d_out, int out_size, void* d_ws, size_t ws_size, hipStream_t stream) {
    (void)in_sizes; (void)out_size;
    if (n_in != 31 || ws_size < WS_NEED) { fprintf(stderr, "hymba_mega: bad arguments (n_in %d, ws %zu < %zu)\n", n_in, ws_size, (size_t)WS_NEED); return; }
    Params P{};
    for (int i = 0; i < 31; ++i) P.in[i] = (const float*)d_in[i];
    P.out = (float*)d_out; P.ws = (char*)d_ws;
#if MK_COOP
    static int grid_blocks = 0;
    if (!grid_blocks) {
        (void)hipFuncSetAttribute((const void*)hymba_mega<true>, hipFuncAttributeMaxDynamicSharedMemorySize, LDS_BYTES);
        int dev = 0, cus = 0, per_cu = 0; (void)hipGetDevice(&dev); (void)hipDeviceGetAttribute(&cus, hipDeviceAttributeMultiprocessorCount, dev);
        (void)hipOccupancyMaxActiveBlocksPerMultiprocessor(&per_cu, (const void*)hymba_mega<true>, 512, LDS_BYTES);
        if (per_cu < 1) per_cu = 1; if (per_cu > 1) per_cu = 1;
        grid_blocks = cus * per_cu;
    }
    (void)hipMemsetAsync((char*)d_ws + OFF_BAR, 0, 16384, stream);
    int lo = 0, hi = 11; void* args[] = {&P, &lo, &hi};
    hipError_t e = hipLaunchCooperativeKernel((const void*)hymba_mega<true>, dim3(grid_blocks), dim3(512), args, LDS_BYTES, stream);
    if (e != hipSuccess) fprintf(stderr, "cooperative launch failed: %s (grid %d)\n", hipGetErrorString(e), grid_blocks);
#else
    static bool attr = false;
    if (!attr) { attr = true; (void)hipFuncSetAttribute((const void*)hymba_mega<false>, hipFuncAttributeMaxDynamicSharedMemorySize, LDS_BYTES); }
    for (int ph = 0; ph < 11; ++ph) hymba_mega<false><<<dim3(256), dim3(512), LDS_BYTES, stream>>>(P, ph, ph + 1);
#endif
}
```

```cpp
#include <hip/hip_runtime.h>
#include <hip/hip_cooperative_groups.h>
#include <cstdio>
#include <cstdint>
namespace cg = cooperative_groups;

#ifndef MK_COOP
#define MK_COOP 1
#endif
#ifndef MK_PROBE
#define MK_PROBE 0
#endif
#ifndef MK_PROBE_ID
#define MK_PROBE_ID 0
#endif
#if MK_PROBE_ID
#define PB_BEGIN(id) unsigned long long _pb##id = 0; if (((MK_PROBE_ID) >> (id)) & 1) _pb##id = __builtin_amdgcn_s_memrealtime()
#define PB_END(id) if (((MK_PROBE_ID) >> (id)) & 1) tacc2 += __builtin_amdgcn_s_memrealtime() - _pb##id
#else
#define PB_BEGIN(id)
#define PB_END(id)
#endif
#ifndef MK_PHMASK
#define MK_PHMASK 0x7ff
#endif
#define PH_ON(x) (((MK_PHMASK) >> (x)) & 1)

#define LAS __attribute__((address_space(3)))
typedef unsigned short bf16_t;
typedef short bf16x8 __attribute__((ext_vector_type(8)));
typedef short s16x4 __attribute__((ext_vector_type(4)));
typedef float f32x4 __attribute__((ext_vector_type(4)));
typedef float f32x16 __attribute__((ext_vector_type(16)));
typedef unsigned u32x4 __attribute__((ext_vector_type(4)));
typedef unsigned u32x2 __attribute__((ext_vector_type(2)));

constexpr int T_ = 16384, SB_ = 128, MR_ = 16512, MP_ = 16640;
constexpr float EPS_ = 1e-6f;
constexpr float LOG2E_ = 1.4426950408889634f;
constexpr float QSCALE_ = 0.08838834764831845f * 1.4426950408889634f;
constexpr int LDS_BYTES = 140288;

constexpr size_t OFF_WT_ADA = 0;
constexpr size_t OFF_A_ADA = OFF_WT_ADA + (size_t)6144 * 1024 * 2;
constexpr size_t OFF_MOD = OFF_A_ADA + (size_t)256 * 1024 * 2;
constexpr size_t OFF_WT_IN = OFF_MOD + (size_t)256 * 6144 * 4;
constexpr size_t OFF_WT_OUT = OFF_WT_IN + (size_t)3584 * 1024 * 2;
constexpr size_t OFF_WT_UP = OFF_WT_OUT + (size_t)1024 * 2048 * 2;
constexpr size_t OFF_WT_DOWN = OFF_WT_UP + (size_t)5632 * 1024 * 2;
constexpr size_t OFF_WT_A = OFF_WT_DOWN + (size_t)1024 * 2816 * 2;
constexpr size_t OFF_WT_I = OFF_WT_A + (size_t)8 * 128 * 128 * 2;
constexpr size_t OFF_SP8 = OFF_WT_I + (size_t)8 * 128 * 128 * 2;
constexpr size_t OFF_SS = OFF_SP8 + 4096;
constexpr size_t OFF_SEGA = OFF_SS + (size_t)4 * MP_ * 4;
constexpr size_t OFF_SEGE = OFF_SEGA + (size_t)512 * 1024 * 4;
constexpr size_t OFF_TILEA = OFF_SEGE + (size_t)512 * 1024 * 4;
constexpr size_t OFF_TILEE = OFF_TILEA + (size_t)128 * 1024 * 4;
constexpr size_t OFF_VSB = OFF_TILEE + (size_t)128 * 1024 * 4;
constexpr size_t OFF_OS2 = OFF_VSB + (size_t)256 * 256 * 2;
constexpr size_t OFF_OS4 = OFF_OS2 + (size_t)8 * 128 * 1024 * 4;
constexpr size_t OFF_BAR = OFF_OS4 + (size_t)8 * 128 * 1024 * 4;
constexpr size_t OFF_MIX = OFF_BAR + 16384;
constexpr size_t OFF_U = OFF_MIX + (size_t)MP_ * 2048 * 2;
constexpr size_t OFF_KB = OFF_U + (size_t)MP_ * 1024 * 2;
constexpr size_t OFF_VT = OFF_KB + (size_t)MP_ * 256 * 2;
constexpr size_t OFF_XR = OFF_VT + (size_t)256 * T_ * 2;
constexpr size_t OFF_HM0 = OFF_XR + (size_t)MP_ * 1024 * 2;
constexpr size_t OFF_HM = OFF_HM0 + 4096;
constexpr size_t WS_NEED = OFF_HM + (size_t)MP_ * 1024 * 2;
static_assert(WS_NEED <= (size_t)256 * 1024 * 1024, "workspace");
static_assert(OFF_MIX + (size_t)MP_ * 2816 * 2 <= OFF_KB, "FIN alias");

constexpr size_t O_YP = 0, O_YS = O_YP + (size_t)T_ * 1024, O_KP = O_YS + 128 * 1024, O_VP = O_KP + 32768, O_HP = O_VP + 32768,
                 O_CP = O_HP + 1024, O_FP = O_CP + 3072, O_KS = O_FP + 11264, O_VS = O_KS + 4194304, O_HS = O_VS + 4194304,
                 O_CS = O_HS + 131072, O_FS = O_CS + 393216;

struct Params { const float* in[31]; float* out; char* ws; };
enum { I_XP = 0, I_XS, I_CK, I_CV, I_SH, I_SC, I_SF, I_CP, I_CS, I_WADA, I_BADA, I_GPM, I_WIN, I_CW, I_CB, I_WA, I_BA, I_WI, I_BI, I_LAM, I_SINK,
       I_GAO, I_GRO, I_WOUT, I_GPOM, I_GPF, I_WUP, I_FCW, I_FCB, I_WDOWN, I_GPOF };

__device__ __forceinline__ unsigned cvt_pk_bf16(float lo, float hi) { unsigned r; asm volatile("v_cvt_pk_bf16_f32 %0, %1, %2" : "=v"(r) : "v"(lo), "v"(hi)); return r; }
__device__ __forceinline__ float bf2f(unsigned b) { return __uint_as_float(b << 16); }
__device__ __forceinline__ float bflo(unsigned w) { return __uint_as_float(w << 16); }
__device__ __forceinline__ float bfhi(unsigned w) { return __uint_as_float(w & 0xffff0000u); }
__device__ __forceinline__ bf16_t f2bf(float f) { return (bf16_t)(cvt_pk_bf16(f, 0.f) & 0xffffu); }
__device__ __forceinline__ float gelu_t(float x) { const float u = x * (1.0f + 0.044715f * x * x); const float e = __builtin_amdgcn_exp2f(-2.302208198f * u); return x * __builtin_amdgcn_rcpf(1.0f + e); }
__device__ __forceinline__ float sigmoid_f(float x) { return __builtin_amdgcn_rcpf(1.0f + __builtin_amdgcn_exp2f(-LOG2E_ * x)); }
__device__ __forceinline__ float wave_sum(float v) { v += __shfl_xor(v, 1); v += __shfl_xor(v, 2); v += __shfl_xor(v, 4); v += __shfl_xor(v, 8); v += __shfl_xor(v, 16); v += __shfl_xor(v, 32); return v; }
__device__ __forceinline__ int modrow(int r) { return r < T_ ? 0 : r - T_ + 1; }

constexpr int BM = 256, BK = 64, HALF = 128, HTB = HALF * BK * 2, STAGE_BYTES = 8 * HTB, NXCD = 8, WGM = 8;
__device__ __forceinline__ int lds_byte(int r, int c) { const int st = (r >> 4) * 2 + (c >> 5), rr = r & 15, cc = c & 31, ob = rr * 64 + cc * 2; return st * 1024 + (ob ^ (((ob >> 9) & 1) << 5)); }
__device__ __forceinline__ void stage_rc(int b, int& R, int& C) { const int st = b / 1024, sb = b % 1024, swz = sb ^ (((sb >> 9) & 1) << 5); R = (st >> 1) * 16 + swz / 64; C = (st & 1) * 32 + (swz % 64) / 2; }
struct Unit { int pm, pn; };
struct Gemm { const bf16_t* A; const bf16_t* Bt; int K; };
struct Sched {
    int nM, nN, nwg, G, c;
    __device__ void init(int nM_, int nN_, int G_, int c_) { nM = nM_; nN = nN_; nwg = nM * nN; G = G_; c = c_; }
    __device__ bool next(int i, Unit& u) const {
        const long L = (long)i * G + c; if (L >= nwg) return false;
        int wgid = (int)L; { const int q = nwg / NXCD, r = nwg % NXCD, xcd = wgid % NXCD, off = wgid / NXCD; wgid = (xcd < r ? xcd * (q + 1) : r * (q + 1) + (xcd - r) * q) + off; }
        const int nig = WGM * nN, gid = wgid / nig, fm = gid * WGM, gsz = (nM - fm) < WGM ? (nM - fm) : WGM;
        u.pm = fm + ((wgid % nig) % gsz); u.pn = (wgid % nig) / gsz; return true;
    }
};
template <bool APERM> __device__ __forceinline__ size_t tileA_off(int pm, int K) {
    if (APERM) return (size_t)(pm < 66 ? 252 * pm : 16386) * (size_t)K * 2 - (size_t)2 * K * 2;
    return (size_t)pm * 256 * (size_t)K * 2;
}

template <class Epi, bool APERM, bool MID>
__device__ __forceinline__ void gemm_phase(LAS unsigned char* lds, const Gemm g, const Sched& S, const Epi& E) {
    int tid = threadIdx.x; asm volatile("" : "+v"(tid));
    const int wid = __builtin_amdgcn_readfirstlane(tid >> 6), lane = tid & 63, wr = wid >> 2, wc = wid & 3, fr = lane & 15, fq = lane >> 4;
    const int K = g.K, nt = K / BK;
    unsigned voffA[2], voffB[2];
#pragma unroll
    for (int i = 0; i < 2; ++i) { int R, C; stage_rc(tid * 16 + i * 8192, R, C);
        const int Ra = APERM ? (126 * (R >> 6) + 8 * (R & 15) + ((R >> 4) & 3)) : R;
        voffA[i] = (unsigned)(Ra * K + C) * 2u; voffB[i] = (unsigned)(R * K + C) * 2u; }
    const size_t kstep = (size_t)(BK * 2);
    const size_t hstepB = (size_t)HALF * K * 2;
    const size_t hstepA = APERM ? (size_t)4 * K * 2 : hstepB;
    const size_t tstepB = 2 * hstepB;
    const unsigned ldsw = (unsigned)wid * 1024u;
    const int aoff = lds_byte(wr * 64 + fr, fq * 8), boff = lds_byte(wc * 32 + fr, fq * 8);
#define PG8_SA(b, h) (((b) * 2 + (h)) * HTB)
#define PG8_SB(b, h) ((4 + (b) * 2 + (h)) * HTB)
#define PG8_STAGE(bufoff, gbase, voff) do { _Pragma("unroll") for (int _i = 0; _i < 2; ++_i) \
        __builtin_amdgcn_global_load_lds((const unsigned*)((const char*)(gbase) + (voff)[_i]), (LAS unsigned*)(lds + (bufoff) + ldsw + _i * 8192), 16, 0, 0); } while (0)
#define PG8_LDA(dst, b, h) do { _Pragma("unroll") for (int m = 0; m < 4; ++m) _Pragma("unroll") for (int k = 0; k < 2; ++k) dst[m][k] = *(const LAS bf16x8*)(lds + PG8_SA(b, h) + aoff + m * 2048 + k * 1024); } while (0)
#define PG8_LDB(dst, b, h) do { _Pragma("unroll") for (int n = 0; n < 2; ++n) _Pragma("unroll") for (int k = 0; k < 2; ++k) dst[n][k] = *(const LAS bf16x8*)(lds + PG8_SB(b, h) + boff + n * 2048 + k * 1024); } while (0)
#define PG8_MMA(ai, bj, At, Bt) do { __builtin_amdgcn_s_setprio(1); _Pragma("unroll") for (int m = 0; m < 4; ++m) _Pragma("unroll") for (int n = 0; n < 2; ++n) _Pragma("unroll") for (int k = 0; k < 2; ++k) \
        acc[ai][bj][m][n] = __builtin_amdgcn_mfma_f32_16x16x32_bf16(Bt[n][k], At[m][k], acc[ai][bj][m][n], 0, 0, 0); __builtin_amdgcn_s_setprio(0); } while (0)
#define PG8_WAIT_V(n) asm volatile("s_waitcnt vmcnt(" #n ")" ::: "memory")
#define PG8_WAIT_L(n) asm volatile("s_waitcnt lgkmcnt(" #n ")" ::: "memory")
#define PG8_BAR __builtin_amdgcn_s_barrier()
#define PG8_SCHED __builtin_amdgcn_sched_barrier(0)
    Unit cur, nxt; int ui = 0;
    if (!S.next(0, cur)) return;
    f32x4 acc[2][2][4][2];
#pragma unroll
    for (int a = 0; a < 2; ++a)
#pragma unroll
        for (int b = 0; b < 2; ++b)
#pragma unroll
            for (int m = 0; m < 4; ++m)
#pragma unroll
                for (int n = 0; n < 2; ++n) acc[a][b][m][n] = (f32x4){0.f, 0.f, 0.f, 0.f};
    bf16x8 At[4][2], B0[2][2], B1[2][2];
    const char* cA = (const char*)g.A + tileA_off<APERM>(cur.pm, K); const char* cB = (const char*)g.Bt + (size_t)cur.pn * tstepB;
    PG8_STAGE(PG8_SB(0, 0), cB, voffB); PG8_STAGE(PG8_SA(0, 0), cA, voffA); PG8_STAGE(PG8_SB(0, 1), cB + hstepB, voffB); PG8_STAGE(PG8_SA(0, 1), cA + hstepA, voffA);
    if (wr == 1) PG8_BAR;
    PG8_WAIT_V(4); PG8_BAR;
    PG8_STAGE(PG8_SB(1, 0), cB + kstep, voffB); PG8_STAGE(PG8_SA(1, 0), cA + kstep, voffA); PG8_STAGE(PG8_SB(1, 1), cB + hstepB + kstep, voffB);
    PG8_WAIT_V(6); PG8_BAR;
    for (;;) {
        const bool has_next = S.next(ui + 1, nxt);
        const char* nA = has_next ? (const char*)g.A + tileA_off<APERM>(nxt.pm, K) : cA; const char* nB = has_next ? (const char*)g.Bt + (size_t)nxt.pn * tstepB : cB;
        for (int t = 0; t < nt; t += 2) {
            const bool last = (t == nt - 2);
            const char* a1 = cA + (size_t)(t + 1) * kstep;
            const char* a2 = last ? nA : cA + (size_t)(t + 2) * kstep; const char* b2 = last ? nB : cB + (size_t)(t + 2) * kstep;
            const char* a3 = a2 + kstep; const char* b3 = b2 + kstep;
            if constexpr (MID) { if (t == (nt >> 1)) E.mid(acc, cur, wr, fr); }
            PG8_LDB(B0, 0, 0); PG8_SCHED; PG8_LDA(At, 0, 0); PG8_STAGE(PG8_SA(1, 1), a1 + hstepA, voffA);
            PG8_WAIT_L(8); PG8_BAR; PG8_WAIT_L(0); PG8_MMA(0, 0, At, B0); PG8_BAR; PG8_SCHED;
            PG8_LDB(B1, 0, 1); PG8_STAGE(PG8_SB(0, 0), b2, voffB);
            PG8_BAR; PG8_WAIT_L(0); PG8_MMA(0, 1, At, B1); PG8_BAR;
            PG8_LDA(At, 0, 1); PG8_STAGE(PG8_SA(0, 0), a2, voffA);
            PG8_BAR; PG8_WAIT_L(0); PG8_MMA(1, 0, At, B0); PG8_BAR; PG8_SCHED;
            PG8_STAGE(PG8_SB(0, 1), b2 + hstepB, voffB);
            PG8_WAIT_V(6); PG8_BAR; PG8_MMA(1, 1, At, B1); PG8_BAR;
            PG8_LDB(B0, 1, 0); PG8_SCHED; PG8_LDA(At, 1, 0); PG8_STAGE(PG8_SA(0, 1), a2 + hstepA, voffA);
            PG8_WAIT_L(8); PG8_BAR; PG8_WAIT_L(0); PG8_MMA(0, 0, At, B0); PG8_BAR; PG8_SCHED;
            PG8_LDB(B1, 1, 1); PG8_STAGE(PG8_SB(1, 0), b3, voffB);
            PG8_BAR; PG8_WAIT_L(0); PG8_MMA(0, 1, At, B1); PG8_BAR;
            PG8_LDA(At, 1, 1); PG8_STAGE(PG8_SA(1, 0), a3, voffA);
            PG8_BAR; PG8_WAIT_L(0); PG8_MMA(1, 0, At, B0); PG8_BAR; PG8_SCHED;
            PG8_STAGE(PG8_SB(1, 1), b3 + hstepB, voffB);
            PG8_WAIT_V(6); PG8_BAR; PG8_MMA(1, 1, At, B1); PG8_BAR;
        }
        E(acc, cur, wr, wc, fr, fq);
        if (!has_next) break;
#pragma unroll
        for (int a = 0; a < 2; ++a)
#pragma unroll
            for (int b = 0; b < 2; ++b)
#pragma unroll
                for (int m = 0; m < 4; ++m)
#pragma unroll
                    for (int n = 0; n < 2; ++n) acc[a][b][m][n] = (f32x4){0.f, 0.f, 0.f, 0.f};
        cur = nxt; cA = nA; cB = nB; ++ui;
    }
    PG8_WAIT_V(0);
    if (wr == 0) PG8_BAR;
    PG8_BAR;
#undef PG8_SA
#undef PG8_SB
#undef PG8_STAGE
#undef PG8_LDA
#undef PG8_LDB
#undef PG8_MMA
#undef PG8_WAIT_V
#undef PG8_WAIT_L
#undef PG8_BAR
#undef PG8_SCHED
}

typedef f32x4 AccT[2][2][4][2];

#ifndef E1MASK
#define E1MASK 31
#endif
#define E1B(x) (((E1MASK) >> (x)) & 1)
#ifndef P4MASK
#define P4MASK 7
#endif
#define P4B(x) (((P4MASK) >> (x)) & 1)
#define EPI_FENCE() asm volatile("" ::: "memory")
__device__ __forceinline__ u32x2 pk4(const f32x4 v) { u32x2 w; w.x = cvt_pk_bf16(v[0], v[1]); w.y = cvt_pk_bf16(v[2], v[3]); return w; }

struct EpiAda {
    float* C; const float* bias;
    __device__ __forceinline__ void operator()(const AccT& acc, const Unit& u, int wr, int wc, int fr, int fq) const {
        const int col0 = u.pn * BM + wc * 32 + 4 * fq;
        float* base = C + (size_t)(u.pm * BM + wr * 64 + fr) * 6144 + col0; const float* bp = bias + col0;
#pragma unroll
        for (int bj = 0; bj < 2; ++bj)
#pragma unroll
            for (int n = 0; n < 2; ++n) { const f32x4 bv = *(const f32x4*)(bp + bj * HALF + n * 16);
#pragma unroll
                for (int ai = 0; ai < 2; ++ai)
#pragma unroll
                    for (int m = 0; m < 4; ++m) *(f32x4*)(base + (size_t)(ai * HALF + m * 16) * 6144 + bj * HALF + n * 16) = acc[ai][bj][m][n] + bv;
                EPI_FENCE(); }
    }
};

struct Epi1 {
    bf16_t* MIX; bf16_t* KB; bf16_t* VT; bf16_t* VSB; bf16_t* XR;
    __device__ __forceinline__ void operator()(const AccT& acc, const Unit& u, int wr, int wc, int fr, int fq) const {
        const int rl = wr * 64 + fr, row0 = u.pm * BM + rl, cw = wc * 32 + 4 * fq; const int pn = u.pn, pm = u.pm;
        if (pn == 5 && pm < 64) {
            bf16_t* cp0 = VT + (size_t)cw * T_ + row0;
#pragma unroll
            for (int bj = 0; bj < 2; ++bj)
#pragma unroll
                for (int n = 0; n < 2; ++n) {
#pragma unroll
                    for (int e = 0; e < 4; ++e) { bf16_t* p = cp0 + (size_t)(bj * HALF + n * 16 + e) * T_;
#pragma unroll
                        for (int ai = 0; ai < 2; ++ai)
#pragma unroll
                            for (int m = 0; m < 4; ++m) p[ai * HALF + m * 16] = f2bf(acc[ai][bj][m][n][e]);
                        EPI_FENCE(); } }
            return;
        }
        bf16_t* base; int ld; float sc = 1.0f; bool gel = false;
        if (pn < 4) { base = MIX + (size_t)row0 * 2048 + pn * 256 + cw; ld = 2048; sc = QSCALE_; }
        else if (pn == 4) { base = KB + (size_t)row0 * 256 + cw; ld = 256; }
        else if (pn == 5) { base = VSB + (size_t)rl * 256 + cw; ld = 256; }
        else if (pn < 10) { base = XR + (size_t)row0 * 1024 + (pn - 6) * 256 + cw; ld = 1024; }
        else { base = MIX + (size_t)row0 * 2048 + 1024 + (pn - 10) * 256 + cw; ld = 2048; gel = true; }
        if (!gel) {
#pragma unroll
            for (int ai = 0; ai < 2; ++ai)
#pragma unroll
                for (int m = 0; m < 4; ++m) { bf16_t* rp = base + (size_t)(ai * HALF + m * 16) * ld;
#pragma unroll
                    for (int bj = 0; bj < 2; ++bj)
#pragma unroll
                        for (int n = 0; n < 2; ++n) *(u32x2*)(rp + bj * HALF + n * 16) = pk4(acc[ai][bj][m][n] * sc);
                    EPI_FENCE(); }
        } else {
#pragma unroll
            for (int ai = 0; ai < 2; ++ai)
#pragma unroll
                for (int m = 0; m < 4; ++m) { bf16_t* rp = base + (size_t)(ai * HALF + m * 16) * ld;
#pragma unroll
                    for (int bj = 0; bj < 2; ++bj)
#pragma unroll
                        for (int n = 0; n < 2; ++n) { const f32x4 v = acc[ai][bj][m][n]; u32x2 w; w.x = cvt_pk_bf16(gelu_t(v[0]), gelu_t(v[1])); w.y = cvt_pk_bf16(gelu_t(v[2]), gelu_t(v[3]));
                            *(u32x2*)(rp + bj * HALF + n * 16) = w; }
                    EPI_FENCE(); }
        }
    }
};

struct Epi2 {
    bf16_t* O; const float* SSA; const float* SSR;
    __device__ __forceinline__ void mid(AccT& acc, const Unit& u, int wr, int fr) const {
        const int row0 = u.pm * BM + wr * 64 + fr; const float* pa = SSA + row0; const float* pr = SSR + row0;
        float va[8], vr[8];
#pragma unroll
        for (int q = 0; q < 8; ++q) { va[q] = pa[(q >> 2) * HALF + (q & 3) * 16]; vr[q] = pr[(q >> 2) * HALF + (q & 3) * 16]; }
        EPI_FENCE();
#pragma unroll
        for (int ai = 0; ai < 2; ++ai)
#pragma unroll
            for (int m = 0; m < 4; ++m) {
                const float ra = va[ai * 4 + m] * (1.0f / 1024.0f) + EPS_, rr = vr[ai * 4 + m] * (1.0f / 1024.0f) + EPS_; const float ratio = sqrtf(rr * __builtin_amdgcn_rcpf(ra));
#pragma unroll
                for (int bj = 0; bj < 2; ++bj)
#pragma unroll
                    for (int n = 0; n < 2; ++n) acc[ai][bj][m][n] *= ratio; }
    }
    __device__ __forceinline__ void operator()(const AccT& acc, const Unit& u, int wr, int wc, int fr, int fq) const {
        const int row0 = u.pm * BM + wr * 64 + fr, col0 = u.pn * BM + wc * 32 + 4 * fq;
        bf16_t* base = O + (size_t)row0 * 1024 + col0; const float* pr = SSR + row0;
        float vr[8];
#pragma unroll
        for (int q = 0; q < 8; ++q) vr[q] = pr[(q >> 2) * HALF + (q & 3) * 16];
        EPI_FENCE();
#pragma unroll
        for (int ai = 0; ai < 2; ++ai)
#pragma unroll
            for (int m = 0; m < 4; ++m) { const float rs = rsqrtf(vr[ai * 4 + m] * (1.0f / 1024.0f) + EPS_); bf16_t* rp = base + (size_t)(ai * HALF + m * 16) * 1024;
#pragma unroll
                for (int bj = 0; bj < 2; ++bj)
#pragma unroll
                    for (int n = 0; n < 2; ++n) *(u32x2*)(rp + bj * HALF + n * 16) = pk4(acc[ai][bj][m][n] * rs);
                EPI_FENCE(); }
    }
};

struct Epi4 {
    bf16_t* F;
    __device__ __forceinline__ void operator()(const AccT& acc, const Unit& u, int wr, int wc, int fr, int fq) const {
        const int row0 = u.pm * BM + wr * 64 + fr, col0 = u.pn * BM + wc * 32 + 4 * fq;
        bf16_t* base = F + (size_t)row0 * 1024 + col0;
#pragma unroll
        for (int ai = 0; ai < 2; ++ai)
#pragma unroll
            for (int m = 0; m < 4; ++m) { bf16_t* rp = base + (size_t)(ai * HALF + m * 16) * 1024;
#pragma unroll
                for (int bj = 0; bj < 2; ++bj)
#pragma unroll
                    for (int n = 0; n < 2; ++n) *(u32x2*)(rp + bj * HALF + n * 16) = pk4(acc[ai][bj][m][n]);
                EPI_FENCE(); }
    }
};

template <int KS>
__device__ __forceinline__ void small_gemm_item(const bf16_t* A, int lda, const bf16_t* Bt, int ldb, float* OS, int nc, int ksp, const float* ss) {
    int tid = threadIdx.x; asm volatile("" : "+v"(tid));
    const int wid = tid >> 6, lane = tid & 63, fr = lane & 15, fq = lane >> 4;
    const int k0 = ksp * KS * 32, n0 = nc * 32, row = 16 * wid + fr;
    const bf16_t* ap = A + (size_t)row * lda + k0 + 8 * fq; const bf16_t* bp = Bt + (size_t)(n0 + fr) * ldb + k0 + 8 * fq;
    bf16x8 af[KS], b0[KS], b1[KS];
#pragma unroll
    for (int ks = 0; ks < KS; ++ks) { af[ks] = *(const bf16x8*)(ap + 32 * ks); b0[ks] = *(const bf16x8*)(bp + 32 * ks); b1[ks] = *(const bf16x8*)(bp + (size_t)16 * ldb + 32 * ks); }
    __builtin_amdgcn_sched_barrier(0);
    f32x4 c0 = {0.f, 0.f, 0.f, 0.f}, c1 = {0.f, 0.f, 0.f, 0.f};
#pragma unroll
    for (int ks = 0; ks < KS; ++ks) { c0 = __builtin_amdgcn_mfma_f32_16x16x32_bf16(b0[ks], af[ks], c0, 0, 0, 0); c1 = __builtin_amdgcn_mfma_f32_16x16x32_bf16(b1[ks], af[ks], c1, 0, 0, 0); }
    float sc = 1.0f; if (ss) sc = rsqrtf(ss[row] * (1.0f / 1024.0f) + EPS_);
    float* op = OS + (size_t)ksp * 131072 + (size_t)row * 1024 + n0 + 4 * fq;
    *(f32x4*)op = c0 * sc; *(f32x4*)(op + 16) = c1 * sc;
}

struct Epi3 {
    bf16_t* FIN; const float* fcw; const float* fcb; const float* sfc; float* out;
    __device__ __forceinline__ void operator()(const AccT& acc, const Unit& u, int wr, int wc, int fr, int fq) const {
        const bool sample = (u.pm == 66);
        const int tau = sample ? 16386 : 252 * u.pm;
        const int tb = tau + 126 * wr + 8 * fr - 2;
        const int j0 = 128 * u.pn + 32 * wc + 4 * fq;
#pragma unroll
        for (int n = 0; n < 2; ++n) {
            const int j = j0 + 16 * n; const float* wp = fcw + j; const float* bp = fcb + j;
            const f32x4 gw0 = *(const f32x4*)(wp), gw1 = *(const f32x4*)(wp + 5632), gw2 = *(const f32x4*)(wp + 2 * 5632), gb = *(const f32x4*)(bp);
            const f32x4 vw0 = *(const f32x4*)(wp + 2816), vw1 = *(const f32x4*)(wp + 5632 + 2816), vw2 = *(const f32x4*)(wp + 2 * 5632 + 2816), vb = *(const f32x4*)(bp + 2816);
            EPI_FENCE();
            if (!sample) {
                f32x4 g2, g1, v2, v1;
#pragma unroll
                for (int e = 0; e < 4; ++e) { g2[e] = __shfl_up(acc[1][0][2][n][e], 1, 16); g1[e] = __shfl_up(acc[1][0][3][n][e], 1, 16);
                                              v2[e] = __shfl_up(acc[1][1][2][n][e], 1, 16); v1[e] = __shfl_up(acc[1][1][3][n][e], 1, 16); }
                bf16_t* fp = FIN + (size_t)tb * 2816 + j;
#pragma unroll
                for (int s = 0; s < 8; ++s) {
                    const f32x4 g0 = acc[s >> 2][0][s & 3][n], v0 = acc[s >> 2][1][s & 3][n];
                    const int t = tb + s;
                    const bool valid = !(fr == 0 && s < 2) && t < T_;
                    if (valid) {
                        const f32x4 yg = gw0 * g2 + gw1 * g1 + gw2 * g0 + gb, yv = vw0 * v2 + vw1 * v1 + vw2 * v0 + vb;
                        u32x2 w; w.x = cvt_pk_bf16(gelu_t(yg[0]) * yv[0], gelu_t(yg[1]) * yv[1]); w.y = cvt_pk_bf16(gelu_t(yg[2]) * yv[2], gelu_t(yg[3]) * yv[3]);
                        *(u32x2*)(fp) = w;
                    }
                    g2 = g1; g1 = g0; v2 = v1; v1 = v0; fp += 2816;
                    EPI_FENCE();
                }
                if (u.pm == 65 && wr == 0 && fr == 0) {
                    float* ob = out + O_FP + j;
                    *(f32x4*)(ob) = acc[1][0][0][n]; *(f32x4*)(ob + 2816) = acc[1][1][0][n];
                    *(f32x4*)(ob + 5632) = acc[1][0][1][n]; *(f32x4*)(ob + 5632 + 2816) = acc[1][1][1][n];
                }
            } else if (wr == 0) {
                const float* sp = sfc + (size_t)(8 * fr) * 11264 + j; bf16_t* fp = FIN + (size_t)(T_ + 8 * fr) * 2816 + j; float* ob = out + O_FS + (size_t)(8 * fr) * 11264 + 5632 + j;
#pragma unroll
                for (int s = 0; s < 8; ++s) {
                    const f32x4 g0 = acc[s >> 2][0][s & 3][n], v0 = acc[s >> 2][1][s & 3][n];
                    const f32x4 sg0 = *(const f32x4*)(sp), sg1 = *(const f32x4*)(sp + 5632), sv0 = *(const f32x4*)(sp + 2816), sv1 = *(const f32x4*)(sp + 5632 + 2816);
                    const f32x4 yg = gw0 * sg0 + gw1 * sg1 + gw2 * g0 + gb, yv = vw0 * sv0 + vw1 * sv1 + vw2 * v0 + vb;
                    u32x2 w; w.x = cvt_pk_bf16(gelu_t(yg[0]) * yv[0], gelu_t(yg[1]) * yv[1]); w.y = cvt_pk_bf16(gelu_t(yg[2]) * yv[2], gelu_t(yg[3]) * yv[3]);
                    *(u32x2*)(fp) = w;
                    *(f32x4*)(ob) = g0; *(f32x4*)(ob + 2816) = v0;
                    sp += 11264; fp += 2816; ob += 11264;
                    EPI_FENCE();
                }
            }
            EPI_FENCE();
        }
    }
};

__device__ __forceinline__ void tr_tile(float* tl, const float* W, int ldw, bf16_t* Wt, int ldt, int k0, int n0, int dn0, const float* ks0, const float* ks1) {
    int tid = threadIdx.x; asm volatile("" : "+v"(tid));
    { const int r = tid >> 4, c4 = (tid & 15) * 4;
#pragma unroll
      for (int p = 0; p < 2; ++p) { const int row = p * 32 + r; const f32x4 v = *(const f32x4*)(W + (size_t)(k0 + row) * ldw + n0 + c4);
          float sc = 1.f; if (ks0) { const int k = k0 + row; sc = k < 1024 ? ks0[k] : ks1[k - 1024]; }
          tl[row * 65 + c4 + 0] = v[0] * sc; tl[row * 65 + c4 + 1] = v[1] * sc; tl[row * 65 + c4 + 2] = v[2] * sc; tl[row * 65 + c4 + 3] = v[3] * sc; } }
    __syncthreads();
    { const int n = tid >> 3, kc = (tid & 7) * 8; float f[8];
#pragma unroll
      for (int i = 0; i < 8; ++i) f[i] = tl[(kc + i) * 65 + n];
      u32x4 w; w.x = cvt_pk_bf16(f[0], f[1]); w.y = cvt_pk_bf16(f[2], f[3]); w.z = cvt_pk_bf16(f[4], f[5]); w.w = cvt_pk_bf16(f[6], f[7]);
      *(u32x4*)(Wt + (size_t)(dn0 + n) * ldt + k0 + kc) = w; }
    __syncthreads();
}

__device__ __forceinline__ void tr_group(float* tl, const float* W, int ldw, bf16_t* Wt, int ldt, int k0, int nbase, int mode, const float* ks0, const float* ks1) {
    int tid = threadIdx.x; asm volatile("" : "+v"(tid));
    { const int r = tid >> 4, c4 = (tid & 15) * 4; f32x4 v[4][2];
#pragma unroll
      for (int j = 0; j < 4; ++j)
#pragma unroll
          for (int p = 0; p < 2; ++p) v[j][p] = __builtin_nontemporal_load((const f32x4*)(W + (size_t)(k0 + p * 32 + r) * ldw + nbase + 64 * j + c4));
#pragma unroll
      for (int p = 0; p < 2; ++p) { const int row = p * 32 + r; float sc = 1.f; if (ks0) { const int k = k0 + row; sc = k < 1024 ? ks0[k] : ks1[k - 1024]; }
#pragma unroll
          for (int j = 0; j < 4; ++j) { float* t = tl + j * 4160 + row * 65 + c4; t[0] = v[j][p][0] * sc; t[1] = v[j][p][1] * sc; t[2] = v[j][p][2] * sc; t[3] = v[j][p][3] * sc; } } }
    __syncthreads();
    { const int n = tid >> 3, kc = (tid & 7) * 8;
#pragma unroll
      for (int j = 0; j < 4; ++j) { float f[8];
#pragma unroll
          for (int i = 0; i < 8; ++i) f[i] = tl[j * 4160 + (kc + i) * 65 + n];
          const int n0 = nbase + 64 * j; int dn0 = n0;
          if (mode == 1) dn0 = n0 < 2816 ? ((n0 >> 7) * 256 + (n0 & 127)) : ((((n0 - 2816) >> 7) * 256) + 128 + ((n0 - 2816) & 127));
          u32x4 w; w.x = cvt_pk_bf16(f[0], f[1]); w.y = cvt_pk_bf16(f[2], f[3]); w.z = cvt_pk_bf16(f[4], f[5]); w.w = cvt_pk_bf16(f[6], f[7]);
          *(u32x4*)(Wt + (size_t)(dn0 + n) * ldt + k0 + kc) = w; } }
    __syncthreads();
}

__device__ void phase0(const Params& P, float* ldsf) {
    char* ws = P.ws; const int G = gridDim.x, bid = blockIdx.x; int tid = threadIdx.x; asm volatile("" : "+v"(tid));
    for (int idx = bid; idx < 16 * 24; idx += G) { const int ng = idx % 24, kt = idx / 24;
        tr_group(ldsf, P.in[I_WADA], 6144, (bf16_t*)(ws + OFF_WT_ADA), 1024, kt * 64, ng * 256, 0, nullptr, nullptr); }
    const size_t gt = (size_t)bid * 512 + tid, gs = (size_t)G * 512;
    { bf16_t* A = (bf16_t*)(ws + OFF_A_ADA);
      for (size_t i = gt; i < (size_t)256 * 1024; i += gs) { const int r = (int)(i >> 10), c = (int)(i & 1023); float v = 0.f;
          if (r == 0) v = P.in[I_CP][c]; else if (r <= 128) v = P.in[I_CS][(size_t)(r - 1) * 1024 + c];
          A[i] = f2bf(v * sigmoid_f(v)); } }
    { float* sp = (float*)(ws + OFF_SP8); for (size_t i = gt; i < 1024; i += gs) sp[i] = 8.0f * log1pf(expf(-P.in[I_LAM][i])); }
    { float* ss = (float*)(ws + OFF_SS); for (size_t i = gt; i < (size_t)4 * MP_; i += gs) ss[i] = 0.f; }
    { float* __restrict__ o = P.out + O_CS; const float* __restrict__ s = P.in[I_SC];
#pragma unroll 4
      for (size_t i = gt; i < (size_t)128 * 2048; i += gs) { const size_t b = i >> 11, r = i & 2047; o[b * 3072 + r] = s[b * 3072 + 1024 + r]; } }
    { float* __restrict__ o = P.out + O_FS; const float* __restrict__ s = P.in[I_SF];
#pragma unroll 8
      for (size_t i = gt; i < (size_t)128 * 5632; i += gs) { const size_t b = i / 5632, r = i % 5632; o[b * 11264 + r] = s[b * 11264 + 5632 + r]; } }
    { unsigned* z = (unsigned*)(ws + OFF_HM0); for (size_t i = gt; i < 1024; i += gs) z[i] = 0u; }
}

__device__ void phase1(const Params& P, LAS unsigned char* lds, float* ldsf) {
    char* ws = P.ws; const int G = gridDim.x, bid = blockIdx.x;
    { Gemm g{(const bf16_t*)(ws + OFF_A_ADA), (const bf16_t*)(ws + OFF_WT_ADA), 1024}; Sched S; S.init(1, 24, G, bid);
      EpiAda E{(float*)(ws + OFF_MOD), P.in[I_BADA]}; gemm_phase<EpiAda, false, false>(lds, g, S, E); }
    __syncthreads();
    int wk, nw; if (G > 48) { if (bid < 24) return; wk = bid - 24; nw = G - 24; } else { wk = bid; nw = G; }
    for (int idx = wk; idx < 944; idx += nw) {
        if (idx < 224) { const int ng = idx % 14, kt = idx / 14; tr_group(ldsf, P.in[I_WIN], 3584, (bf16_t*)(ws + OFF_WT_IN), 1024, kt * 64, ng * 256, 0, nullptr, nullptr); }
        else if (idx < 352) { const int i2 = idx - 224, ng = i2 & 3, kt = i2 >> 2; tr_group(ldsf, P.in[I_WOUT], 1024, (bf16_t*)(ws + OFF_WT_OUT), 2048, kt * 64, ng * 256, 0, P.in[I_GAO], P.in[I_GRO]); }
        else if (idx < 704) { const int i2 = idx - 352, ng = i2 % 22, kt = i2 / 22; tr_group(ldsf, P.in[I_WUP], 5632, (bf16_t*)(ws + OFF_WT_UP), 1024, kt * 64, ng * 256, 1, nullptr, nullptr); }
        else if (idx < 880) { const int i2 = idx - 704, ng = i2 & 3, kt = i2 >> 2; tr_group(ldsf, P.in[I_WDOWN], 1024, (bf16_t*)(ws + OFF_WT_DOWN), 2816, kt * 64, ng * 256, 0, nullptr, nullptr); }
        else { const int i2 = (idx - 880) & 31, blk = i2 >> 2, kt = (i2 >> 1) & 1, ntile = i2 & 1; const bool isA = idx < 912;
            tr_tile(ldsf, P.in[isA ? I_WA : I_WI] + (size_t)blk * 16384, 128, (bf16_t*)(ws + (isA ? OFF_WT_A : OFF_WT_I)) + (size_t)blk * 16384, 128, kt * 64, ntile * 64, ntile * 64, nullptr, nullptr); }
    }
}

constexpr int NBR = 4;
__device__ __forceinline__ const float* xrow(const Params& P, int r) { return r < T_ ? P.in[I_XP] + (size_t)r * 1024 : P.in[I_XS] + (size_t)(r - T_) * 1024; }
constexpr int NB2 = 8;
template <bool PO>
__device__ __forceinline__ void phase2_batch(const Params& P, int r0, int nw, int lane) {
    char* ws = P.ws; const float* MOD = (const float*)(ws + OFF_MOD); bf16_t* H = (bf16_t*)(ws + OFF_HM);
    f32x4 v[NB2][4]; float ss[NB2];
#pragma unroll
    for (int b = 0; b < NB2; ++b) { const int r = r0 + b * nw; ss[b] = 0.f;
        if (PO || r < MR_) { const float* x = xrow(P, r);
#pragma unroll
            for (int i = 0; i < 4; ++i) v[b][i] = __builtin_nontemporal_load((const f32x4*)(x + i * 256 + lane * 4)); }
        else {
#pragma unroll
            for (int i = 0; i < 4; ++i) v[b][i] = (f32x4){0.f, 0.f, 0.f, 0.f}; } }
#pragma unroll
    for (int b = 0; b < NB2; ++b) {
#pragma unroll
        for (int i = 0; i < 4; ++i) ss[b] += (v[b][i][0] * v[b][i][0] + v[b][i][1] * v[b][i][1]) + (v[b][i][2] * v[b][i][2] + v[b][i][3] * v[b][i][3]);
        ss[b] = wave_sum(ss[b]); }
#pragma unroll
    for (int b = 0; b < NB2; ++b) { const int r = r0 + b * nw; if (!PO && r >= MP_) continue;
        if (!PO && r >= MR_) { for (int i = 0; i < 4; ++i) *(u32x2*)(H + (size_t)r * 1024 + i * 256 + lane * 4) = (u32x2){0u, 0u}; continue; }
        const float* md = MOD + (size_t)modrow(r) * 6144; const float rs = rsqrtf(ss[b] * (1.0f / 1024.0f) + EPS_);
#pragma unroll
        for (int i = 0; i < 4; ++i) { const int c = i * 256 + lane * 4; const f32x4 g = *(const f32x4*)(P.in[I_GPM] + c), sh = *(const f32x4*)(md + c), sc = *(const f32x4*)(md + 1024 + c);
            __builtin_nontemporal_store(pk4((v[b][i] * rs * g) * (sc + 1.0f) + sh), (u32x2*)(H + (size_t)r * 1024 + c)); } }
}
__device__ void phase2(const Params& P) {
    int tid = threadIdx.x; asm volatile("" : "+v"(tid));
    const int wid = __builtin_amdgcn_readfirstlane(tid >> 6), lane = tid & 63;
    const int nw = gridDim.x * 8;
    for (int r0 = blockIdx.x * 8 + wid; r0 < MP_; r0 += nw * NB2) {
        if (r0 + (NB2 - 1) * nw < T_) phase2_batch<true>(P, r0, nw, lane); else phase2_batch<false>(P, r0, nw, lane);
    }
}

__device__ __forceinline__ int crow(int r, int hi) { return (r & 3) + 8 * (r >> 2) + 4 * hi; }
__device__ void attn_prompt_item(const Params& P, char* lds, int qb, int kv) {
    char* ws = P.ws; bf16_t* MIX = (bf16_t*)(ws + OFF_MIX); const bf16_t* KB = (const bf16_t*)(ws + OFF_KB); const bf16_t* VT = (const bf16_t*)(ws + OFF_VT); float* SSA = (float*)(ws + OFF_SS);
    bf16_t* Ks = (bf16_t*)lds; bf16_t* Vs = (bf16_t*)(lds + 256 * 136 * 2);
    int tid = threadIdx.x; asm volatile("" : "+v"(tid));
    const int wid = tid >> 6, lane = tid & 63; int r32 = lane & 31, hi = lane >> 5;
    const int tbase = 128 * (qb - 1);
    if (qb > 0) {
        u32x4 kv_[8], vv_[8];
#pragma unroll
        for (int i = 0; i < 8; ++i) { const int id = i * 512 + tid; kv_[i] = *(const u32x4*)(KB + (size_t)(tbase + (id >> 4)) * 256 + kv * 128 + (id & 15) * 8);
            vv_[i] = *(const u32x4*)(VT + (size_t)(kv * 128 + (id >> 5)) * T_ + tbase + (id & 31) * 8); }
#pragma unroll
        for (int i = 0; i < 8; ++i) { const int id = i * 512 + tid; *(u32x4*)(Ks + (id >> 4) * 136 + (id & 15) * 8) = kv_[i];
            u32x2* dst = (u32x2*)(Vs + (id >> 5) * 260 + (id & 31) * 8); dst[0] = (u32x2){vv_[i].x, vv_[i].y}; dst[1] = (u32x2){vv_[i].z, vv_[i].w}; }
    } else {
#pragma unroll
        for (int i = 0; i < 8; ++i) { const int id = i * 512 + tid, row = id >> 4, c = id & 15; const int t = tbase + row;
            u32x4 v = {0u, 0u, 0u, 0u}; if (t >= 0) v = *(const u32x4*)(KB + (size_t)t * 256 + kv * 128 + c * 8);
            *(u32x4*)(Ks + row * 136 + c * 8) = v; }
#pragma unroll
        for (int i = 0; i < 8; ++i) { const int id = i * 512 + tid, d = id >> 5, c = id & 31; const int t = tbase + c * 8;
            u32x4 v = {0u, 0u, 0u, 0u}; if (t >= 0) v = *(const u32x4*)(VT + (size_t)(kv * 128 + d) * T_ + t);
            u32x2* dst = (u32x2*)(Vs + d * 260 + c * 8); dst[0] = (u32x2){v.x, v.y}; dst[1] = (u32x2){v.z, v.w}; }
    }
    __syncthreads();
#pragma unroll 1
    for (int it = 0; it < 2; ++it) {
        asm volatile("" : "+v"(r32), "+v"(hi));
        const int tile = wid + 8 * it, g = tile >> 2, w4 = tile & 3, head = kv * 4 + g;
        const int trow = 128 * qb + 32 * w4 + r32;
        bf16_t* qp = MIX + (size_t)trow * 2048 + head * 128;
        bf16x8 qr[8];
#pragma unroll
        for (int d0 = 0; d0 < 8; ++d0) qr[d0] = *(const bf16x8*)(qp + d0 * 16 + hi * 8);
        f32x16 p[5];
#pragma unroll
        for (int kt = 0; kt < 5; ++kt) {
            f32x16 a = {};
            const bf16_t* kp = Ks + (32 * (w4 + kt) + r32) * 136 + hi * 8;
#pragma unroll
            for (int d0 = 0; d0 < 8; ++d0) { const bf16x8 kf = *(const bf16x8*)(kp + d0 * 16); a = __builtin_amdgcn_mfma_f32_32x32x16_bf16(kf, qr[d0], a, 0, 0, 0); }
            p[kt] = a;
            EPI_FENCE();
        }
        const float slope2 = __builtin_amdgcn_exp2f(-(float)(head + 1)) * LOG2E_, sink2 = P.in[I_SINK][head] * LOG2E_;
        float mx = sink2;
#pragma unroll
        for (int kt = 0; kt < 5; ++kt)
#pragma unroll
            for (int r = 0; r < 16; ++r) { const int c = crow(r, hi); const int dist = 128 + r32 - 32 * kt - c; const int jb = 32 * (w4 + kt) + c;
                const bool valid = ((unsigned)dist < 128u) && (qb > 0 || jb >= 128);
                const float s = valid ? p[kt][r] - slope2 * (float)dist : -__builtin_inff(); p[kt][r] = s; mx = fmaxf(mx, s); }
        mx = fmaxf(mx, __shfl_xor(mx, 32));
        float l = 0.f;
        u32x4 pb[5][2];
#pragma unroll
        for (int kt = 0; kt < 5; ++kt) {
            float e[16];
#pragma unroll
            for (int r = 0; r < 16; ++r) { e[r] = __builtin_amdgcn_exp2f(p[kt][r] - mx); l += e[r]; }
#pragma unroll
            for (int s2 = 0; s2 < 2; ++s2) { pb[kt][s2].x = cvt_pk_bf16(e[8 * s2 + 0], e[8 * s2 + 1]); pb[kt][s2].y = cvt_pk_bf16(e[8 * s2 + 2], e[8 * s2 + 3]);
                pb[kt][s2].z = cvt_pk_bf16(e[8 * s2 + 4], e[8 * s2 + 5]); pb[kt][s2].w = cvt_pk_bf16(e[8 * s2 + 6], e[8 * s2 + 7]); }
        }
        l += __shfl_xor(l, 32); l += __builtin_amdgcn_exp2f(sink2 - mx);
        EPI_FENCE();
        f32x16 o[4] = {};
#pragma unroll
        for (int kt = 0; kt < 5; ++kt)
#pragma unroll
            for (int s2 = 0; s2 < 2; ++s2) {
                const bf16x8 pf = *reinterpret_cast<const bf16x8*>(&pb[kt][s2]);
#pragma unroll
                for (int db = 0; db < 4; ++db) { const bf16_t* vp = Vs + (32 * db + r32) * 260 + 32 * (w4 + kt) + 16 * s2 + 4 * hi;
                    const u32x2 lo = *(const u32x2*)vp, hh = *(const u32x2*)(vp + 8); u32x4 vw = {lo.x, lo.y, hh.x, hh.y};
                    o[db] = __builtin_amdgcn_mfma_f32_32x32x16_bf16(*reinterpret_cast<const bf16x8*>(&vw), pf, o[db], 0, 0, 0); }
                EPI_FENCE();
            }
        const float inv = 1.0f / l; float ss = 0.f;
#pragma unroll
        for (int db = 0; db < 4; ++db)
#pragma unroll
            for (int r4 = 0; r4 < 4; ++r4) { const float a = o[db][4 * r4] * inv, b = o[db][4 * r4 + 1] * inv, c = o[db][4 * r4 + 2] * inv, d = o[db][4 * r4 + 3] * inv;
                ss += (a * a + b * b) + (c * c + d * d); u32x2 w; w.x = cvt_pk_bf16(a, b); w.y = cvt_pk_bf16(c, d);
                *(u32x2*)(qp + 32 * db + 8 * r4 + 4 * hi) = w; }
        ss += __shfl_xor(ss, 32);
        if (hi == 0) atomicAdd(SSA + trow, ss);
    }
    __syncthreads();
}

__device__ void attn_sample_item(const Params& P, char* lds, int b, int kv) {
    char* ws = P.ws; bf16_t* MIX = (bf16_t*)(ws + OFF_MIX); const bf16_t* KB = (const bf16_t*)(ws + OFF_KB); const bf16_t* VSB = (const bf16_t*)(ws + OFF_VSB); float* SSA = (float*)(ws + OFF_SS);
    float* Kf = (float*)lds; float* Vf = Kf + 128 * 129; float* qs = Vf + 128 * 129; float* ps = qs + 512; float* red = ps + 512;
    int tid = threadIdx.x; asm volatile("" : "+v"(tid));
    const int g = tid >> 7, jd = tid & 127, head = kv * 4 + g;
    bf16_t* qp = MIX + (size_t)(T_ + b) * 2048 + head * 128;
    qs[tid] = bf2f(qp[jd]);
    { f32x4 kk[8], vv[8];
#pragma unroll
      for (int i = 0; i < 8; ++i) { const int id = i * 512 + tid, j = id >> 5, c4 = (id & 31) * 4;
          if (j < 127) { const size_t src = ((size_t)(b * 128 + j + 1) * 2 + kv) * 128 + c4; kk[i] = __builtin_nontemporal_load((const f32x4*)(P.in[I_CK] + src)); vv[i] = __builtin_nontemporal_load((const f32x4*)(P.in[I_CV] + src)); }
          else { const u32x2 kw = *(const u32x2*)(KB + (size_t)(T_ + b) * 256 + kv * 128 + c4), vw = *(const u32x2*)(VSB + (size_t)b * 256 + kv * 128 + c4);
              kk[i] = (f32x4){bflo(kw.x), bfhi(kw.x), bflo(kw.y), bfhi(kw.y)}; vv[i] = (f32x4){bflo(vw.x), bfhi(vw.x), bflo(vw.y), bfhi(vw.y)}; } }
#pragma unroll
      for (int i = 0; i < 8; ++i) { const int id = i * 512 + tid, j = id >> 5, c4 = (id & 31) * 4;
          const size_t dst = ((size_t)(b * 128 + j) * 2 + kv) * 128 + c4; __builtin_nontemporal_store(kk[i], (f32x4*)(P.out + O_KS + dst)); __builtin_nontemporal_store(vv[i], (f32x4*)(P.out + O_VS + dst));
#pragma unroll
          for (int e = 0; e < 4; ++e) { Kf[j * 129 + c4 + e] = kk[i][e]; Vf[j * 129 + c4 + e] = vv[i][e]; } } }
    __syncthreads();
    const float slope2 = __builtin_amdgcn_exp2f(-(float)(head + 1)) * LOG2E_, sink2 = P.in[I_SINK][head] * LOG2E_;
    float s = 0.f;
    for (int d = 0; d < 128; ++d) s += qs[g * 128 + d] * Kf[jd * 129 + d];
    s -= slope2 * (float)(127 - jd);
    ps[tid] = s;
    __syncthreads();
    float mx = sink2; for (int j = 0; j < 128; ++j) mx = fmaxf(mx, ps[g * 128 + j]);
    const float e = __builtin_amdgcn_exp2f(s - mx);
    __syncthreads();
    ps[tid] = e;
    __syncthreads();
    float l = __builtin_amdgcn_exp2f(sink2 - mx); for (int j = 0; j < 128; ++j) l += ps[g * 128 + j];
    float o = 0.f;
    for (int j = 0; j < 128; ++j) o += ps[g * 128 + j] * Vf[j * 129 + jd];
    o /= l;
    qp[jd] = f2bf(o);
    const float ss = wave_sum(o * o);
    if ((tid & 63) == 0) atomicAdd(SSA + T_ + b, ss);
    (void)red;
    __syncthreads();
}

template <bool SAMPLE>
__device__ void rnn1_item(const Params& P, char* lds, int tile, int nb, int rg) {
    char* ws = P.ws; constexpr bool sample = SAMPLE;
    const bf16_t* XR = (const bf16_t*)(ws + OFF_XR); bf16_t* MIX = (bf16_t*)(ws + OFF_MIX); bf16_t* LAT = (bf16_t*)(ws + OFF_HM); bf16_t* UT = (bf16_t*)(ws + OFF_U);
    const float* SP8 = (const float*)(ws + OFF_SP8); float* SSR = (float*)(ws + OFF_SS) + MP_;
    bf16_t* XC = (bf16_t*)lds; bf16_t* WA = XC + 128 * 136; bf16_t* WI = WA + 128 * 136;
    float* As = (float*)lds; float* Us = As + 128 * 129; float* sgA = Us + 128 * 129; float* sgE = sgA + 512; float* bl = sgE + 512;
    int tid = threadIdx.x; asm volatile("" : "+v"(tid));
    const int wid = tid >> 6, lane = tid & 63, fr = lane & 15, fq = lane >> 4;
    const int t0 = tile * 128, ch0 = nb * 128;
    float blv = 0.f; if (tid < 384) blv = tid < 128 ? P.in[I_BA][ch0 + tid] : (tid < 256 ? P.in[I_BI][ch0 + tid - 128] : SP8[ch0 + tid - 256]);
    if (!sample) {
        const int c8 = (tid & 15) * 8, ch = ch0 + c8;
        u32x4 xv[4][4];
        if (tile > 0) {
#pragma unroll
            for (int i = 0; i < 4; ++i)
#pragma unroll
                for (int k = 0; k < 4; ++k) xv[i][k] = *(const u32x4*)(XR + (size_t)(t0 + i * 32 + (tid >> 4) - 3 + k) * 1024 + ch);
        } else {
#pragma unroll
            for (int i = 0; i < 4; ++i)
#pragma unroll
                for (int k = 0; k < 4; ++k) { const int tt = i * 32 + (tid >> 4) - 3 + k; xv[i][k] = (u32x4){0u, 0u, 0u, 0u}; if (tt >= 0) xv[i][k] = *(const u32x4*)(XR + (size_t)tt * 1024 + ch); }
        }
        f32x4 cw[4][2], cb[2];
#pragma unroll
        for (int k = 0; k < 4; ++k) { cw[k][0] = *(const f32x4*)(P.in[I_CW] + k * 1024 + ch); cw[k][1] = *(const f32x4*)(P.in[I_CW] + k * 1024 + ch + 4); }
        cb[0] = *(const f32x4*)(P.in[I_CB] + ch); cb[1] = *(const f32x4*)(P.in[I_CB] + ch + 4);
#pragma unroll
        for (int i = 0; i < 4; ++i) { const int row = i * 32 + (tid >> 4);
            f32x4 x0 = cb[0], x1 = cb[1];
#pragma unroll
            for (int k = 0; k < 4; ++k) { const u32x4 v = xv[i][k];
                x0 += cw[k][0] * (f32x4){bflo(v.x), bfhi(v.x), bflo(v.y), bfhi(v.y)}; x1 += cw[k][1] * (f32x4){bflo(v.z), bfhi(v.z), bflo(v.w), bfhi(v.w)}; }
            u32x4 w; w.x = cvt_pk_bf16(x0[0], x0[1]); w.y = cvt_pk_bf16(x0[2], x0[3]); w.z = cvt_pk_bf16(x1[0], x1[1]); w.w = cvt_pk_bf16(x1[2], x1[3]);
            *(u32x4*)(XC + row * 136 + c8) = w; }
    } else if (tid < 256) {
        const int row = tid >> 4, c8 = (tid & 15) * 8, ch = ch0 + c8, b = 16 * rg + row;
        float xc[8];
        { const f32x4 b0 = *(const f32x4*)(P.in[I_CB] + ch), b1 = *(const f32x4*)(P.in[I_CB] + ch + 4);
          xc[0] = b0[0]; xc[1] = b0[1]; xc[2] = b0[2]; xc[3] = b0[3]; xc[4] = b1[0]; xc[5] = b1[1]; xc[6] = b1[2]; xc[7] = b1[3]; }
#pragma unroll
        for (int k = 0; k < 3; ++k) { const float* sp = P.in[I_SC] + (size_t)b * 3072 + k * 1024 + ch; const f32x4 x0 = *(const f32x4*)sp, x1 = *(const f32x4*)(sp + 4);
            const f32x4 w0 = *(const f32x4*)(P.in[I_CW] + k * 1024 + ch), w1 = *(const f32x4*)(P.in[I_CW] + k * 1024 + ch + 4);
#pragma unroll
            for (int e = 0; e < 4; ++e) { xc[e] += w0[e] * x0[e]; xc[4 + e] += w1[e] * x1[e]; } }
        { const u32x4 v = *(const u32x4*)(XR + (size_t)(T_ + b) * 1024 + ch);
          const f32x4 x0 = {bflo(v.x), bfhi(v.x), bflo(v.y), bfhi(v.y)}, x1 = {bflo(v.z), bfhi(v.z), bflo(v.w), bfhi(v.w)};
          float* oc = P.out + O_CS + (size_t)b * 3072 + 2048 + ch; *(f32x4*)oc = x0; *(f32x4*)(oc + 4) = x1;
          const f32x4 w0 = *(const f32x4*)(P.in[I_CW] + 3 * 1024 + ch), w1 = *(const f32x4*)(P.in[I_CW] + 3 * 1024 + ch + 4);
#pragma unroll
          for (int e = 0; e < 4; ++e) { xc[e] += w0[e] * x0[e]; xc[4 + e] += w1[e] * x1[e]; } }
        u32x4 w; w.x = cvt_pk_bf16(xc[0], xc[1]); w.y = cvt_pk_bf16(xc[2], xc[3]); w.z = cvt_pk_bf16(xc[4], xc[5]); w.w = cvt_pk_bf16(xc[6], xc[7]);
        *(u32x4*)(XC + row * 136 + c8) = w;
    }
    if (tid < 384) bl[tid] = blv;
    { u32x4 wa_[4], wi_[4];
#pragma unroll
      for (int i = 0; i < 4; ++i) { const int id = i * 512 + tid; wa_[i] = *(const u32x4*)((const bf16_t*)(ws + OFF_WT_A) + (size_t)nb * 16384 + id * 8); wi_[i] = *(const u32x4*)((const bf16_t*)(ws + OFF_WT_I) + (size_t)nb * 16384 + id * 8); }
#pragma unroll
      for (int i = 0; i < 4; ++i) { const int id = i * 512 + tid, d = id >> 4, c8 = (id & 15) * 8; *(u32x4*)(WA + d * 136 + c8) = wa_[i]; *(u32x4*)(WI + d * 136 + c8) = wi_[i]; } }
    __syncthreads();
    constexpr bool active = true;
    constexpr int NT = SAMPLE ? 1 : 8;
    const int dofs = SAMPLE ? 16 * wid : 0;
    const int row = SAMPLE ? fr : 16 * wid + fr;
    f32x4 aa[NT], ai[NT]; u32x2 xcw[NT];
    if (active) {
        bf16x8 xf[4];
#pragma unroll
        for (int ks = 0; ks < 4; ++ks) xf[ks] = *(const bf16x8*)(XC + row * 136 + 32 * ks + 8 * fq);
#pragma unroll
        for (int nt = 0; nt < NT; ++nt) { f32x4 a = {0.f, 0.f, 0.f, 0.f}, b = {0.f, 0.f, 0.f, 0.f};
#pragma unroll
            for (int ks = 0; ks < 4; ++ks) { const bf16x8 wa = *(const bf16x8*)(WA + (dofs + 16 * nt + fr) * 136 + 32 * ks + 8 * fq), wi = *(const bf16x8*)(WI + (dofs + 16 * nt + fr) * 136 + 32 * ks + 8 * fq);
                a = __builtin_amdgcn_mfma_f32_16x16x32_bf16(wa, xf[ks], a, 0, 0, 0); b = __builtin_amdgcn_mfma_f32_16x16x32_bf16(wi, xf[ks], b, 0, 0, 0); }
            aa[nt] = a; ai[nt] = b; xcw[nt] = *(const u32x2*)(XC + row * 136 + dofs + 16 * nt + 4 * fq); }
    }
    __syncthreads();
    if (active) {
        float ssr = 0.f; const int brow = 16 * rg + fr;
#pragma unroll
        for (int nt = 0; nt < NT; ++nt) { const int d = dofs + 16 * nt + 4 * fq, ch = ch0 + d;
            const f32x4 ba = *(const f32x4*)(bl + d), bi = *(const f32x4*)(bl + 128 + d), sp = *(const f32x4*)(bl + 256 + d);
            const float xv[4] = {bflo(xcw[nt].x), bfhi(xcw[nt].x), bflo(xcw[nt].y), bfhi(xcw[nt].y)};
            float la[4], uu[4], av[4];
#pragma unroll
            for (int e = 0; e < 4; ++e) { const float r = sigmoid_f(aa[nt][e] + ba[e]), ig = sigmoid_f(ai[nt][e] + bi[e]);
                la[e] = -r * sp[e]; av[e] = __builtin_amdgcn_exp2f(LOG2E_ * la[e]);
                const float x2 = 2.0f * la[e];
                const float pol = -x2 * (1.0f + x2 * 0.5f * (1.0f + x2 * (1.0f / 3.0f) * (1.0f + x2 * 0.25f * (1.0f + x2 * 0.2f))));
                const float em = x2 > -0.25f ? pol : 1.0f - av[e] * av[e];
                uu[e] = __builtin_amdgcn_sqrtf(fmaxf(em, 0.f)) * (ig * xv[e]); }
            if (!sample) {
#pragma unroll
                for (int e = 0; e < 4; ++e) { As[row * 129 + d + e] = la[e]; Us[row * 129 + d + e] = uu[e]; }
            } else {
                const f32x4 h0 = *(const f32x4*)(P.in[I_SH] + (size_t)brow * 1024 + ch);
                bf16_t* gp = MIX + (size_t)(T_ + brow) * 2048 + 1024 + ch; const u32x2 gw = *(const u32x2*)gp; const float gy[4] = {bflo(gw.x), bfhi(gw.x), bflo(gw.y), bfhi(gw.y)};
                f32x4 h; float rn[4];
#pragma unroll
                for (int e = 0; e < 4; ++e) { h[e] = av[e] * h0[e] + uu[e]; rn[e] = h[e] * gy[e]; ssr += rn[e] * rn[e]; }
                *(f32x4*)(P.out + O_HS + (size_t)brow * 1024 + ch) = h;
                u32x2 w; w.x = cvt_pk_bf16(rn[0], rn[1]); w.y = cvt_pk_bf16(rn[2], rn[3]); *(u32x2*)gp = w;
            } }
        if (sample) { ssr += __shfl_xor(ssr, 16); ssr += __shfl_xor(ssr, 32); if (fq == 0) atomicAdd(SSR + T_ + brow, ssr); }
    }
    __syncthreads();
    if (sample) return;
    { const int s = tid >> 7, c = tid & 127; float A = 1.f, E = 0.f; unsigned lw[16], uw[16];
#pragma unroll
      for (int j = 0; j < 32; j += 2) { const float l0 = As[(32 * s + j) * 129 + c], u0 = Us[(32 * s + j) * 129 + c], l1 = As[(32 * s + j + 1) * 129 + c], u1 = Us[(32 * s + j + 1) * 129 + c];
          const float a0 = __builtin_amdgcn_exp2f(LOG2E_ * l0), a1 = __builtin_amdgcn_exp2f(LOG2E_ * l1);
          E = a0 * E + u0; A *= a0; E = a1 * E + u1; A *= a1; lw[j >> 1] = cvt_pk_bf16(l0, l1); uw[j >> 1] = cvt_pk_bf16(u0, u1); }
      ((float*)(ws + OFF_SEGA))[(size_t)(tile * 4 + s) * 1024 + ch0 + c] = A; ((float*)(ws + OFF_SEGE))[(size_t)(tile * 4 + s) * 1024 + ch0 + c] = E;
      sgA[tid] = A; sgE[tid] = E;
      u32x4* lp = (u32x4*)(LAT + (size_t)(ch0 + c) * T_ + t0 + 32 * s); u32x4* up = (u32x4*)(UT + (size_t)(ch0 + c) * T_ + t0 + 32 * s);
#pragma unroll
      for (int q = 0; q < 4; ++q) { lp[q] = (u32x4){lw[4 * q], lw[4 * q + 1], lw[4 * q + 2], lw[4 * q + 3]}; up[q] = (u32x4){uw[4 * q], uw[4 * q + 1], uw[4 * q + 2], uw[4 * q + 3]}; } }
    __syncthreads();
    if (tid < 128) { float A = 1.f, E = 0.f;
#pragma unroll
        for (int s = 0; s < 4; ++s) { const float a = sgA[s * 128 + tid], e = sgE[s * 128 + tid]; E = a * E + e; A *= a; }
        ((float*)(ws + OFF_TILEA))[(size_t)tile * 1024 + ch0 + tid] = A; ((float*)(ws + OFF_TILEE))[(size_t)tile * 1024 + ch0 + tid] = E; }
    __syncthreads();
}

__device__ void rnn2_item(const Params& P, char* lds, int tile, int nb) {
    char* ws = P.ws; bf16_t* MIX = (bf16_t*)(ws + OFF_MIX); const bf16_t* LAT = (const bf16_t*)(ws + OFF_HM); const bf16_t* UT = (const bf16_t*)(ws + OFF_U);
    const float* SEGA = (const float*)(ws + OFF_SEGA); const float* SEGE = (const float*)(ws + OFF_SEGE); const float* TA = (const float*)(ws + OFF_TILEA); const float* TE = (const float*)(ws + OFF_TILEE);
    float* SSR = (float*)(ws + OFF_SS) + MP_;
    float* pa = (float*)lds; float* pe = pa + 512; float* sq = pe + 512; bf16_t* GY = (bf16_t*)(sq + 128 * 129);
    int tid = threadIdx.x; asm volatile("" : "+v"(tid));
    const int s = tid >> 7, c = tid & 127, ch = nb * 128 + c;
    const int t0 = tile * 128, tb = t0 + 32 * s;
    u32x4 gyv[4];
#pragma unroll
    for (int i = 0; i < 4; ++i) { const int id = i * 512 + tid, row = id >> 4, c8 = (id & 15) * 8; gyv[i] = *(const u32x4*)(MIX + (size_t)(t0 + row) * 2048 + 1024 + nb * 128 + c8); }
    u32x4 lav[4], uv[4];
    { const u32x4* lp = (const u32x4*)(LAT + (size_t)ch * T_ + tb); const u32x4* up = (const u32x4*)(UT + (size_t)ch * T_ + tb);
#pragma unroll
      for (int q = 0; q < 4; ++q) { lav[q] = lp[q]; uv[q] = up[q]; } }
    { float A = 1.f, E = 0.f; const int lo = s * 32, hi = min(lo + 32, tile);
      for (int k0 = lo; k0 < hi; k0 += 16) { float av[16], ev[16];
#pragma unroll
          for (int i = 0; i < 16; ++i) { const int k = min(k0 + i, hi - 1); av[i] = TA[(size_t)k * 1024 + ch]; ev[i] = TE[(size_t)k * 1024 + ch]; }
#pragma unroll
          for (int i = 0; i < 16; ++i) { const bool on = k0 + i < hi; const float a = on ? av[i] : 1.f, e = on ? ev[i] : 0.f; E = a * E + e; A *= a; } }
      pa[tid] = A; pe[tid] = E; }
#pragma unroll
    for (int i = 0; i < 4; ++i) { const int id = i * 512 + tid, row = id >> 4, c8 = (id & 15) * 8; *(u32x4*)(GY + row * 136 + c8) = gyv[i]; }
    __syncthreads();
    float h = 0.f;
#pragma unroll
    for (int q = 0; q < 4; ++q) h = pa[q * 128 + c] * h + pe[q * 128 + c];
    { float sa[3], se[3];
#pragma unroll
      for (int s2 = 0; s2 < 3; ++s2) { const int sx = min(s2, max(s - 1, 0)); sa[s2] = SEGA[(size_t)(tile * 4 + sx) * 1024 + ch]; se[s2] = SEGE[(size_t)(tile * 4 + sx) * 1024 + ch]; }
#pragma unroll
      for (int s2 = 0; s2 < 3; ++s2) if (s2 < s) h = sa[s2] * h + se[s2]; }
#pragma unroll
    for (int q = 0; q < 4; ++q) {
        const unsigned lw[4] = {lav[q].x, lav[q].y, lav[q].z, lav[q].w}, uw[4] = {uv[q].x, uv[q].y, uv[q].z, uv[q].w};
#pragma unroll
        for (int p = 0; p < 4; ++p)
#pragma unroll
            for (int hh = 0; hh < 2; ++hh) { const int j = 8 * q + 2 * p + hh; const float la = hh ? bfhi(lw[p]) : bflo(lw[p]), u = hh ? bfhi(uw[p]) : bflo(uw[p]);
                bf16_t* g = GY + (32 * s + j) * 136 + c;
                h = __builtin_amdgcn_exp2f(LOG2E_ * la) * h + u; const float rn = h * bf2f(*g); *g = f2bf(rn); sq[(32 * s + j) * 129 + c] = rn * rn; }
    }
    if (tile == 127 && s == 3) P.out[O_HP + ch] = h;
    __syncthreads();
#pragma unroll
    for (int i = 0; i < 4; ++i) { const int id = i * 512 + tid, row = id >> 4, c8 = (id & 15) * 8; *(u32x4*)(MIX + (size_t)(t0 + row) * 2048 + 1024 + nb * 128 + c8) = *(const u32x4*)(GY + row * 136 + c8); }
    { const int row = tid >> 2, q = tid & 3; float a = 0.f;
#pragma unroll 8
      for (int j = 0; j < 32; ++j) a += sq[row * 129 + q * 32 + ((j + 8 * q) & 31)];
      a += __shfl_xor(a, 1); a += __shfl_xor(a, 2);
      if (q == 0) atomicAdd(SSR + tile * 128 + row, a); }
    __syncthreads();
}

__device__ void state_out_prompt(const Params& P) {
    char* ws = P.ws; const bf16_t* KB = (const bf16_t*)(ws + OFF_KB); const bf16_t* VT = (const bf16_t*)(ws + OFF_VT); const bf16_t* XR = (const bf16_t*)(ws + OFF_XR);
    int tid = threadIdx.x; asm volatile("" : "+v"(tid));
    const size_t gt = (size_t)blockIdx.x * 512 + tid, gs = (size_t)gridDim.x * 512;
    for (size_t i = gt; i < 32768; i += gs) { const int j = (int)(i >> 8), c = (int)(i & 255);
        P.out[O_KP + i] = bf2f(KB[(size_t)(T_ - 128 + j) * 256 + c]); P.out[O_VP + i] = bf2f(VT[(size_t)c * T_ + (T_ - 128 + j)]); }
    for (size_t i = gt; i < 3072; i += gs) P.out[O_CP + i] = bf2f(XR[(size_t)(T_ - 3) * 1024 + i]);
}

template <bool PO>
__device__ __forceinline__ void ld_row16(const bf16_t* B, const float* S, int r, int lane, f32x4 (&o)[4]) {
    if (PO || r < T_) {
        u32x2 w[4];
#pragma unroll
        for (int i = 0; i < 4; ++i) w[i] = *(const u32x2*)(B + (size_t)r * 1024 + i * 256 + lane * 4);
#pragma unroll
        for (int i = 0; i < 4; ++i) o[i] = (f32x4){bflo(w[i].x), bfhi(w[i].x), bflo(w[i].y), bfhi(w[i].y)};
    } else {
        const float* p = S + (size_t)(r - T_) * 1024 + lane * 4;
#pragma unroll
        for (int i = 0; i < 4; ++i) o[i] = (f32x4){0.f, 0.f, 0.f, 0.f};
#pragma unroll
        for (int k0 = 0; k0 < 8; k0 += 2) { f32x4 t[2][4];
#pragma unroll
            for (int k = 0; k < 2; ++k)
#pragma unroll
                for (int i = 0; i < 4; ++i) t[k][i] = *(const f32x4*)(p + (size_t)(k0 + k) * 131072 + i * 256);
#pragma unroll
            for (int i = 0; i < 4; ++i) o[i] += t[0][i] + t[1][i]; }
    }
}
template <bool PO>
__device__ __forceinline__ void phase7_batch(const Params& P, int r0, int nw, int lane) {
    char* ws = P.ws; const float* MOD = (const float*)(ws + OFF_MOD);
    const bf16_t* O = (const bf16_t*)(ws + OFF_XR); bf16_t* H = (bf16_t*)(ws + OFF_HM); const float* OS2 = (const float*)(ws + OFF_OS2);
    f32x4 v[NBR][4], ov[NBR][4]; float sso[NBR], ss[NBR];
#pragma unroll
    for (int b = 0; b < NBR; ++b) { const int r = r0 + b * nw;
        if (PO || r < MR_) { const float* x = xrow(P, r);
#pragma unroll
            for (int i = 0; i < 4; ++i) v[b][i] = __builtin_nontemporal_load((const f32x4*)(x + i * 256 + lane * 4));
            ld_row16<PO>(O, OS2, r, lane, ov[b]); }
        else {
#pragma unroll
            for (int i = 0; i < 4; ++i) { v[b][i] = (f32x4){0.f, 0.f, 0.f, 0.f}; ov[b][i] = (f32x4){0.f, 0.f, 0.f, 0.f}; } } }
#pragma unroll
    for (int b = 0; b < NBR; ++b) { sso[b] = 0.f;
#pragma unroll
        for (int i = 0; i < 4; ++i) sso[b] += (ov[b][i][0] * ov[b][i][0] + ov[b][i][1] * ov[b][i][1]) + (ov[b][i][2] * ov[b][i][2] + ov[b][i][3] * ov[b][i][3]);
        sso[b] = wave_sum(sso[b]); }
#pragma unroll
    for (int b = 0; b < NBR; ++b) { const int r = r0 + b * nw; ss[b] = 0.f; if (!PO && r >= MR_) continue;
        const float* md = MOD + (size_t)modrow(r) * 6144; const float rso = rsqrtf(sso[b] * (1.0f / 1024.0f) + EPS_);
#pragma unroll
        for (int i = 0; i < 4; ++i) { const int c = i * 256 + lane * 4; const f32x4 g1 = *(const f32x4*)(md + 2048 + c), gp = *(const f32x4*)(P.in[I_GPOM] + c);
            v[b][i] = v[b][i] + g1 * ((ov[b][i] * rso) * gp); ss[b] += (v[b][i][0] * v[b][i][0] + v[b][i][1] * v[b][i][1]) + (v[b][i][2] * v[b][i][2] + v[b][i][3] * v[b][i][3]); }
        ss[b] = wave_sum(ss[b]); }
#pragma unroll
    for (int b = 0; b < NBR; ++b) { const int r = r0 + b * nw; if (!PO && r >= MP_) continue;
        if (!PO && r >= MR_) { for (int i = 0; i < 4; ++i) *(u32x2*)(H + (size_t)r * 1024 + i * 256 + lane * 4) = (u32x2){0u, 0u}; continue; }
        const float* md = MOD + (size_t)modrow(r) * 6144; const float rs = rsqrtf(ss[b] * (1.0f / 1024.0f) + EPS_);
#pragma unroll
        for (int i = 0; i < 4; ++i) { const int c = i * 256 + lane * 4; const f32x4 g = *(const f32x4*)(P.in[I_GPF] + c), sh = *(const f32x4*)(md + 3072 + c), sc = *(const f32x4*)(md + 4096 + c);
            __builtin_nontemporal_store(pk4((v[b][i] * rs * g) * (sc + 1.0f) + sh), (u32x2*)(H + (size_t)r * 1024 + c)); } }
}
__device__ void phase7(const Params& P) {
    int tid = threadIdx.x; asm volatile("" : "+v"(tid));
    const int wid = __builtin_amdgcn_readfirstlane(tid >> 6), lane = tid & 63;
    const int nw = gridDim.x * 8;
    for (int r0 = blockIdx.x * 8 + wid; r0 < MP_; r0 += nw * NBR) {
        if (r0 + (NBR - 1) * nw < T_) phase7_batch<true>(P, r0, nw, lane); else phase7_batch<false>(P, r0, nw, lane);
    }
}

constexpr int NB10 = 2;
template <bool PO>
__device__ __forceinline__ void phase10_batch(const Params& P, int r0, int nw, int lane) {
    char* ws = P.ws; const float* MOD = (const float*)(ws + OFF_MOD);
    const bf16_t* O = (const bf16_t*)(ws + OFF_XR); const bf16_t* F = (const bf16_t*)(ws + OFF_HM); const float* OS2 = (const float*)(ws + OFF_OS2); const float* OS4 = (const float*)(ws + OFF_OS4);
    f32x4 xv[NB10][4], ov[NB10][4], fv[NB10][4]; float sso[NB10], ssf[NB10];
#pragma unroll
    for (int b = 0; b < NB10; ++b) { const int r = r0 + b * nw;
        if (PO || r < MR_) { const float* x = xrow(P, r);
#pragma unroll
            for (int i = 0; i < 4; ++i) xv[b][i] = __builtin_nontemporal_load((const f32x4*)(x + i * 256 + lane * 4));
            ld_row16<PO>(O, OS2, r, lane, ov[b]); ld_row16<PO>(F, OS4, r, lane, fv[b]); }
        else {
#pragma unroll
            for (int i = 0; i < 4; ++i) { xv[b][i] = (f32x4){0.f, 0.f, 0.f, 0.f}; ov[b][i] = (f32x4){0.f, 0.f, 0.f, 0.f}; fv[b][i] = (f32x4){0.f, 0.f, 0.f, 0.f}; } } }
#pragma unroll
    for (int b = 0; b < NB10; ++b) { sso[b] = 0.f; ssf[b] = 0.f;
#pragma unroll
        for (int i = 0; i < 4; ++i) { sso[b] += (ov[b][i][0] * ov[b][i][0] + ov[b][i][1] * ov[b][i][1]) + (ov[b][i][2] * ov[b][i][2] + ov[b][i][3] * ov[b][i][3]);
            ssf[b] += (fv[b][i][0] * fv[b][i][0] + fv[b][i][1] * fv[b][i][1]) + (fv[b][i][2] * fv[b][i][2] + fv[b][i][3] * fv[b][i][3]); }
        sso[b] = wave_sum(sso[b]); ssf[b] = wave_sum(ssf[b]); }
#pragma unroll
    for (int b = 0; b < NB10; ++b) { const int r = r0 + b * nw; if (!PO && r >= MR_) continue;
        const float* md = MOD + (size_t)modrow(r) * 6144; float* y = r < T_ ? P.out + O_YP + (size_t)r * 1024 : P.out + O_YS + (size_t)(r - T_) * 1024;
        const float rso = rsqrtf(sso[b] * (1.0f / 1024.0f) + EPS_), rsf = rsqrtf(ssf[b] * (1.0f / 1024.0f) + EPS_);
#pragma unroll
        for (int i = 0; i < 4; ++i) { const int c = i * 256 + lane * 4;
            const f32x4 g1 = *(const f32x4*)(md + 2048 + c), gp = *(const f32x4*)(P.in[I_GPOM] + c), g2 = *(const f32x4*)(md + 5120 + c), gf = *(const f32x4*)(P.in[I_GPOF] + c);
            const f32x4 x1 = xv[b][i] + g1 * ((ov[b][i] * rso) * gp);
            __builtin_nontemporal_store(x1 + g2 * ((fv[b][i] * rsf) * gf), (f32x4*)(y + c)); } }
}
constexpr int NBF = 3;
__device__ __forceinline__ f32x4 up4(const u32x2 w) { return (f32x4){bflo(w.x), bfhi(w.x), bflo(w.y), bfhi(w.y)}; }
__device__ __forceinline__ void phase10_fast(const Params& P, int r0, int nw, int lane) {
    char* ws = P.ws; const float* md = (const float*)(ws + OFF_MOD);
    const bf16_t* O = (const bf16_t*)(ws + OFF_XR); const bf16_t* F = (const bf16_t*)(ws + OFF_HM);
    f32x4 xv[NBF][4]; u32x2 ow[NBF][4], fw[NBF][4]; float sso[NBF], ssf[NBF];
#pragma unroll
    for (int b = 0; b < NBF; ++b) { const int r = r0 + b * nw; const float* x = P.in[I_XP] + (size_t)r * 1024;
#pragma unroll
        for (int i = 0; i < 4; ++i) { const int c = i * 256 + lane * 4; xv[b][i] = __builtin_nontemporal_load((const f32x4*)(x + c));
            ow[b][i] = *(const u32x2*)(O + (size_t)r * 1024 + c); fw[b][i] = *(const u32x2*)(F + (size_t)r * 1024 + c); } }
#pragma unroll
    for (int b = 0; b < NBF; ++b) { sso[b] = 0.f; ssf[b] = 0.f;
#pragma unroll
        for (int i = 0; i < 4; ++i) { const f32x4 o = up4(ow[b][i]), f = up4(fw[b][i]);
            sso[b] += (o[0] * o[0] + o[1] * o[1]) + (o[2] * o[2] + o[3] * o[3]); ssf[b] += (f[0] * f[0] + f[1] * f[1]) + (f[2] * f[2] + f[3] * f[3]); }
        sso[b] = wave_sum(sso[b]); ssf[b] = wave_sum(ssf[b]); }
#pragma unroll
    for (int i = 0; i < 4; ++i) { const int c = i * 256 + lane * 4;
        const f32x4 g1 = *(const f32x4*)(md + 2048 + c), gp = *(const f32x4*)(P.in[I_GPOM] + c), g2 = *(const f32x4*)(md + 5120 + c), gf = *(const f32x4*)(P.in[I_GPOF] + c);
        const f32x4 a1 = g1 * gp, a2 = g2 * gf;
#pragma unroll
        for (int b = 0; b < NBF; ++b) { const int r = r0 + b * nw;
            const float rso = rsqrtf(sso[b] * (1.0f / 1024.0f) + EPS_), rsf = rsqrtf(ssf[b] * (1.0f / 1024.0f) + EPS_);
            const f32x4 x1 = xv[b][i] + a1 * (up4(ow[b][i]) * rso);
            __builtin_nontemporal_store(x1 + a2 * (up4(fw[b][i]) * rsf), (f32x4*)(P.out + O_YP + (size_t)r * 1024 + c)); } }
}
__device__ void phase10(const Params& P) {
    int tid = threadIdx.x; asm volatile("" : "+v"(tid));
    const int wid = __builtin_amdgcn_readfirstlane(tid >> 6), lane = tid & 63;
    const int nw = gridDim.x * 8;
    int r0 = blockIdx.x * 8 + wid;
    for (; r0 + (NBF - 1) * nw < T_; r0 += nw * NBF) phase10_fast(P, r0, nw, lane);
    for (; r0 < MR_; r0 += nw * NB10) {
        if (r0 + (NB10 - 1) * nw < T_) phase10_batch<true>(P, r0, nw, lane); else phase10_batch<false>(P, r0, nw, lane);
    }
}

#define XB_TMO      128
#define XB_XCNT(j)  (256  + 64 * (j))
#define XB_XSUB(j)  (1280 + 64 * (j))
#define XB_XGEN(j)  (2304 + 64 * (j))
#define XB_TOP      3328
#define XB_TOPGEN   3392
#define XCD_BAR_WORDS 3456
#define XB_SPIN_CAP (1u << 22)
__device__ __forceinline__ unsigned xb_ld(unsigned* p)              { return __hip_atomic_load(p, __ATOMIC_RELAXED, __HIP_MEMORY_SCOPE_AGENT); }
__device__ __forceinline__ unsigned xb_add(unsigned* p, unsigned v) { return __hip_atomic_fetch_add(p, v, __ATOMIC_RELAXED, __HIP_MEMORY_SCOPE_AGENT); }
__device__ __forceinline__ unsigned xb_xcc_id() { return (unsigned)__builtin_amdgcn_s_getreg((3 << 11) | 20) & 0xFu; }
#define XB_SPIN(cond, bar) do { unsigned _sp = 0; while (cond) { __builtin_amdgcn_s_sleep(1); \
    if ((++_sp & 255u) == 0u) { if (xb_ld(&(bar)[XB_TMO])) break; if (_sp > XB_SPIN_CAP) { atomicAdd(&(bar)[XB_TMO], 1u); break; } } } } while (0)
struct XcdBarrier { unsigned* bar; unsigned x; volatile LAS unsigned* st; };
__device__ __forceinline__ XcdBarrier xcd_barrier_post(unsigned* bar, volatile LAS unsigned* st) {
    XcdBarrier b; b.bar = bar; b.x = xb_xcc_id(); b.st = st;
    if (threadIdx.x == 0) (void)xb_add(&bar[XB_XCNT(b.x)], 1u);
    return b;
}
__device__ __forceinline__ void xcd_barrier_complete(unsigned* bar, unsigned x, unsigned& nloc, unsigned& nx) {
    const unsigned G = gridDim.x * gridDim.y * gridDim.z;
    unsigned sum, cnt, mine, sp = 0u;
    for (;;) {
        sum = 0u; cnt = 0u; mine = 0u;
#pragma unroll
        for (unsigned j = 0; j < 16; ++j) { const unsigned c = xb_ld(&bar[XB_XCNT(j)]); sum += c; cnt += (c > 0u) ? 1u : 0u; mine = (j == x) ? c : mine; }
        if (sum == G) break;
        __builtin_amdgcn_s_sleep(1);
        if ((++sp & 255u) == 0u) { if (xb_ld(&bar[XB_TMO])) break; if (sp > XB_SPIN_CAP) { atomicAdd(&bar[XB_TMO], 1u); break; } }
    }
    nloc = mine > 0u ? mine : 1u; nx = cnt > 0u ? cnt : 1u;
}
__device__ __forceinline__ void xcd_barrier(const XcdBarrier& b) {
    asm volatile("s_waitcnt vmcnt(0)" ::: "memory");
    __syncthreads();
    if (threadIdx.x == 0) {
        unsigned* bar = b.bar;
        __builtin_amdgcn_s_waitcnt(0);
        unsigned nloc = b.st[0], nx = b.st[1];
        if (nloc == 0u) { xcd_barrier_complete(bar, b.x, nloc, nx); b.st[0] = nloc; b.st[1] = nx; }
        const unsigned old = xb_add(&bar[XB_XSUB(b.x)], 1u);
        const unsigned gen = old / nloc;
        if (old + 1u == (gen + 1u) * nloc) {
            __builtin_amdgcn_fence(__ATOMIC_RELEASE, "agent");
            asm volatile("s_waitcnt vmcnt(0)" ::: "memory");
            const unsigned og = xb_add(&bar[XB_TOP], 1u);
            const unsigned tg = og / nx;
            if (og + 1u == (tg + 1u) * nx) xb_add(&bar[XB_TOPGEN], 1u);
            else XB_SPIN(xb_ld(&bar[XB_TOPGEN]) == tg, bar);
            __builtin_amdgcn_fence(__ATOMIC_ACQUIRE, "agent");
            xb_add(&bar[XB_XGEN(b.x)], 1u);
            asm volatile("s_waitcnt vmcnt(0)" ::: "memory");
        } else {
            XB_SPIN(xb_ld(&bar[XB_XGEN(b.x)]) == gen, bar);
            __builtin_amdgcn_fence(__ATOMIC_ACQUIRE, "agent");
            asm volatile("s_waitcnt vmcnt(0)" ::: "memory");
        }
    }
    __syncthreads();
}

template <bool COOP>
__global__ void __launch_bounds__(512) hymba_mega(Params P, int ph_lo, int ph_hi) {
    extern __shared__ __attribute__((aligned(16))) char lds_raw[];
    LAS unsigned char* lds = (LAS unsigned char*)lds_raw;
    char* ws = P.ws; const int G = gridDim.x, bid = blockIdx.x;
    XcdBarrier xb; xb.bar = (unsigned*)(ws + OFF_BAR); xb.x = 0; xb.st = (volatile LAS unsigned*)(lds + LDS_BYTES - 16);
    if (COOP) { if (threadIdx.x == 0) { xb.st[0] = 0u; xb.st[1] = 0u; } __syncthreads(); xb = xcd_barrier_post((unsigned*)(ws + OFF_BAR), (volatile LAS unsigned*)(lds + LDS_BYTES - 16)); }
#if MK_PROBE
    unsigned long long tprev = __builtin_amdgcn_s_memrealtime(), tacc = 0ull;
#endif
#if MK_PROBE_ID
    unsigned long long tacc2 = 0ull;
#endif
    for (int ph = ph_lo; ph < ph_hi; ++ph) {
        switch (ph) {
        case 0: if constexpr (PH_ON(0)) phase0(P, (float*)lds_raw); break;
        case 1: if constexpr (PH_ON(1)) phase1(P, lds, (float*)lds_raw); break;
        case 2: if constexpr (PH_ON(2)) phase2(P); break;
        case 3: if constexpr (PH_ON(3)) { Gemm g{(const bf16_t*)(ws + OFF_HM), (const bf16_t*)(ws + OFF_WT_IN), 1024}; Sched S; S.init(65, 14, G, bid);
                  Epi1 E{(bf16_t*)(ws + OFF_MIX), (bf16_t*)(ws + OFF_KB), (bf16_t*)(ws + OFF_VT), (bf16_t*)(ws + OFF_VSB), (bf16_t*)(ws + OFF_XR)};
                  PB_BEGIN(5); gemm_phase<Epi1, false, false>(lds, g, S, E); PB_END(5); } break;
        case 4: if constexpr (PH_ON(4)) {
                  const int nR = (1024 + 64 + G - 1) / G, nslot = 2 + nR;
                  const int cls = (bid >> 3) % nslot;
#pragma unroll 1
                  for (int st = 0; st < nslot; ++st) { int which = st + cls; if (which >= nslot) which -= nslot;
                      if (which == 0) { for (int it = bid; it < 256; it += G) attn_prompt_item(P, lds_raw, it >> 1, it & 1); }
                      else if (which == 1) { for (int it = bid; it < 256; it += G) attn_sample_item(P, lds_raw, it >> 1, it & 1); }
                      else { const int it = bid + (which - 2) * G;
                          if (it < 1024) rnn1_item<false>(P, lds_raw, it >> 3, it & 7, 0); else if (it < 1024 + 64) rnn1_item<true>(P, lds_raw, 128, (it - 1024) & 7, (it - 1024) >> 3); } }
                  state_out_prompt(P); } break;
        case 5: if constexpr (PH_ON(5)) { for (int it = bid; it < 128 * 8; it += G) rnn2_item(P, lds_raw, it >> 3, it & 7); } break;
        case 6: if constexpr (PH_ON(6)) { Gemm g{(const bf16_t*)(ws + OFF_MIX), (const bf16_t*)(ws + OFF_WT_OUT), 2048}; Sched S; S.init(64, 4, G, bid);
                  Epi2 E{(bf16_t*)(ws + OFF_XR), (const float*)(ws + OFF_SS), (const float*)(ws + OFF_SS) + MP_};
                  PB_BEGIN(1); gemm_phase<Epi2, false, true>(lds, g, S, E); PB_END(1);
                  PB_BEGIN(2); for (int it = bid; it < 256; it += G) small_gemm_item<8>((const bf16_t*)(ws + OFF_MIX) + (size_t)T_ * 2048, 2048, (const bf16_t*)(ws + OFF_WT_OUT), 2048, (float*)(ws + OFF_OS2), it >> 3, it & 7,
                                                                          (const float*)(ws + OFF_SS) + ((it & 7) < 4 ? 0 : MP_) + T_); PB_END(2); } break;
        case 7: if constexpr (PH_ON(7)) phase7(P); break;
        case 8: if constexpr (PH_ON(8)) { Gemm g{(const bf16_t*)(ws + OFF_HM), (const bf16_t*)(ws + OFF_WT_UP), 1024}; Sched S; S.init(67, 22, G, bid);
                  Epi3 E{(bf16_t*)(ws + OFF_MIX), P.in[I_FCW], P.in[I_FCB], P.in[I_SF], P.out};
                  PB_BEGIN(6); gemm_phase<Epi3, true, false>(lds, g, S, E); PB_END(6); } break;
        case 9: if constexpr (PH_ON(9)) { Gemm g{(const bf16_t*)(ws + OFF_MIX), (const bf16_t*)(ws + OFF_WT_DOWN), 2816}; Sched S; S.init(64, 4, G, bid);
                  Epi4 E{(bf16_t*)(ws + OFF_HM)};
                  PB_BEGIN(3); gemm_phase<Epi4, false, false>(lds, g, S, E); PB_END(3);
                  PB_BEGIN(4); for (int it = bid; it < 256; it += G) small_gemm_item<11>((const bf16_t*)(ws + OFF_MIX) + (size_t)T_ * 2816, 2816, (const bf16_t*)(ws + OFF_WT_DOWN), 2816, (float*)(ws + OFF_OS4), it >> 3, it & 7, nullptr); PB_END(4); } break;
        case 10: if constexpr (PH_ON(10)) phase10(P); break;
        }
        if (COOP) { if (ph + 1 < ph_hi) xcd_barrier(xb); }
#if MK_PROBE
        { const unsigned long long tn = __builtin_amdgcn_s_memrealtime(); if ((MK_PROBE >> ph) & 1) tacc += tn - tprev; tprev = tn; }
#endif
    }
#if MK_PROBE_ID
    if (bid == 0 && threadIdx.x == 0) { const unsigned long long t0 = __builtin_amdgcn_s_memrealtime(); while (__builtin_amdgcn_s_memrealtime() - t0 < 4ull * tacc2) __builtin_amdgcn_s_sleep(8); }
#endif
#if MK_PROBE
    if (bid == 0 && threadIdx.x == 0) { const unsigned long long t0 = __builtin_amdgcn_s_memrealtime(); while (__builtin_amdgcn_s_memrealtime() - t0 < 4ull * tacc) __builtin_amdgcn_s_sleep(8); }
#endif
}

extern "C" void kernel_launch(void* const* d_in, const int* in_sizes, int n_in, void* d_out, int out_size, void* d_ws, size_t ws_size, hipStream_t stream) {
    (void)in_sizes; (void)out_size;
    if (n_in != 31 || ws_size < WS_NEED) { fprintf(stderr, "hymba_mega: bad arguments (n_in %d, ws %zu < %zu)\n", n_in, ws_size, (size_t)WS_NEED); return; }
    Params P{};
    for (int i = 0; i < 31; ++i) P.in[i] = (const float*)d_in[i];
    P.out = (float*)d_out; P.ws = (char*)d_ws;
#if MK_COOP
    static int grid_blocks = 0;
    if (!grid_blocks) {
        (void)hipFuncSetAttribute((const void*)hymba_mega<true>, hipFuncAttributeMaxDynamicSharedMemorySize, LDS_BYTES);
        int dev = 0, cus = 0, per_cu = 0; (void)hipGetDevice(&dev); (void)hipDeviceGetAttribute(&cus, hipDeviceAttributeMultiprocessorCount, dev);
        (void)hipOccupancyMaxActiveBlocksPerMultiprocessor(&per_cu, (const void*)hymba_mega<true>, 512, LDS_BYTES);
        if (per_cu < 1) per_cu = 1; if (per_cu > 1) per_cu = 1;
        grid_blocks = cus * per_cu;
    }
    (void)hipMemsetAsync((char*)d_ws + OFF_BAR, 0, 16384, stream);
    int lo = 0, hi = 11; void* args[] = {&P, &lo, &hi};
    hipError_t e = hipLaunchCooperativeKernel((const void*)hymba_mega<true>, dim3(grid_blocks), dim3(512), args, LDS_BYTES, stream);
    if (e != hipSuccess) fprintf(stderr, "cooperative launch failed: %s (grid %d)\n", hipGetErrorString(e), grid_blocks);
#else
    static bool attr = false;
    if (!attr) { attr = true; (void)hipFuncSetAttribute((const void*)hymba_mega<false>, hipFuncAttributeMaxDynamicSharedMemorySize, LDS_BYTES); }
    for (int ph = 0; ph < 11; ++ph) hymba_mega<false><<<dim3(256), dim3(512), LDS_BYTES, stream>>>(P, ph, ph + 1);
#endif
}
```
